# Optimizing an MI355X kernel written in HIP

```python
import math
import jax, jax.numpy as jnp
from jax import lax
import numpy as np

D_MODEL = 1024
BATCH = 32
SEQ = 256
DEPTH = 2
DEC_BATCH = 8
DEC_SEQ = 4096
PAST_LEN = 512

GRID_W = 64
N_EVEN = (DEPTH + 1) // 2
N_ODD = DEPTH // 2
EPS = 1e-6
A_WIDTH = D_MODEL // 2
A_HEADS = 4
A_DK = A_WIDTH // A_HEADS
A_DV = A_WIDTH // A_HEADS
CHUNK = 64
B_WIDTH = D_MODEL // 2
S5_GROUP = 16
S5_GROUPS = B_WIDTH // S5_GROUP
S5_P = 64
C_WIDTH = D_MODEL
CONV_W = 3
EVEN_IN = 5 * A_WIDTH + 2 * B_WIDTH
EVEN_SPLITS = (A_WIDTH, 2 * A_WIDTH, 3 * A_WIDTH, 4 * A_WIDTH, 5 * A_WIDTH, 5 * A_WIDTH + B_WIDTH)
ODD_IN = 4 * C_WIDTH

kernel_name = "hybrid_hgrn2_s5_shortconv_diffusion_step"

F32 = jnp.float32


def _rmsnorm(x, g):
    xf = x.astype(F32)
    y = xf * lax.rsqrt(jnp.mean(xf * xf, axis=-1, keepdims=True) + EPS) * g.astype(F32)
    return y.astype(x.dtype)


def _adaln(cvec, w, b):
    m = jnp.dot(jax.nn.silu(cvec.astype(F32)), w.astype(F32)) + b.astype(F32)
    return jnp.split(m, 3, axis=-1)


def _modulate(h, shift, scale):
    return (h.astype(F32) * (1.0 + scale[:, None, :]) + shift[:, None, :]).astype(h.dtype)


def _hgrn2_chunk_scan(q, k, v, logf, s0):
    bsz, L, H, _ = q.shape
    n = L // CHUNK

    def to_chunks(t):
        return t.reshape(bsz, n, CHUNK, H, t.shape[-1]).transpose(1, 0, 3, 2, 4)

    mask = jnp.tril(jnp.ones((CHUNK, CHUNK), dtype=bool))[:, :, None]

    def step(S, inp):
        qc, kc, vc, gc = inp
        b = jnp.cumsum(gc, axis=2)
        diff = b[:, :, :, None, :] - b[:, :, None, :, :]
        decay = jnp.exp(jnp.where(mask, diff, -jnp.inf))
        scores = jnp.einsum('bhtk,bhtsk,bhsk->bhts', qc, decay, kc)
        o = (jnp.einsum('bhts,bhsv->bhtv', scores, vc)
             + jnp.einsum('bhtk,bhkv->bhtv', qc * jnp.exp(b), S))
        b_last = b[:, :, -1:, :]
        S_new = (jnp.exp(b_last[:, :, 0, :])[..., None] * S
                 + jnp.einsum('bhsk,bhsv->bhkv', kc * jnp.exp(b_last - b), vc))
        return S_new, o

    S_fin, o = lax.scan(step, s0, (to_chunks(q), to_chunks(k), to_chunks(v), to_chunks(logf)))
    o = o.transpose(1, 0, 3, 2, 4).reshape(bsz, L, H, v.shape[-1])
    return o, S_fin


def _hgrn2_dir(q, f_pre, v, lb, s0):
    f = lb + (1.0 - lb) * jax.nn.sigmoid(f_pre)
    heads = lambda t: t.reshape(t.shape[0], t.shape[1], A_HEADS, -1)
    return _hgrn2_chunk_scan(heads(q), heads(1.0 - f), heads(v), heads(jnp.log(f)), s0)


def _complex_affine_combine(e1, e2):
    a1r, a1i, b1r, b1i = e1
    a2r, a2i, b2r, b2i = e2
    return (a2r * a1r - a2i * a1i,
            a2r * a1i + a2i * a1r,
            a2r * b1r - a2i * b1i + b2r,
            a2r * b1i + a2i * b1r + b2i)


def _s5_mixer(u, lam_re, lam_im, log_dt, b_re, b_im, c_re, c_im, d_skip, w_glu, b_glu, x0_re, x0_im):
    bsz, L, _ = u.shape
    uf = u.reshape(bsz, L, S5_GROUPS, S5_GROUP)
    dt = jnp.exp(log_dt)[..., None]
    mag = jnp.exp(lam_re * dt)
    lbar_re = mag * jnp.cos(lam_im * dt)
    lbar_im = mag * jnp.sin(lam_im * dt)
    den = lam_re * lam_re + lam_im * lam_im
    coef_re = ((lbar_re - 1.0) * lam_re + lbar_im * lam_im) / den
    coef_im = (lbar_im * lam_re - (lbar_re - 1.0) * lam_im) / den
    bb_re = coef_re[..., None] * b_re - coef_im[..., None] * b_im
    bb_im = coef_re[..., None] * b_im + coef_im[..., None] * b_re

    def one_dir(d, useq):
        lr, li = lbar_re[d], lbar_im[d]
        xr0, xi0 = x0_re[:, d], x0_im[:, d]
        bu_re = jnp.einsum('blgs,gps->blgp', useq, bb_re[d])
        bu_im = jnp.einsum('blgs,gps->blgp', useq, bb_im[d])
        bu_re = bu_re.at[:, 0].add(lr * xr0 - li * xi0)
        bu_im = bu_im.at[:, 0].add(lr * xi0 + li * xr0)
        a_re = jnp.broadcast_to(lr, bu_re.shape)
        a_im = jnp.broadcast_to(li, bu_im.shape)
        _, _, xr, xi = lax.associative_scan(_complex_affine_combine, (a_re, a_im, bu_re, bu_im), axis=1)
        y = jnp.einsum('blgp,gsp->blgs', xr, c_re[d]) - jnp.einsum('blgp,gsp->blgs', xi, c_im[d])
        return y, xr[:, -1], xi[:, -1]

    y_f, xr_f, xi_f = one_dir(0, uf)
    y_b, xr_b, xi_b = one_dir(1, uf[:, ::-1])
    y = y_f + y_b[:, ::-1] + d_skip.reshape(S5_GROUPS, S5_GROUP) * uf
    y = jax.nn.gelu(y.reshape(bsz, L, B_WIDTH))
    y = y * jax.nn.sigmoid(jnp.dot(y, w_glu) + b_glu)
    return y, jnp.stack([xr_f, xr_b], axis=1), jnp.stack([xi_f, xi_b], axis=1)


def _even_mixer(h, w_in, w_out, lb, hgrn_g, lam_re, lam_im, log_dt, b_re, b_im, c_re, c_im,
                d_skip, w_glu, b_glu, s_hgrn, s_re, s_im):
    bsz, L, _ = h.shape
    z = jnp.dot(h, w_in).astype(F32)
    q, f_fw, f_bw, v, g_a, u, g_b = jnp.split(z, EVEN_SPLITS, axis=-1)
    s_hgrn = s_hgrn.astype(F32)
    o_f, s_f = _hgrn2_dir(q, f_fw, v, lb, s_hgrn[:, 0])
    o_b, s_b = _hgrn2_dir(q[:, ::-1], f_bw[:, ::-1], v[:, ::-1], lb, s_hgrn[:, 1])
    o = o_f + o_b[:, ::-1]
    o = o * lax.rsqrt(jnp.mean(o * o, axis=-1, keepdims=True) + EPS) * hgrn_g.astype(F32).reshape(A_HEADS, A_DV)
    o_a = o.reshape(bsz, L, A_WIDTH) * jax.nn.silu(g_a)
    y_b, n_re, n_im = _s5_mixer(u, lam_re.astype(F32), lam_im.astype(F32), log_dt.astype(F32),
                                b_re.astype(F32), b_im.astype(F32), c_re.astype(F32), c_im.astype(F32),
                                d_skip.astype(F32), w_glu.astype(F32), b_glu.astype(F32),
                                s_re.astype(F32), s_im.astype(F32))
    o_b2 = y_b * jax.nn.silu(g_b)
    out = jnp.dot(jnp.concatenate([o_a, o_b2], axis=-1).astype(h.dtype), w_out)
    return out, jnp.stack([s_f, s_b], axis=1), n_re, n_im


def _row_conv(z, w, b, rows):
    bsz, L, ch = z.shape
    zr = z.reshape(bsz * rows, L // rows, ch)
    zp = jnp.pad(zr, ((0, 0), (1, 1), (0, 0)))
    out = w[0] * zp[:, :-2] + w[1] * zp[:, 1:-1] + w[2] * zp[:, 2:] + b
    return out.reshape(bsz, L, ch)


def _odd_mixer(h, w_in, w_out, conv_w, conv_b, rows):
    z = jnp.dot(h, w_in).astype(F32)
    bg, cg, v, g = jnp.split(z, 4, axis=-1)
    y = bg * _row_conv(cg * v, conv_w.astype(F32), conv_b.astype(F32), rows)
    return jnp.dot((y * jax.nn.silu(g)).astype(h.dtype), w_out)


def setup_inputs(seed: int = 0) -> dict:
    key = jax.random.key(seed)
    ks = jax.random.split(key, 32)
    D = D_MODEL
    nrm = lambda k, shape, s: jax.random.normal(k, shape, F32) * s
    G, P, S = S5_GROUPS, S5_P, S5_GROUP
    n_idx = jnp.arange(P, dtype=F32)
    return {
        "x_prompt": nrm(ks[0], (BATCH, SEQ, D), 1.0),
        "x_sample": nrm(ks[1], (DEC_BATCH, DEC_SEQ, D), 1.0),
        "state_hgrn": nrm(ks[2], (DEC_BATCH, N_EVEN, 2, A_HEADS, A_DK, A_DV), 0.5),
        "state_s5_re": nrm(ks[3], (DEC_BATCH, N_EVEN, 2, G, P), 0.1),
        "state_s5_im": nrm(ks[4], (DEC_BATCH, N_EVEN, 2, G, P), 0.1),
        "c": nrm(ks[5], (DEC_BATCH, D), 1.0),
        "c_ctx": nrm(ks[6], (D,), 1.0),
        "norm_g": 1.0 + nrm(ks[7], (DEPTH, D), 0.05),
        "w_mod": nrm(ks[8], (DEPTH, D, 3 * D), 0.5 * D ** -0.5),
        "b_mod": nrm(ks[9], (DEPTH, 3 * D), 0.02),
        "w_in_even": nrm(ks[10], (N_EVEN, D, EVEN_IN), D ** -0.5),
        "w_out_even": nrm(ks[11], (N_EVEN, A_WIDTH + B_WIDTH, D), (A_WIDTH + B_WIDTH) ** -0.5),
        "lb_logits": nrm(ks[12], (N_EVEN + 1, A_WIDTH), 0.5),
        "hgrn_norm_g": 1.0 + nrm(ks[13], (N_EVEN, A_WIDTH), 0.05),
        "s5_lam_re": -0.5 + nrm(ks[14], (N_EVEN, 2, G, P), 0.01),
        "s5_lam_im": jnp.pi * n_idx + nrm(ks[15], (N_EVEN, 2, G, P), 0.01),
        "s5_log_dt": jax.random.uniform(ks[16], (N_EVEN, 2, G), F32, math.log(1e-3), math.log(1e-1)),
        "s5_b_re": nrm(ks[17], (N_EVEN, 2, G, P, S), (2 * S) ** -0.5),
        "s5_b_im": nrm(ks[18], (N_EVEN, 2, G, P, S), (2 * S) ** -0.5),
        "s5_c_re": nrm(ks[19], (N_EVEN, 2, G, S, P), P ** -0.5),
        "s5_c_im": nrm(ks[20], (N_EVEN, 2, G, S, P), P ** -0.5),
        "s5_d": nrm(ks[21], (N_EVEN, B_WIDTH), 1.0),
        "w_glu": nrm(ks[22], (N_EVEN, B_WIDTH, B_WIDTH), B_WIDTH ** -0.5),
        "b_glu": nrm(ks[23], (N_EVEN, B_WIDTH), 0.02),
        "w_in_odd": nrm(ks[24], (N_ODD, D, ODD_IN), D ** -0.5),
        "w_out_odd": nrm(ks[25], (N_ODD, C_WIDTH, D), C_WIDTH ** -0.5),
        "conv_w": nrm(ks[26], (N_ODD, CONV_W, C_WIDTH), CONV_W ** -0.5),
        "conv_b": nrm(ks[27], (N_ODD, C_WIDTH), 0.02),
        "final_norm_g": 1.0 + nrm(ks[28], (D,), 0.05),
    }


def reference(x_prompt, x_sample, state_hgrn, state_s5_re, state_s5_im, c, c_ctx, norm_g, w_mod, b_mod,
              w_in_even, w_out_even, lb_logits, hgrn_norm_g, s5_lam_re, s5_lam_im, s5_log_dt,
              s5_b_re, s5_b_im, s5_c_re, s5_c_im, s5_d, w_glu, b_glu, w_in_odd, w_out_odd,
              conv_w, conv_b, final_norm_g):
    rows = x_sample.shape[1] // GRID_W
    n_ctx = x_prompt.shape[0]
    lb_all = jnp.cumsum(jax.nn.softmax(lb_logits.astype(F32), axis=0), axis=0)
    zero_hgrn = jnp.zeros((n_ctx, 2, A_HEADS, A_DK, A_DV), F32)
    zero_s5 = jnp.zeros((n_ctx, 2, S5_GROUPS, S5_P), F32)
    yp, ys = x_prompt, x_sample
    st_hgrn, st_re, st_im = [], [], []
    for l in range(DEPTH):
        sh_p, sc_p, g_p = _adaln(c_ctx[None, :], w_mod[l], b_mod[l])
        sh_s, sc_s, g_s = _adaln(c, w_mod[l], b_mod[l])
        hp = _modulate(_rmsnorm(yp, norm_g[l]), sh_p, sc_p)
        hs = _modulate(_rmsnorm(ys, norm_g[l]), sh_s, sc_s)
        j = l // 2
        if l % 2 == 0:
            ev = (w_in_even[j], w_out_even[j], lb_all[j], hgrn_norm_g[j], s5_lam_re[j], s5_lam_im[j],
                  s5_log_dt[j], s5_b_re[j], s5_b_im[j], s5_c_re[j], s5_c_im[j], s5_d[j], w_glu[j], b_glu[j])
            op, sh_new, re_new, im_new = _even_mixer(hp, *ev, zero_hgrn, zero_s5, zero_s5)
            os_, _, _, _ = _even_mixer(hs, *ev, state_hgrn[:, j], state_s5_re[:, j], state_s5_im[:, j])
            st_hgrn.append(sh_new.astype(x_prompt.dtype))
            st_re.append(re_new.astype(x_prompt.dtype))
            st_im.append(im_new.astype(x_prompt.dtype))
        else:
            op = _odd_mixer(hp, w_in_odd[j], w_out_odd[j], conv_w[j], conv_b[j], 1)
            os_ = _odd_mixer(hs, w_in_odd[j], w_out_odd[j], conv_w[j], conv_b[j], rows)
        yp = (yp.astype(F32) + g_p[:, None, :] * op.astype(F32)).astype(x_prompt.dtype)
        ys = (ys.astype(F32) + g_s[:, None, :] * os_.astype(F32)).astype(x_sample.dtype)
    y_prompt = _rmsnorm(yp, final_norm_g)
    y_sample = _rmsnorm(ys, final_norm_g)
    new_state_hgrn = jnp.stack(st_hgrn, axis=1)
    new_state_s5_re = jnp.stack(st_re, axis=1)
    new_state_s5_im = jnp.stack(st_im, axis=1)
    return (y_prompt, y_sample, new_state_hgrn, new_state_s5_re, new_state_s5_im)
```

```cpp
#include <hip/hip_runtime.h>
#include <hip/hip_cooperative_groups.h>
#include <cstdio>
#include <cstdint>
namespace cg = cooperative_groups;
#ifndef MK_COOP
#define MK_COOP 1
#endif

namespace pg8 {
#define PG8_LAS __attribute__((address_space(3)))
typedef unsigned short bf16_t;
typedef short bf16x8 __attribute__((ext_vector_type(8)));
typedef float f32x4 __attribute__((ext_vector_type(4)));
typedef unsigned u32x4 __attribute__((ext_vector_type(4)));
constexpr int BM = 256, BK = 64, HALF = 128, HTB = HALF * BK * 2  , STAGE_BYTES = 8 * HTB, NXCD = 8, WGM = 8;

__host__ __device__ __forceinline__ int lds_byte(int r, int c) { const int st = (r >> 4) * 2 + (c >> 5), rr = r & 15, cc = c & 31, ob = rr * 64 + cc * 2; return st * 1024 + (ob ^ (((ob >> 9) & 1) << 5)); }
__host__ __device__ __forceinline__ void stage_rc(int b, int& R, int& C) { const int st = b / 1024, sb = b % 1024, swz = sb ^ (((sb >> 9) & 1) << 5); R = (st >> 1) * 16 + swz / 64; C = (st & 1) * 32 + (swz % 64) / 2; }
__host__ __device__ __forceinline__ int perm32(int rho) { const int n = rho >> 4, i = rho & 15; return 8 * (i >> 2) + 4 * n + (i & 3); }

struct Unit { int pm, pn; };
struct Gemm { const bf16_t* A; const bf16_t* Bt; int M, N, K; };

struct StaticOrder {
    int nM, nN, nwg, G, c;
    __host__ __device__ void init(int M, int N, int G_, int c_) { nM = M / BM; nN = N / BM; nwg = nM * nN; G = G_; c = c_; }
    __host__ __device__ bool next(int i, Unit& u) const {
        const long L = (long)i * G + c; if (L >= nwg) return false;
        int wgid = (int)L; { const int q = nwg / NXCD, r = nwg % NXCD, xcd = wgid % NXCD, off = wgid / NXCD; wgid = (xcd < r ? xcd * (q + 1) : r * (q + 1) + (xcd - r) * q) + off; }
        const int nig = WGM * nN, gid = wgid / nig, fm = gid * WGM, gsz = (nM - fm) < WGM ? (nM - fm) : WGM;
        u.pm = fm + ((wgid % nig) % gsz); u.pn = (wgid % nig) / gsz; return true;
    }
    __device__ __forceinline__ void a_ready(const Unit&) const {}
    __device__ __forceinline__ void done(const Unit&) const {}
};

__device__ __forceinline__ unsigned cvt_pk_bf16(float lo, float hi) { unsigned r; asm volatile("v_cvt_pk_bf16_f32 %0, %1, %2" : "=v"(r) : "v"(lo), "v"(hi)); return r; }

template <class Epi, class Sched>
__device__ __forceinline__ void gemm_phase(PG8_LAS unsigned char* lds, const Gemm g, const Sched& S, const Epi& E) {
    const int tid = threadIdx.x, wid = __builtin_amdgcn_readfirstlane(tid >> 6), lane = tid & 63, wr = wid >> 2, wc = wid & 3, fr = lane & 15, fq = lane >> 4;
    const int K = g.K, nt = K / BK;
    unsigned voffA[2], voffB[2];
#pragma unroll
    for (int i = 0; i < 2; ++i) { int R, C; stage_rc(tid * 16 + i * 8192, R, C); const int Rb = Epi::PERM ? ((R & ~31) + perm32(R & 31)) : R;
        voffA[i] = (unsigned)(R * K + C) * 2u; voffB[i] = (unsigned)(Rb * K + C) * 2u; }
    const size_t kstep = (size_t)(BK * 2);
    const size_t hstep = (size_t)HALF * K * 2;
    const size_t tstep = 2 * hstep;
    const unsigned ldsw = (unsigned)wid * 1024u;
    const int aoff = lds_byte(wr * 64 + fr, fq * 8), boff = lds_byte(wc * 32 + fr, fq * 8);
#define PG8_SA(b, h) (((b) * 2 + (h)) * HTB)
#define PG8_SB(b, h) ((4 + (b) * 2 + (h)) * HTB)
#define PG8_STAGE(bufoff, gbase, voff) do { _Pragma("unroll") for (int _i = 0; _i < 2; ++_i) \
        __builtin_amdgcn_global_load_lds((const unsigned*)((const char*)(gbase) + (voff)[_i]), (PG8_LAS unsigned*)(lds + (bufoff) + ldsw + _i * 8192), 16, 0, 0); } while (0)
#define PG8_LDA(dst, b, h) do { _Pragma("unroll") for (int m = 0; m < 4; ++m) _Pragma("unroll") for (int k = 0; k < 2; ++k) dst[m][k] = *(const PG8_LAS bf16x8*)(lds + PG8_SA(b, h) + aoff + m * 2048 + k * 1024); } while (0)
#define PG8_LDB(dst, b, h) do { _Pragma("unroll") for (int n = 0; n < 2; ++n) _Pragma("unroll") for (int k = 0; k < 2; ++k) dst[n][k] = *(const PG8_LAS bf16x8*)(lds + PG8_SB(b, h) + boff + n * 2048 + k * 1024); } while (0)
#define PG8_MMA(ai, bj, At, Bt) do { __builtin_amdgcn_s_setprio(1); _Pragma("unroll") for (int m = 0; m < 4; ++m) _Pragma("unroll") for (int n = 0; n < 2; ++n) _Pragma("unroll") for (int k = 0; k < 2; ++k) \
        acc[ai][bj][m][n] = __builtin_amdgcn_mfma_f32_16x16x32_bf16(Bt[n][k], At[m][k], acc[ai][bj][m][n], 0, 0, 0); __builtin_amdgcn_s_setprio(0); } while (0)
#define PG8_WAIT_V(n) asm volatile("s_waitcnt vmcnt(" #n ")" ::: "memory")
#define PG8_WAIT_L(n) asm volatile("s_waitcnt lgkmcnt(" #n ")" ::: "memory")
#define PG8_BAR __builtin_amdgcn_s_barrier()
#define PG8_SCHED __builtin_amdgcn_sched_barrier(0)
    Unit cur, nxt; int ui = 0;
    if (!S.next(0, cur)) return;
    f32x4 acc[2][2][4][2];
#pragma unroll
    for (int a = 0; a < 2; ++a)
#pragma unroll
        for (int b = 0; b < 2; ++b)
#pragma unroll
            for (int m = 0; m < 4; ++m)
#pragma unroll
                for (int n = 0; n < 2; ++n) acc[a][b][m][n] = (f32x4){0.f, 0.f, 0.f, 0.f};
    bf16x8 At[4][2], B0[2][2], B1[2][2];
    const char* cA = (const char*)g.A + (size_t)cur.pm * tstep; const char* cB = (const char*)g.Bt + (size_t)cur.pn * tstep;
    S.a_ready(cur);
    PG8_STAGE(PG8_SB(0, 0), cB, voffB); PG8_STAGE(PG8_SA(0, 0), cA, voffA); PG8_STAGE(PG8_SB(0, 1), cB + hstep, voffB); PG8_STAGE(PG8_SA(0, 1), cA + hstep, voffA);
    if (wr == 1) PG8_BAR;
    PG8_WAIT_V(4); PG8_BAR;
    PG8_STAGE(PG8_SB(1, 0), cB + kstep, voffB); PG8_STAGE(PG8_SA(1, 0), cA + kstep, voffA); PG8_STAGE(PG8_SB(1, 1), cB + hstep + kstep, voffB);
    PG8_WAIT_V(6); PG8_BAR;
    for (;;) {
        const bool has_next = S.next(ui + 1, nxt);
        const char* nA = has_next ? (const char*)g.A + (size_t)nxt.pm * tstep : cA; const char* nB = has_next ? (const char*)g.Bt + (size_t)nxt.pn * tstep : cB;
        for (int t = 0; t < nt; t += 2) {
            const bool last = (t == nt - 2);
            const char* a1 = cA + (size_t)(t + 1) * kstep;
            const char* a2 = last ? nA : cA + (size_t)(t + 2) * kstep; const char* b2 = last ? nB : cB + (size_t)(t + 2) * kstep;
            const char* a3 = a2 + kstep; const char* b3 = b2 + kstep;
            if (last && has_next) S.a_ready(nxt);
            PG8_LDB(B0, 0, 0); PG8_SCHED; PG8_LDA(At, 0, 0); PG8_STAGE(PG8_SA(1, 1), a1 + hstep, voffA);
            PG8_WAIT_L(8); PG8_BAR; PG8_WAIT_L(0); PG8_MMA(0, 0, At, B0); PG8_BAR; PG8_SCHED;
            PG8_LDB(B1, 0, 1); PG8_STAGE(PG8_SB(0, 0), b2, voffB);
            PG8_BAR; PG8_WAIT_L(0); PG8_MMA(0, 1, At, B1); PG8_BAR;
            PG8_LDA(At, 0, 1); PG8_STAGE(PG8_SA(0, 0), a2, voffA);
            PG8_BAR; PG8_WAIT_L(0); PG8_MMA(1, 0, At, B0); PG8_BAR; PG8_SCHED;
            PG8_STAGE(PG8_SB(0, 1), b2 + hstep, voffB);
            PG8_WAIT_V(6); PG8_BAR; PG8_MMA(1, 1, At, B1); PG8_BAR;
            PG8_LDB(B0, 1, 0); PG8_SCHED; PG8_LDA(At, 1, 0); PG8_STAGE(PG8_SA(0, 1), a2 + hstep, voffA);
            PG8_WAIT_L(8); PG8_BAR; PG8_WAIT_L(0); PG8_MMA(0, 0, At, B0); PG8_BAR; PG8_SCHED;
            PG8_LDB(B1, 1, 1); PG8_STAGE(PG8_SB(1, 0), b3, voffB);
            PG8_BAR; PG8_WAIT_L(0); PG8_MMA(0, 1, At, B1); PG8_BAR;
            PG8_LDA(At, 1, 1); PG8_STAGE(PG8_SA(1, 0), a3, voffA);
            PG8_BAR; PG8_WAIT_L(0); PG8_MMA(1, 0, At, B0); PG8_BAR; PG8_SCHED;
            PG8_STAGE(PG8_SB(1, 1), b3 + hstep, voffB);
            PG8_WAIT_V(6); PG8_BAR; PG8_MMA(1, 1, At, B1); PG8_BAR;
        }
        if constexpr (!Epi::AFTER_DRAIN) { E(acc, cur, wr, wc, fr, fq); S.done(cur); }
        if (!has_next) break;
#pragma unroll
        for (int a = 0; a < 2; ++a)
#pragma unroll
            for (int b = 0; b < 2; ++b)
#pragma unroll
                for (int m = 0; m < 4; ++m)
#pragma unroll
                    for (int n = 0; n < 2; ++n) acc[a][b][m][n] = (f32x4){0.f, 0.f, 0.f, 0.f};
        cur = nxt; cA = nA; cB = nB; ++ui;
    }
    PG8_WAIT_V(0);
    if (wr == 0) PG8_BAR;
    PG8_BAR;
    if constexpr (Epi::AFTER_DRAIN) { E.fused(acc, cur, wr, wc, fr, fq, lds, wid, lane); S.done(cur); }
#undef PG8_SA
#undef PG8_SB
#undef PG8_STAGE
#undef PG8_LDA
#undef PG8_LDB
#undef PG8_MMA
#undef PG8_WAIT_V
#undef PG8_WAIT_L
#undef PG8_BAR
#undef PG8_SCHED
}
}


#define LAS __attribute__((address_space(3)))
typedef unsigned short bf16_t;
typedef short bf16x8 __attribute__((ext_vector_type(8)));
typedef short s16x4 __attribute__((ext_vector_type(4)));
typedef float f32x4 __attribute__((ext_vector_type(4)));
typedef float f32x16 __attribute__((ext_vector_type(16)));
typedef unsigned u32x4 __attribute__((ext_vector_type(4)));
typedef unsigned u32x2 __attribute__((ext_vector_type(2)));

constexpr int D = 1024, MP = 8192, MS = 32768, M = 40960, NZ = 3584;
constexpr int ZQ = 0, ZF = 512, ZV = 1536, ZGA = 2048, ZU = 2560, ZGB = 3072;
constexpr float EPS = 1e-6f;
constexpr size_t MiB = 1u << 20;
constexpr size_t WS_MOD = 1 * MiB;
constexpr size_t WS_BSEG = 1 * MiB + 512 * 1024;
constexpr size_t WS_WIN_E = 2 * MiB;
constexpr size_t WS_WOUT_E = 10 * MiB;
constexpr size_t WS_WGLU = 12 * MiB;
constexpr size_t WS_WIN_O = 13 * MiB;
constexpr size_t WS_WOUT_O = 21 * MiB;
constexpr size_t WS_XLOC = 23 * MiB;
constexpr size_t WS_H = 32 * MiB;
constexpr size_t WS_Z = 112 * MiB;
constexpr size_t WS_A2 = 392 * MiB;
constexpr size_t WS_YBF = 472 * MiB;
constexpr size_t WS_END = 512 * MiB;
constexpr size_t OUT_YS = (size_t)MP * D, OUT_SH = (size_t)M * D, OUT_SRE = OUT_SH + 32 * 2 * 4 * 128 * 128, OUT_SIM = OUT_SRE + 32 * 2 * 32 * 64;

struct Params { const float* in[29]; float* out; unsigned char* ws; int ph_lo, ph_hi, li, pad; };
enum { I_XP = 0, I_XS, I_SH, I_SRE, I_SIM, I_C, I_CCTX, I_NORMG, I_WMOD, I_BMOD, I_WINE, I_WOUTE, I_LB, I_HG, I_LRE, I_LIM, I_LDT, I_BRE, I_BIM, I_CRE, I_CIM, I_S5D, I_WGLU, I_BGLU, I_WINO, I_WOUTO, I_CW, I_CB, I_FNG };

__device__ __forceinline__ float bf2f(unsigned x) { return __uint_as_float(x << 16); }
__device__ __forceinline__ float bflo(unsigned w) { return __uint_as_float(w << 16); }
__device__ __forceinline__ float bfhi(unsigned w) { return __uint_as_float(w & 0xffff0000u); }
typedef __bf16 bf16v2 __attribute__((ext_vector_type(2)));
__device__ __forceinline__ unsigned pk2(float lo, float hi) { bf16v2 v; v[0] = (__bf16)lo; v[1] = (__bf16)hi; return __builtin_bit_cast(unsigned, v); }
__device__ __forceinline__ float fsigmoid(float x) { return __builtin_amdgcn_rcpf(1.0f + __expf(-x)); }
__device__ __forceinline__ float fsilu(float x) { return x * fsigmoid(x); }
__device__ __forceinline__ float wave_sum(float v) {
#pragma unroll
    for (int o = 1; o < 64; o <<= 1) v += __shfl_xor(v, o);
    return v;
}
__device__ __forceinline__ void unpack8(const u32x4 w, float (&f)[8]) {
    f[0] = bflo(w.x); f[1] = bfhi(w.x); f[2] = bflo(w.y); f[3] = bfhi(w.y); f[4] = bflo(w.z); f[5] = bfhi(w.z); f[6] = bflo(w.w); f[7] = bfhi(w.w);
}
__device__ __forceinline__ u32x4 pack8(const float (&f)[8]) { u32x4 w; w.x = pk2(f[0], f[1]); w.y = pk2(f[2], f[3]); w.z = pk2(f[4], f[5]); w.w = pk2(f[6], f[7]); return w; }
#define LDS_WAIT() asm volatile("s_waitcnt lgkmcnt(0)" ::: "memory")

using pg8::Unit; using pg8::HALF; using pg8::BM;
struct EpiZ {
    static constexpr bool PERM = true, AFTER_DRAIN = false;
    bf16_t* Z; const float* lbl;
    __device__ __forceinline__ void operator()(const f32x4 (&acc)[2][2][4][2], const Unit& u, int wr, int wc, int fr, int fq) const {
        const int row0 = u.pm * BM + wr * 64 + fr, col0 = u.pn * BM + wc * 32 + 8 * fq, type = u.pn >> 1;
        float lb[2][8];
        if (type == 1 || type == 2) {
#pragma unroll
            for (int bj = 0; bj < 2; ++bj)
#pragma unroll
                for (int e = 0; e < 8; ++e) { const int c = (col0 + bj * HALF + e) & 511; lb[bj][e] = __builtin_amdgcn_rcpf(1.0f + __expf(lbl[512 + c] - lbl[c])); }
        }
#pragma unroll
        for (int ai = 0; ai < 2; ++ai)
#pragma unroll
            for (int m = 0; m < 4; ++m) { bf16_t* rowp = Z + (size_t)(row0 + ai * HALF + m * 16) * NZ + col0;
#pragma unroll
                for (int bj = 0; bj < 2; ++bj) { float v[8];
#pragma unroll
                    for (int e = 0; e < 4; ++e) { v[e] = acc[ai][bj][m][0][e]; v[4 + e] = acc[ai][bj][m][1][e]; }
                    if (type == 1 || type == 2) {
#pragma unroll
                        for (int e = 0; e < 8; ++e) v[e] = __logf(lb[bj][e] + (1.0f - lb[bj][e]) * fsigmoid(v[e]));
                    } else if (type == 4 || type == 6) {
#pragma unroll
                        for (int e = 0; e < 8; ++e) v[e] = fsilu(v[e]);
                    }
                    *(u32x4*)(rowp + bj * HALF) = pack8(v); } }
    }
};
struct EpiGlu {
    static constexpr bool PERM = true, AFTER_DRAIN = false;
    const bf16_t* Y; const bf16_t* Z; const float* bglu; bf16_t* A2;
    __device__ __forceinline__ void operator()(const f32x4 (&acc)[2][2][4][2], const Unit& u, int wr, int wc, int fr, int fq) const {
        const int row0 = u.pm * BM + wr * 64 + fr, col0 = u.pn * BM + wc * 32 + 8 * fq;
        float bv[2][8];
#pragma unroll
        for (int bj = 0; bj < 2; ++bj)
#pragma unroll
            for (int e = 0; e < 8; ++e) bv[bj][e] = bglu[col0 + bj * HALF + e];
#pragma unroll
        for (int ai = 0; ai < 2; ++ai)
#pragma unroll
            for (int m = 0; m < 4; ++m) { const size_t row = (size_t)(row0 + ai * HALF + m * 16);
#pragma unroll
                for (int bj = 0; bj < 2; ++bj) { const int col = col0 + bj * HALF; float y[8], sg[8], o[8];
                    unpack8(*(const u32x4*)(Y + row * 512 + col), y); unpack8(*(const u32x4*)(Z + row * NZ + ZGB + col), sg);
#pragma unroll
                    for (int e = 0; e < 8; ++e) { const float a = (e < 4 ? acc[ai][bj][m][0][e] : acc[ai][bj][m][1][e - 4]) + bv[bj][e]; o[e] = y[e] * fsigmoid(a) * sg[e]; }
                    *(u32x4*)(A2 + row * 1024 + 512 + col) = pack8(o); } }
    }
};
struct EpiRes {
    static constexpr bool PERM = false, AFTER_DRAIN = false;
    const float* base_p; const float* base_s; const float* gate; float* out;
    __device__ __forceinline__ void operator()(const f32x4 (&acc)[2][2][4][2], const Unit& u, int wr, int wc, int fr, int fq) const {
        const int rowt = u.pm * BM, row0 = rowt + wr * 64 + fr, col0 = u.pn * BM + wc * 32 + 4 * fq;
        const int n = rowt < MP ? 0 : 1 + ((rowt - MP) >> 12);
        const float* base = rowt < MP ? base_p : base_s - (size_t)MP * D;
        f32x4 gv[2][2];
#pragma unroll
        for (int bj = 0; bj < 2; ++bj)
#pragma unroll
            for (int nn = 0; nn < 2; ++nn) gv[bj][nn] = *(const f32x4*)(gate + n * 3072 + col0 + bj * HALF + nn * 16);
#pragma unroll
        for (int ai = 0; ai < 2; ++ai)
#pragma unroll
            for (int m = 0; m < 4; ++m) { const size_t off = (size_t)(row0 + ai * HALF + m * 16) * D + col0;
#pragma unroll
                for (int bj = 0; bj < 2; ++bj)
#pragma unroll
                    for (int nn = 0; nn < 2; ++nn) { const f32x4 b = *(const f32x4*)(base + off + bj * HALF + nn * 16);
                        *(f32x4*)(out + off + bj * HALF + nn * 16) = b + gv[bj][nn] * acc[ai][bj][m][nn]; } }
    }
};
struct EpiOdd {
    static constexpr bool PERM = false, AFTER_DRAIN = false;
    bf16_t* PB; bf16_t* GB;
    __device__ __forceinline__ void operator()(const f32x4 (&acc)[2][2][4][2], const Unit& u, int wr, int wc, int fr, int fq) const {
        const int row0 = u.pm * BM + wr * 64 + fr, ch0 = u.pn * 64 + 16 * wc + 4 * fq;
#pragma unroll
        for (int ai = 0; ai < 2; ++ai)
#pragma unroll
            for (int m = 0; m < 4; ++m) { const size_t off = (size_t)(row0 + ai * HALF + m * 16) * D + ch0;
                const f32x4 bg = acc[ai][0][m][0], cgv = acc[ai][0][m][1], vv = acc[ai][1][m][0], gg = acc[ai][1][m][1];
                const f32x4 p = cgv * vv; f32x4 g;
#pragma unroll
                for (int e = 0; e < 4; ++e) g[e] = bg[e] * fsilu(gg[e]);
                u32x2 wp, wg; wp.x = pk2(p[0], p[1]); wp.y = pk2(p[2], p[3]); wg.x = pk2(g[0], g[1]); wg.y = pk2(g[2], g[3]);
                *(u32x2*)(PB + off) = wp; *(u32x2*)(GB + off) = wg; }
    }
};

template <int MODE>
__device__ __forceinline__ void transpose_item(const float* W, int K, int N, bf16_t* WT, LAS float* scr, int item, int lane) {
    const int nblk = N / 32, kb = item / nblk, nb = item % nblk, k0 = 64 * kb, n0 = 32 * nb;
#pragma unroll 8
    for (int i = 0; i < 32; ++i) { const int kk = 2 * i + (lane >> 5); scr[kk * 33 + (lane & 31)] = W[(size_t)(k0 + kk) * N + n0 + (lane & 31)]; }
    LDS_WAIT();
    const int c = lane & 7;
#pragma unroll
    for (int j = 0; j < 4; ++j) { const int n = (lane >> 3) + 8 * j; const LAS float* s = scr + (8 * c) * 33 + n;
        u32x4 o; o.x = pk2(s[0 * 33], s[1 * 33]); o.y = pk2(s[2 * 33], s[3 * 33]); o.z = pk2(s[4 * 33], s[5 * 33]); o.w = pk2(s[6 * 33], s[7 * 33]);
        int dn = n0 + n;
        if (MODE == 1) { const int blk = dn >> 10, rem = dn & 1023, tile = rem >> 6, ch = rem & 63; dn = tile * 256 + 128 * (blk >> 1) + 32 * (ch >> 4) + 16 * (blk & 1) + (ch & 15); }
        *(u32x4*)(WT + (size_t)dn * K + k0 + 8 * c) = o; }
    LDS_WAIT();
}
__device__ __forceinline__ void phase0(const Params& P, LAS unsigned char* lds) {
    const int tid = threadIdx.x, lane = tid & 63, wave = tid >> 6;
    float* MOD = (float*)(P.ws + WS_MOD);
    if (blockIdx.x < 96) {
        LAS float* sc = (LAS float*)lds;
        LAS float* red = (LAS float*)(lds + 36864);
        for (int i = tid; i < 9 * 1024; i += 512) { const int n = i >> 10, k = i & 1023; const float c = n == 0 ? P.in[I_CCTX][k] : P.in[I_C][(n - 1) * 1024 + k]; sc[i] = fsilu(c); }
        __syncthreads();
        for (int item = blockIdx.x; item < 96; item += gridDim.x) {
            const int l = item / 48, jb = item % 48;
            const float* W = P.in[I_WMOD] + (size_t)l * 1024 * 3072 + jb * 64 + lane;
            float acc[9];
#pragma unroll
            for (int n = 0; n < 9; ++n) acc[n] = 0.f;
            for (int kk = 0; kk < 128; kk += 4) { const int k = wave * 128 + kk;
                const float w0 = W[(size_t)k * 3072], w1 = W[(size_t)(k + 1) * 3072], w2 = W[(size_t)(k + 2) * 3072], w3 = W[(size_t)(k + 3) * 3072];
#pragma unroll
                for (int n = 0; n < 9; ++n) { const f32x4 s = *(const LAS f32x4*)(sc + n * 1024 + k); acc[n] += s[0] * w0 + s[1] * w1 + s[2] * w2 + s[3] * w3; } }
#pragma unroll
            for (int n = 0; n < 9; ++n) red[(wave * 9 + n) * 64 + lane] = acc[n];
            __syncthreads();
            for (int i = tid; i < 576; i += 512) { const int n = i >> 6, jj = i & 63; float s = 0.f;
#pragma unroll
                for (int w = 0; w < 8; ++w) s += red[(w * 9 + n) * 64 + jj];
                MOD[(l * 9 + n) * 3072 + jb * 64 + jj] = s + P.in[I_BMOD][l * 3072 + jb * 64 + jj]; }
            __syncthreads();
        }
    }
    __syncthreads();
    LAS float* scr = (LAS float*)(lds + wave * 8448);
    const int gw = blockIdx.x * 8 + wave, NGW = gridDim.x * 8;
    constexpr int I1 = 16 * 112, I2 = 16 * 32, I3 = 8 * 16, I4 = 16 * 128, I5 = 16 * 32;
    for (int it = gw; it < I1 + I2 + I3 + I4 + I5; it += NGW) {
        int r = it;
        if (r < I1) { transpose_item<0>(P.in[I_WINE], 1024, 3584, (bf16_t*)(P.ws + WS_WIN_E), scr, r, lane); continue; } r -= I1;
        if (r < I2) { transpose_item<0>(P.in[I_WOUTE], 1024, 1024, (bf16_t*)(P.ws + WS_WOUT_E), scr, r, lane); continue; } r -= I2;
        if (r < I3) { transpose_item<0>(P.in[I_WGLU], 512, 512, (bf16_t*)(P.ws + WS_WGLU), scr, r, lane); continue; } r -= I3;
        if (r < I4) { transpose_item<1>(P.in[I_WINO], 1024, 4096, (bf16_t*)(P.ws + WS_WIN_O), scr, r, lane); continue; } r -= I4;
        transpose_item<0>(P.in[I_WOUTO], 1024, 1024, (bf16_t*)(P.ws + WS_WOUT_O), scr, r, lane);
    }
}

__device__ __forceinline__ void phase_norm(const float* xp, const float* xs, const float* ng, const float* mod, bf16_t* H) {
    const int lane = threadIdx.x & 63, gw = blockIdx.x * 8 + (threadIdx.x >> 6), NGW = gridDim.x * 8;
    for (int m = gw; m < M; m += NGW) {
        const float* xr = m < MP ? xp + (size_t)m * D : xs + (size_t)(m - MP) * D; const int n = m < MP ? 0 : 1 + ((m - MP) >> 12);
        f32x4 v[4]; float ss = 0.f;
#pragma unroll
        for (int j = 0; j < 4; ++j) { v[j] = *(const f32x4*)(xr + 4 * lane + 256 * j); ss += (v[j][0] * v[j][0] + v[j][1] * v[j][1]) + (v[j][2] * v[j][2] + v[j][3] * v[j][3]); }
        const float rstd = rsqrtf(wave_sum(ss) * (1.0f / D) + EPS);
#pragma unroll
        for (int j = 0; j < 4; ++j) { const int col = 4 * lane + 256 * j;
            const f32x4 g = *(const f32x4*)(ng + col), sh = *(const f32x4*)(mod + n * 3072 + col), sc = *(const f32x4*)(mod + n * 3072 + 1024 + col);
            const f32x4 y = v[j] * rstd * g * (sc + 1.0f) + sh;
            u32x2 w; w.x = pk2(y[0], y[1]); w.y = pk2(y[2], y[3]); *(u32x2*)(H + (size_t)m * D + col) = w; }
    }
}
__device__ __forceinline__ void phase_final_norm(float* out, const float* g) {
    const int lane = threadIdx.x & 63, gw = blockIdx.x * 8 + (threadIdx.x >> 6), NGW = gridDim.x * 8;
    for (int m = gw; m < M; m += NGW) { float* xr = out + (size_t)m * D;
        f32x4 v[4]; float ss = 0.f;
#pragma unroll
        for (int j = 0; j < 4; ++j) { v[j] = *(const f32x4*)(xr + 4 * lane + 256 * j); ss += (v[j][0] * v[j][0] + v[j][1] * v[j][1]) + (v[j][2] * v[j][2] + v[j][3] * v[j][3]); }
        const float rstd = rsqrtf(wave_sum(ss) * (1.0f / D) + EPS);
#pragma unroll
        for (int j = 0; j < 4; ++j) { const int col = 4 * lane + 256 * j; *(f32x4*)(xr + col) = v[j] * rstd * *(const f32x4*)(g + col); }
    }
}

constexpr int HG_QP = 272, HG_SP = 144;
constexpr int HG_Q = 0, HG_K = 17408, HG_KT = 34816, HG_VT = 53248, HG_P = 71680, HG_ST = 80896, HG_TAB = 115712;
__device__ __forceinline__ int seg_rowbase(int sg) { return sg < 32 ? sg * 256 : MP + (sg - 32) * 256; }
#define MFMA16(a, b, c) __builtin_amdgcn_mfma_f32_16x16x32_bf16((a), (b), (c), 0, 0, 0)
#define MFMA32(a, b, c) __builtin_amdgcn_mfma_f32_32x32x16_bf16((a), (b), (c), 0, 0, 0)

template <bool PASS2>
__device__ __forceinline__ void hgrn_task(const Params& P, LAS unsigned char* lds, int task) {
    const int tid = threadIdx.x, lane = tid & 63, w = __builtin_amdgcn_readfirstlane(tid >> 6), col = lane & 15, quad = lane >> 4;
    const int ch = tid & 127, qt = tid >> 7;
    const int d = task & 1, h = (task >> 1) & 3, sg = PASS2 ? (task >> 3) : 32 + (task >> 3);
    const int rowbase = seg_rowbase(sg), slot = ((sg - 32) << 3) | (h << 1) | d;
    const bf16_t* Z = (const bf16_t*)(P.ws + WS_Z);
    float* SLOC = (float*)(P.ws + WS_A2); float* BSEG = (float*)(P.ws + WS_BSEG);
    bf16_t* OB = (bf16_t*)(P.ws + WS_H) + (size_t)d * M * 512;
    LAS float* qtot = (LAS float*)(lds + HG_TAB); LAS float* ebm = qtot + 512; LAS float* e2t = qtot + 640;
    f32x4 S[8];
#pragma unroll
    for (int vt = 0; vt < 8; ++vt) {
        if (PASS2 && sg >= 32) {
#pragma unroll
            for (int j = 0; j < 4; ++j) S[vt][j] = SLOC[(size_t)slot * 16384 + (16 * w + 4 * quad + j) * 128 + 16 * vt + col];
        } else S[vt] = (f32x4){0.f, 0.f, 0.f, 0.f};
    }
    float bsum = 0.f;
    unsigned nlf[16], nv[16], nq[16];
#define HG_LOAD(cc) do { _Pragma("unroll") for (int e = 0; e < 16; ++e) { const int pos = 64 * (cc) + 16 * qt + e; const int row = rowbase + (d ? 255 - pos : pos); \
            const bf16_t* zr = Z + (size_t)row * NZ + 128 * h + ch; nlf[e] = zr[ZF + 512 * d]; nv[e] = zr[ZV]; if (PASS2) nq[e] = zr[ZQ]; } } while (0)
    HG_LOAD(0);
    for (int c = 0; c < 4; ++c) {
        float lf[16], cs[16], qq[16]; unsigned vraw[16];
#pragma unroll
        for (int e = 0; e < 16; ++e) { lf[e] = bf2f(nlf[e]); vraw[e] = nv[e]; if (PASS2) qq[e] = bf2f(nq[e]); }
        { float run = 0.f;
#pragma unroll
          for (int e = 0; e < 16; ++e) { run += lf[e]; cs[e] = run; } }
        qtot[qt * 128 + ch] = cs[15];
        __syncthreads();
        const float t0 = qtot[ch], t1 = qtot[128 + ch], t2 = qtot[256 + ch], t3 = qtot[384 + ch];
        const float off = qt == 0 ? 0.f : (qt == 1 ? t0 : (qt == 2 ? t0 + t1 : t0 + t1 + t2));
        const float bmid = t0 + t1, blast = (t0 + t1) + (t2 + t3);
        unsigned ktp[8], vtp[8];
#pragma unroll
        for (int e = 0; e < 16; e += 2) {
            float kt[2];
#pragma unroll
            for (int z = 0; z < 2; ++z) { const float b = off + cs[e + z]; const float kk = 1.0f - __expf(lf[e + z]); kt[z] = kk * __expf(fminf(bmid - b, 80.f));
                if (PASS2) { const int i = 16 * qt + e + z; const float qv = qq[e + z] * __expf(b - bmid);
                    *(LAS bf16_t*)(lds + HG_Q + i * HG_QP + ch * 2) = (bf16_t)(pk2(qv, 0.f) & 0xffffu);
                    *(LAS bf16_t*)(lds + HG_K + i * HG_QP + ch * 2) = (bf16_t)(pk2(kt[z], 0.f) & 0xffffu); } }
            ktp[e >> 1] = pk2(kt[0], kt[1]); vtp[e >> 1] = vraw[e] | (vraw[e + 1] << 16);
        }
        *(LAS u32x4*)(lds + HG_KT + ch * HG_SP + qt * 32) = (u32x4){ktp[0], ktp[1], ktp[2], ktp[3]};
        *(LAS u32x4*)(lds + HG_KT + ch * HG_SP + qt * 32 + 16) = (u32x4){ktp[4], ktp[5], ktp[6], ktp[7]};
        *(LAS u32x4*)(lds + HG_VT + ch * HG_SP + qt * 32) = (u32x4){vtp[0], vtp[1], vtp[2], vtp[3]};
        *(LAS u32x4*)(lds + HG_VT + ch * HG_SP + qt * 32 + 16) = (u32x4){vtp[4], vtp[5], vtp[6], vtp[7]};
        if (qt == 0) { ebm[ch] = __expf(bmid); e2t[ch] = __expf(blast - bmid); bsum += blast; }
        __syncthreads();
        if (c < 3) HG_LOAD(c + 1);
        const f32x4 eb = *(const LAS f32x4*)(ebm + 16 * w + 4 * quad), e2v = *(const LAS f32x4*)(e2t + 16 * w + 4 * quad);
#pragma unroll
        for (int vt = 0; vt < 8; ++vt) { S[vt] = S[vt] * eb;
            if (PASS2) { u32x2 sw; sw.x = pk2(S[vt][0], S[vt][1]); sw.y = pk2(S[vt][2], S[vt][3]);
                *(LAS u32x2*)(lds + HG_ST + (16 * vt + col) * HG_QP + (16 * w + 4 * quad) * 2) = sw; } }
        if (PASS2) {
#pragma unroll
            for (int ti = 0; ti < 2; ++ti) { const int id = 2 * w + ti, st = id >> 2, tt = id & 3;
                f32x4 ap = (f32x4){0.f, 0.f, 0.f, 0.f};
                if (st <= tt) {
#pragma unroll
                    for (int ks = 0; ks < 4; ++ks) { const bf16x8 a = *(const LAS bf16x8*)(lds + HG_K + (16 * st + col) * HG_QP + ks * 64 + quad * 16);
                        const bf16x8 b = *(const LAS bf16x8*)(lds + HG_Q + (16 * tt + col) * HG_QP + ks * 64 + quad * 16); ap = MFMA16(a, b, ap); }
                    const int tpos = 16 * tt + col, s0 = 16 * st + 4 * quad;
#pragma unroll
                    for (int j = 0; j < 4; ++j) ap[j] = (s0 + j <= tpos) ? ap[j] : 0.f;
                }
                u32x2 pw; pw.x = pk2(ap[0], ap[1]); pw.y = pk2(ap[2], ap[3]);
                *(LAS u32x2*)(lds + HG_P + (16 * tt + col) * HG_SP + (16 * st + 4 * quad) * 2) = pw; }
        }
        __syncthreads();
        if (PASS2) { const int tt = w >> 1;
#pragma unroll
            for (int vi = 0; vi < 4; ++vi) { const int vt = 4 * (w & 1) + vi; f32x4 ao = (f32x4){0.f, 0.f, 0.f, 0.f};
#pragma unroll
                for (int ks = 0; ks < 2; ++ks) { const bf16x8 a = *(const LAS bf16x8*)(lds + HG_VT + (16 * vt + col) * HG_SP + ks * 64 + quad * 16);
                    const bf16x8 b = *(const LAS bf16x8*)(lds + HG_P + (16 * tt + col) * HG_SP + ks * 64 + quad * 16); ao = MFMA16(a, b, ao); }
#pragma unroll
                for (int ks = 0; ks < 4; ++ks) { const bf16x8 a = *(const LAS bf16x8*)(lds + HG_ST + (16 * vt + col) * HG_QP + ks * 64 + quad * 16);
                    const bf16x8 b = *(const LAS bf16x8*)(lds + HG_Q + (16 * tt + col) * HG_QP + ks * 64 + quad * 16); ao = MFMA16(a, b, ao); }
                const int pos = 64 * c + 16 * tt + col; const int row = rowbase + (d ? 255 - pos : pos);
                u32x2 ow; ow.x = pk2(ao[0], ao[1]); ow.y = pk2(ao[2], ao[3]);
                *(u32x2*)(OB + (size_t)row * 512 + 128 * h + 16 * vt + 4 * quad) = ow; }
        }
#pragma unroll
        for (int vt = 0; vt < 8; ++vt) {
#pragma unroll
            for (int ks = 0; ks < 2; ++ks) { const bf16x8 a = *(const LAS bf16x8*)(lds + HG_KT + (16 * w + col) * HG_SP + ks * 64 + quad * 16);
                const bf16x8 b = *(const LAS bf16x8*)(lds + HG_VT + (16 * vt + col) * HG_SP + ks * 64 + quad * 16); S[vt] = MFMA16(a, b, S[vt]); }
            S[vt] = S[vt] * e2v; }
    }
#undef HG_LOAD
    if (!PASS2) {
#pragma unroll
        for (int vt = 0; vt < 8; ++vt)
#pragma unroll
            for (int j = 0; j < 4; ++j) SLOC[(size_t)slot * 16384 + (16 * w + 4 * quad + j) * 128 + 16 * vt + col] = S[vt][j];
        if (qt == 0) BSEG[slot * 128 + ch] = bsum;
    } else if (sg < 32) {
        float* o = P.out + OUT_SH + (size_t)((sg * 2 + d) * 4 + h) * 16384;
#pragma unroll
        for (int vt = 0; vt < 8; ++vt)
#pragma unroll
            for (int j = 0; j < 4; ++j) o[(16 * w + 4 * quad + j) * 128 + 16 * vt + col] = S[vt][j];
    }
    __syncthreads();
}
__device__ __forceinline__ void hgrn_carry(const Params& P) {
    float* SLOC = (float*)(P.ws + WS_A2); const float* BSEG = (const float*)(P.ws + WS_BSEG);
    const int gt = blockIdx.x * 512 + threadIdx.x, NT = gridDim.x * 512;
    for (int idx = gt; idx < 64 * 16384; idx += NT) { const int chain = idx >> 14, e = idx & 16383, b = chain >> 3, h = (chain >> 1) & 3, d = chain & 1, k = e >> 7;
        float run = P.in[I_SH][(size_t)((b * 2 + d) * 4 + h) * 16384 + e];
        for (int jj = 0; jj < 16; ++jj) { const int ks = d ? 15 - jj : jj; const int slot = ((b * 16 + ks) << 3) | (h << 1) | d;
            const float tmp = SLOC[(size_t)slot * 16384 + e]; SLOC[(size_t)slot * 16384 + e] = run; run = __expf(BSEG[slot * 128 + k]) * run + tmp; } }
}

template <bool PASS2>
__device__ __forceinline__ void s5_task(const Params& P, LAS unsigned char* img, int task) {
    const int lane = threadIdx.x & 63, n = lane & 31, hh = lane >> 5;
    const int d = task & 1, g = (task >> 1) & 31, pr = task >> 6;
    const int segA = PASS2 ? 2 * pr : 32 + 2 * pr, myseg = segA + hh;
    const bf16_t* Z = (const bf16_t*)(P.ws + WS_Z);
    float* XLOC = (float*)(P.ws + WS_XLOC);
    const int dg = d * 32 + g;
    const float dt = __expf(P.in[I_LDT][dg]);
    float lr[2], li[2], xr[2], xi[2]; bf16x8 Bf[4], Cf[4][2];
    float cre[2], cim[2];
#pragma unroll
    for (int pp = 0; pp < 2; ++pp) { const int p = 32 * pp + n; const float lre = P.in[I_LRE][dg * 64 + p], lim = P.in[I_LIM][dg * 64 + p];
        const float mag = expf(lre * dt); float sn, cs; sincosf(lim * dt, &sn, &cs); lr[pp] = mag * cs; li[pp] = mag * sn;
        const float den = lre * lre + lim * lim; cre[pp] = ((lr[pp] - 1.0f) * lre + li[pp] * lim) / den; cim[pp] = (li[pp] * lre - (lr[pp] - 1.0f) * lim) / den; }
#pragma unroll
    for (int jt = 0; jt < 4; ++jt) { const int pp = jt & 1, part = jt >> 1, p = 32 * pp + n; float v[8];
        const float* br = P.in[I_BRE] + (size_t)(dg * 64 + p) * 16 + 8 * hh; const float* bi = P.in[I_BIM] + (size_t)(dg * 64 + p) * 16 + 8 * hh;
#pragma unroll
        for (int j = 0; j < 8; ++j) v[j] = part ? (cre[pp] * bi[j] + cim[pp] * br[j]) : (cre[pp] * br[j] - cim[pp] * bi[j]);
        Bf[jt] = __builtin_bit_cast(bf16x8, pack8(v)); }
    if (PASS2) {
#pragma unroll
        for (int jt = 0; jt < 4; ++jt)
#pragma unroll
            for (int s = 0; s < 2; ++s) { const int part = jt >> 1, p0 = 32 * (jt & 1) + 16 * s + 8 * hh; float v[8];
                const float* cp = (part ? P.in[I_CIM] : P.in[I_CRE]) + (size_t)(dg * 16 + (n & 15)) * 64 + p0;
#pragma unroll
                for (int j = 0; j < 8; ++j) { const float c = cp[j]; v[j] = n < 16 ? (part ? -c : c) : 0.f; }
                Cf[jt][s] = __builtin_bit_cast(bf16x8, pack8(v)); }
    }
#pragma unroll
    for (int pp = 0; pp < 2; ++pp) { xr[pp] = 0.f; xi[pp] = 0.f; }
    if (PASS2 && myseg >= 32) { const int sb = (myseg - 32) >> 4, sk = (myseg - 32) & 15;
#pragma unroll
        for (int pp = 0; pp < 2; ++pp) { const int p = 32 * pp + n;
            float ar = lr[pp], ai = li[pp];
#pragma unroll
            for (int q = 0; q < 8; ++q) { const float nr = ar * ar - ai * ai, ni = 2.0f * ar * ai; ar = nr; ai = ni; }
            float sr = P.in[I_SRE][(size_t)((sb * 2 + d) * 32 + g) * 64 + p], si = P.in[I_SIM][(size_t)((sb * 2 + d) * 32 + g) * 64 + p];
            const int cnt = d ? 15 - sk : sk;
            for (int jj = 0; jj < cnt; ++jj) { const int ks = d ? 15 - jj : jj; const float* xl = XLOC + (size_t)(((sb * 16 + ks) * 32 + g) * 2 + d) * 128;
                const float nr = ar * sr - ai * si + xl[p], ni = ar * si + ai * sr + xl[64 + p]; sr = nr; si = ni; }
            xr[pp] = sr; xi[pp] = si; }
    }
    const int arow_seg = segA + ((n >> 2) & 1), arow_pos = (n & 3) + 4 * (n >> 3);
    const int abase = seg_rowbase(arow_seg), mybase = seg_rowbase(myseg);
    bf16_t* YD = (bf16_t*)P.out + (size_t)d * M * 512;
    const unsigned ibase = (unsigned)(uintptr_t)img;
    const int i16 = lane & 15, q4 = i16 >> 2, p4 = i16 & 3, blk = (lane >> 4) & 1;
    const bf16_t* zu = Z + ZU + g * 16 + 8 * hh;
    bf16x8 aq[4];
#pragma unroll
    for (int u = 0; u < 4; ++u) { const int apos = 16 * u + arow_pos; aq[u] = *(const bf16x8*)(zu + (size_t)(abase + (d ? 255 - apos : apos)) * NZ); }
#pragma nounroll
    for (int tl = 0; tl < 16; ++tl) {
        const bf16x8 a = aq[0];
        aq[0] = aq[1]; aq[1] = aq[2]; aq[2] = aq[3];
        { const int apos = 16 * (tl < 12 ? tl + 4 : 15) + arow_pos; aq[3] = *(const bf16x8*)(zu + (size_t)(abase + (d ? 255 - apos : apos)) * NZ); }
        f32x16 bu[4];
#pragma unroll
        for (int jt = 0; jt < 4; ++jt) { f32x16 z;
#pragma unroll
            for (int i = 0; i < 16; ++i) z[i] = 0.f;
            bu[jt] = MFMA32(a, Bf[jt], z); }
        asm volatile("s_nop 15" : "+v"(bu[0]), "+v"(bu[1]), "+v"(bu[2]), "+v"(bu[3]));
#pragma unroll
        for (int i = 0; i < 16; ++i)
#pragma unroll
            for (int pp = 0; pp < 2; ++pp) { const float nr = lr[pp] * xr[pp] - li[pp] * xi[pp] + bu[pp][i], ni = lr[pp] * xi[pp] + li[pp] * xr[pp] + bu[2 + pp][i];
                xr[pp] = nr; xi[pp] = ni; bu[pp][i] = nr; bu[2 + pp][i] = ni; }
        if (PASS2) {
#pragma unroll
            for (int jt = 0; jt < 4; ++jt)
#pragma unroll
                for (int g4 = 0; g4 < 4; ++g4) { u32x2 v; v.x = pk2(bu[jt][4 * g4], bu[jt][4 * g4 + 1]); v.y = pk2(bu[jt][4 * g4 + 2], bu[jt][4 * g4 + 3]);
                    *(LAS u32x2*)(img + jt * 2048 + n * 64 + 8 * (2 * g4 + hh)) = v; }
            LDS_WAIT();
            f32x16 y0, y1;
#pragma unroll
            for (int i = 0; i < 16; ++i) { y0[i] = 0.f; y1[i] = 0.f; }
            s16x4 r[16];
            { const unsigned b0 = ibase + 8 * (4 * blk + p4) + (8 * hh + q4) * 64;
              asm volatile("ds_read_b64_tr_b16 %0, %16\n\tds_read_b64_tr_b16 %1, %16 offset:256\n\tds_read_b64_tr_b16 %2, %16 offset:1024\n\tds_read_b64_tr_b16 %3, %16 offset:1280\n\t"
                           "ds_read_b64_tr_b16 %4, %16 offset:2048\n\tds_read_b64_tr_b16 %5, %16 offset:2304\n\tds_read_b64_tr_b16 %6, %16 offset:3072\n\tds_read_b64_tr_b16 %7, %16 offset:3328\n\t"
                           "ds_read_b64_tr_b16 %8, %16 offset:4096\n\tds_read_b64_tr_b16 %9, %16 offset:4352\n\tds_read_b64_tr_b16 %10, %16 offset:5120\n\tds_read_b64_tr_b16 %11, %16 offset:5376\n\t"
                           "ds_read_b64_tr_b16 %12, %16 offset:6144\n\tds_read_b64_tr_b16 %13, %16 offset:6400\n\tds_read_b64_tr_b16 %14, %16 offset:7168\n\tds_read_b64_tr_b16 %15, %16 offset:7424\n\ts_waitcnt lgkmcnt(0)"
                           : "=&v"(r[0]), "=&v"(r[1]), "=&v"(r[2]), "=&v"(r[3]), "=&v"(r[4]), "=&v"(r[5]), "=&v"(r[6]), "=&v"(r[7]),
                             "=&v"(r[8]), "=&v"(r[9]), "=&v"(r[10]), "=&v"(r[11]), "=&v"(r[12]), "=&v"(r[13]), "=&v"(r[14]), "=&v"(r[15])
                           : "v"(b0) : "memory"); }
#pragma unroll
            for (int jt = 0; jt < 4; ++jt) {
                const bf16x8 xa0 = __builtin_shufflevector(r[4 * jt], r[4 * jt + 1], 0, 1, 2, 3, 4, 5, 6, 7), xa1 = __builtin_shufflevector(r[4 * jt + 2], r[4 * jt + 3], 0, 1, 2, 3, 4, 5, 6, 7);
                y0 = MFMA32(Cf[jt][0], xa0, y0); y1 = MFMA32(Cf[jt][1], xa1, y1); }
            asm volatile("s_nop 15" : "+v"(y0), "+v"(y1));
            { const int ypos = 16 * tl + arow_pos; const int yrow = abase + (d ? 255 - ypos : ypos);
              bf16_t* yp = YD + (size_t)yrow * 512 + g * 16 + 4 * hh;
              u32x2 w0, w1; w0.x = pk2(y0[0] + y1[0], y0[1] + y1[1]); w0.y = pk2(y0[2] + y1[2], y0[3] + y1[3]); w1.x = pk2(y0[4] + y1[4], y0[5] + y1[5]); w1.y = pk2(y0[6] + y1[6], y0[7] + y1[7]);
              *(u32x2*)yp = w0; *(u32x2*)(yp + 8) = w1; }
        }
    }
    if (!PASS2) { float* xl = XLOC + (size_t)(((myseg - 32) * 32 + g) * 2 + d) * 128;
#pragma unroll
        for (int pp = 0; pp < 2; ++pp) { xl[32 * pp + n] = xr[pp]; xl[64 + 32 * pp + n] = xi[pp]; }
    } else if (myseg < 32) {
#pragma unroll
        for (int pp = 0; pp < 2; ++pp) { const size_t o = (size_t)((myseg * 2 + d) * 32 + g) * 64 + 32 * pp + n; P.out[OUT_SRE + o] = xr[pp]; P.out[OUT_SIM + o] = xi[pp]; }
    }
}

__device__ __forceinline__ float fgelu_tanh(float y) { const float z = 0.7978845608f * (y + 0.044715f * y * y * y); const float t = 1.0f - 2.0f * __builtin_amdgcn_rcpf(1.0f + __expf(2.0f * z)); return 0.5f * y * (1.0f + t); }
__device__ __forceinline__ void phase_combine(const Params& P) {
    const int lane = threadIdx.x & 63, gw = blockIdx.x * 8 + (threadIdx.x >> 6), NGW = gridDim.x * 8, c0 = lane * 8;
    const bf16_t* OF = (const bf16_t*)(P.ws + WS_H); const bf16_t* OBk = OF + (size_t)M * 512;
    const bf16_t* YF = (const bf16_t*)P.out; const bf16_t* YB = YF + (size_t)M * 512;
    const bf16_t* Z = (const bf16_t*)(P.ws + WS_Z); bf16_t* A2 = (bf16_t*)(P.ws + WS_A2); bf16_t* YBF = (bf16_t*)(P.ws + WS_YBF);
    float hg[8], dsk[8];
#pragma unroll
    for (int e = 0; e < 8; ++e) { hg[e] = P.in[I_HG][c0 + e]; dsk[e] = P.in[I_S5D][c0 + e]; }
    for (int m = gw; m < M; m += NGW) {
        float a[8], b[8], ga[8], o[8];
        unpack8(*(const u32x4*)(OF + (size_t)m * 512 + c0), a); unpack8(*(const u32x4*)(OBk + (size_t)m * 512 + c0), b); unpack8(*(const u32x4*)(Z + (size_t)m * NZ + ZGA + c0), ga);
        float ss = 0.f;
#pragma unroll
        for (int e = 0; e < 8; ++e) { a[e] += b[e]; ss += a[e] * a[e]; }
        ss += __shfl_xor(ss, 1); ss += __shfl_xor(ss, 2); ss += __shfl_xor(ss, 4); ss += __shfl_xor(ss, 8);
        const float r = rsqrtf(ss * (1.0f / 128.0f) + EPS);
#pragma unroll
        for (int e = 0; e < 8; ++e) o[e] = a[e] * r * hg[e] * ga[e];
        *(u32x4*)(A2 + (size_t)m * 1024 + c0) = pack8(o);
        float yf[8], yb[8], uu[8], y[8];
        unpack8(*(const u32x4*)(YF + (size_t)m * 512 + c0), yf); unpack8(*(const u32x4*)(YB + (size_t)m * 512 + c0), yb); unpack8(*(const u32x4*)(Z + (size_t)m * NZ + ZU + c0), uu);
#pragma unroll
        for (int e = 0; e < 8; ++e) y[e] = fgelu_tanh(yf[e] + yb[e] + dsk[e] * uu[e]);
        *(u32x4*)(YBF + (size_t)m * 512 + c0) = pack8(y);
    }
}
__device__ __forceinline__ void phase_conv(const Params& P) {
    const bf16_t* PB = (const bf16_t*)(P.ws + WS_Z + 160 * MiB); const bf16_t* GB = (const bf16_t*)(P.ws + WS_A2); bf16_t* A3 = (bf16_t*)(P.ws + WS_H);
    const int gt = blockIdx.x * 512 + threadIdx.x, NT = gridDim.x * 512;
    for (int idx = gt; idx < M * 128; idx += NT) { const int row = idx >> 7, c0 = (idx & 127) * 8;
        const int pos = row < MP ? (row & 255) : ((row - MP) & 63), L = row < MP ? 256 : 64;
        float p0[8], p1[8], p2[8], gg[8], o[8];
        const u32x4 zero = (u32x4){0u, 0u, 0u, 0u};
        unpack8(pos > 0 ? *(const u32x4*)(PB + (size_t)(row - 1) * D + c0) : zero, p0);
        unpack8(*(const u32x4*)(PB + (size_t)row * D + c0), p1);
        unpack8(pos < L - 1 ? *(const u32x4*)(PB + (size_t)(row + 1) * D + c0) : zero, p2);
        unpack8(*(const u32x4*)(GB + (size_t)row * D + c0), gg);
        const float* cw = P.in[I_CW] + c0; const float* cb = P.in[I_CB] + c0;
#pragma unroll
        for (int e = 0; e < 8; ++e) o[e] = gg[e] * (cw[e] * p0[e] + cw[1024 + e] * p1[e] + cw[2048 + e] * p2[e] + cb[e]);
        *(u32x4*)(A3 + (size_t)row * D + c0) = pack8(o); }
}

#define XB_TMO      128
#define XB_XCNT(j)  (256  + 64 * (j))
#define XB_XSUB(j)  (1280 + 64 * (j))
#define XB_XGEN(j)  (2304 + 64 * (j))
#define XB_TOP      3328
#define XB_TOPGEN   3392
#define XCD_BAR_WORDS 3456
#define XB_SPIN_CAP (1u << 18)

__device__ __forceinline__ unsigned xb_ld(unsigned* p)              { return __hip_atomic_load(p, __ATOMIC_RELAXED, __HIP_MEMORY_SCOPE_AGENT); }
__device__ __forceinline__ unsigned xb_add(unsigned* p, unsigned v) { return __hip_atomic_fetch_add(p, v, __ATOMIC_RELAXED, __HIP_MEMORY_SCOPE_AGENT); }
__device__ __forceinline__ unsigned xb_xcc_id() { return (unsigned)__builtin_amdgcn_s_getreg((3 << 11) | 20) & 0xFu; }
#define XB_SPIN(cond, bar) do { unsigned _sp = 0; while (cond) { __builtin_amdgcn_s_sleep(1); \
    if ((++_sp & 255u) == 0u) { if (xb_ld(&(bar)[XB_TMO])) break; if (_sp > XB_SPIN_CAP) { atomicAdd(&(bar)[XB_TMO], 1u); break; } } } } while (0)

struct XcdBarrier {
    unsigned* bar; unsigned x;
    volatile LAS unsigned* st;
};

__device__ __forceinline__ XcdBarrier xcd_barrier_post(unsigned* bar, volatile LAS unsigned* st) {
    XcdBarrier b; b.bar = bar; b.x = xb_xcc_id(); b.st = st;
    if (threadIdx.x == 0) (void)xb_add(&bar[XB_XCNT(b.x)], 1u);
    return b;
}
__device__ __forceinline__ void xcd_barrier_complete(unsigned* bar, unsigned x, unsigned& nloc, unsigned& nx) {
    const unsigned G = gridDim.x * gridDim.y * gridDim.z;
    unsigned sum, cnt, mine, sp = 0u;
    for (;;) {
        sum = 0u; cnt = 0u; mine = 0u;
#pragma unroll
        for (unsigned j = 0; j < 16; ++j) { const unsigned c = xb_ld(&bar[XB_XCNT(j)]); sum += c; cnt += (c > 0u) ? 1u : 0u; mine = (j == x) ? c : mine; }
        if (sum == G) break;
        __builtin_amdgcn_s_sleep(1);
        if ((++sp & 255u) == 0u) { if (xb_ld(&bar[XB_TMO])) break; if (sp > XB_SPIN_CAP) { atomicAdd(&bar[XB_TMO], 1u); break; } }
    }
    nloc = mine > 0u ? mine : 1u; nx = cnt > 0u ? cnt : 1u;
}

__device__ __forceinline__ void xcd_barrier(const XcdBarrier& b) {
    asm volatile("s_waitcnt vmcnt(0)" ::: "memory");
    __syncthreads();
    if (threadIdx.x == 0) {
        unsigned* bar = b.bar;
        __builtin_amdgcn_s_waitcnt(0);
        unsigned nloc = b.st[0], nx = b.st[1];
        if (nloc == 0u) { xcd_barrier_complete(bar, b.x, nloc, nx); b.st[0] = nloc; b.st[1] = nx; }
        const unsigned old = xb_add(&bar[XB_XSUB(b.x)], 1u);
        const unsigned gen = old / nloc;
        if (old + 1u == (gen + 1u) * nloc) {
            __builtin_amdgcn_fence(__ATOMIC_RELEASE, "agent");
            asm volatile("s_waitcnt vmcnt(0)" ::: "memory");
            const unsigned og = xb_add(&bar[XB_TOP], 1u);
            const unsigned tg = og / nx;
            if (og + 1u == (tg + 1u) * nx) xb_add(&bar[XB_TOPGEN], 1u);
            else XB_SPIN(xb_ld(&bar[XB_TOPGEN]) == tg, bar);
            __builtin_amdgcn_fence(__ATOMIC_ACQUIRE, "agent");
            xb_add(&bar[XB_XGEN(b.x)], 1u);
            asm volatile("s_waitcnt vmcnt(0)" ::: "memory");
        } else {
            XB_SPIN(xb_ld(&bar[XB_XGEN(b.x)]) == gen, bar);
            __builtin_amdgcn_fence(__ATOMIC_ACQUIRE, "agent");
            asm volatile("s_waitcnt vmcnt(0)" ::: "memory");
        }
    }
    __syncthreads();
}


constexpr int LDS_BYTES = 133120;
constexpr int NPHASE = 14;
__global__ void __launch_bounds__(512, 2) mk_fwd(Params P) {
    extern __shared__ __attribute__((aligned(16))) unsigned char lds_raw[];
    LAS unsigned char* lds = (LAS unsigned char*)lds_raw;
    cg::grid_group grid = cg::this_grid();
    const int lo = P.ph_lo, hi = P.ph_hi;
    if (threadIdx.x < 4) ((LAS unsigned*)(lds + 131072))[threadIdx.x] = 0u;
    __syncthreads();
    XcdBarrier bar = xcd_barrier_post((unsigned*)P.ws + P.li * XCD_BAR_WORDS, (volatile LAS unsigned*)(lds + 131072));
    if (hi < 0) grid.sync();
    const int wave = threadIdx.x >> 6;
    bf16_t* H = (bf16_t*)(P.ws + WS_H); bf16_t* Zb = (bf16_t*)(P.ws + WS_Z); bf16_t* A2 = (bf16_t*)(P.ws + WS_A2); bf16_t* YBF = (bf16_t*)(P.ws + WS_YBF);
    float* MOD = (float*)(P.ws + WS_MOD); float* Y1 = (float*)(P.ws + WS_Z);
#ifndef PHMASK
#define PHMASK 0x3fff
#endif
#ifndef DBLMASK
#define DBLMASK 0
#endif
#define IN(k) ((PHMASK & (1 << (k))) && lo <= (k) && (k) < hi)
#ifdef USE_CG_SYNC
#define SEAM(k) do { if (lo <= (k) && (k) + 1 < hi) grid.sync(); } while (0)
#else
#define SEAM(k) do { if (lo <= (k) && (k) + 1 < hi) xcd_barrier(bar); } while (0)
#endif
    if (IN(0)) _Pragma("nounroll") for (int rep_ = 0; rep_ < 1 + ((DBLMASK >> 0) & 1); ++rep_) phase0(P, lds);
    SEAM(0);
    if (IN(1)) _Pragma("nounroll") for (int rep_ = 0; rep_ < 1 + ((DBLMASK >> 1) & 1); ++rep_) phase_norm(P.in[I_XP], P.in[I_XS], P.in[I_NORMG], MOD, H);
    SEAM(1);
    if (IN(2)) _Pragma("nounroll") for (int rep_ = 0; rep_ < 1 + ((DBLMASK >> 2) & 1); ++rep_) { pg8::Gemm g{H, (const bf16_t*)(P.ws + WS_WIN_E), M, NZ, 1024}; pg8::StaticOrder S; S.init(M, NZ, gridDim.x, blockIdx.x);
        EpiZ E{Zb, P.in[I_LB]}; pg8::gemm_phase<EpiZ, pg8::StaticOrder>(lds, g, S, E); }
    SEAM(2);
    if (IN(3)) _Pragma("nounroll") for (int rep_ = 0; rep_ < 1 + ((DBLMASK >> 3) & 1); ++rep_) {
        _Pragma("nounroll") for (int r2_ = 0; r2_ < 1 + ((DBLMASK >> 14) & 1); ++r2_)
        for (int t = blockIdx.x; t < 1024; t += gridDim.x) hgrn_task<false>(P, lds, t);
        _Pragma("nounroll") for (int r2_ = 0; r2_ < 1 + ((DBLMASK >> 15) & 1); ++r2_)
        for (int t = blockIdx.x * 8 + wave; t < 4096; t += gridDim.x * 8) s5_task<false>(P, lds + wave * 8192, t);
    }
    SEAM(3);
    if (IN(4)) _Pragma("nounroll") for (int rep_ = 0; rep_ < 1 + ((DBLMASK >> 4) & 1); ++rep_) hgrn_carry(P);
    SEAM(4);
    if (IN(5)) _Pragma("nounroll") for (int rep_ = 0; rep_ < 1 + ((DBLMASK >> 5) & 1); ++rep_) {
        _Pragma("nounroll") for (int r2_ = 0; r2_ < 1 + ((DBLMASK >> 16) & 1); ++r2_)
        for (int t = blockIdx.x; t < 1280; t += gridDim.x) hgrn_task<true>(P, lds, t);
        _Pragma("nounroll") for (int r2_ = 0; r2_ < 1 + ((DBLMASK >> 17) & 1); ++r2_)
        for (int t = blockIdx.x * 8 + wave; t < 5120; t += gridDim.x * 8) s5_task<true>(P, lds + wave * 8192, t);
    }
    SEAM(5);
    if (IN(6)) _Pragma("nounroll") for (int rep_ = 0; rep_ < 1 + ((DBLMASK >> 6) & 1); ++rep_) phase_combine(P);
    SEAM(6);
    if (IN(7)) _Pragma("nounroll") for (int rep_ = 0; rep_ < 1 + ((DBLMASK >> 7) & 1); ++rep_) { pg8::Gemm g{YBF, (const bf16_t*)(P.ws + WS_WGLU), M, 512, 512}; pg8::StaticOrder S; S.init(M, 512, gridDim.x, blockIdx.x);
        EpiGlu E{YBF, Zb, P.in[I_BGLU], A2}; pg8::gemm_phase<EpiGlu, pg8::StaticOrder>(lds, g, S, E); }
    SEAM(7);
    if (IN(8)) _Pragma("nounroll") for (int rep_ = 0; rep_ < 1 + ((DBLMASK >> 8) & 1); ++rep_) { pg8::Gemm g{A2, (const bf16_t*)(P.ws + WS_WOUT_E), M, 1024, 1024}; pg8::StaticOrder S; S.init(M, 1024, gridDim.x, blockIdx.x);
        EpiRes E{P.in[I_XP], P.in[I_XS], MOD + 2048, Y1}; pg8::gemm_phase<EpiRes, pg8::StaticOrder>(lds, g, S, E); }
    SEAM(8);
    if (IN(9)) _Pragma("nounroll") for (int rep_ = 0; rep_ < 1 + ((DBLMASK >> 9) & 1); ++rep_) phase_norm(Y1, Y1 + (size_t)MP * D, P.in[I_NORMG] + 1024, MOD + 9 * 3072, H);
    SEAM(9);
    if (IN(10)) _Pragma("nounroll") for (int rep_ = 0; rep_ < 1 + ((DBLMASK >> 10) & 1); ++rep_) { pg8::Gemm g{H, (const bf16_t*)(P.ws + WS_WIN_O), M, 4096, 1024}; pg8::StaticOrder S; S.init(M, 4096, gridDim.x, blockIdx.x);
        EpiOdd E{(bf16_t*)(P.ws + WS_Z + 160 * MiB), A2}; pg8::gemm_phase<EpiOdd, pg8::StaticOrder>(lds, g, S, E); }
    SEAM(10);
    if (IN(11)) _Pragma("nounroll") for (int rep_ = 0; rep_ < 1 + ((DBLMASK >> 11) & 1); ++rep_) phase_conv(P);
    SEAM(11);
    if (IN(12)) _Pragma("nounroll") for (int rep_ = 0; rep_ < 1 + ((DBLMASK >> 12) & 1); ++rep_) { pg8::Gemm g{H, (const bf16_t*)(P.ws + WS_WOUT_O), M, 1024, 1024}; pg8::StaticOrder S; S.init(M, 1024, gridDim.x, blockIdx.x);
        EpiRes E{Y1, Y1 + (size_t)MP * D, MOD + 9 * 3072 + 2048, P.out}; pg8::gemm_phase<EpiRes, pg8::StaticOrder>(lds, g, S, E); }
    SEAM(12);
#ifdef PROBE_SYNCS
    for (int i_ = 0; i_ < PROBE_SYNCS; ++i_) xcd_barrier(bar);
#endif
    if (IN(13)) _Pragma("nounroll") for (int rep_ = 0; rep_ < 1 + ((DBLMASK >> 13) & 1); ++rep_) phase_final_norm(P.out, P.in[I_FNG]);
#undef IN
#undef SEAM
}

extern "C" void kernel_launch(void* const* d_in, const int* in_sizes, int n_in, void* d_out, int out_size, void* d_ws, size_t ws_size, hipStream_t stream) {
    static int grid = 0;
    if (grid == 0) {
        if (n_in != 29 || ws_size < WS_END) { fprintf(stderr, "kernel_launch: unexpected n_in %d / ws_size %zu (need %zu)\n", n_in, ws_size, (size_t)WS_END); grid = -1; return; }
        int dev = 0, cus = 0, per_cu = 0;
        hipGetDevice(&dev); hipDeviceGetAttribute(&cus, hipDeviceAttributeMultiprocessorCount, dev);
        if (hipFuncSetAttribute((const void*)mk_fwd, hipFuncAttributeMaxDynamicSharedMemorySize, LDS_BYTES) != hipSuccess) { fprintf(stderr, "kernel_launch: hipFuncSetAttribute failed\n"); grid = -1; return; }
        if (hipOccupancyMaxActiveBlocksPerMultiprocessor(&per_cu, (const void*)mk_fwd, 512, LDS_BYTES) != hipSuccess || per_cu < 1) { fprintf(stderr, "kernel_launch: occupancy query says %d\n", per_cu); per_cu = 1; }
        (void)hipGetLastError();
        grid = cus * per_cu;
        fprintf(stderr, "kernel_launch: grid %d (cus %d x %d)\n", grid, cus, per_cu);
    }
    if (grid < 0) return;
    Params p{};
    (void)hipMemsetAsync(d_ws, 0, 65536, stream);
    for (int i = 0; i < 29; ++i) p.in[i] = (const float*)d_in[i];
    p.out = (float*)d_out; p.ws = (unsigned char*)d_ws;
#if MK_COOP
    void* args[] = {&p};
#ifdef PROBE_SPLIT
    p.ph_lo = 0; p.ph_hi = PROBE_SPLIT + 1;
    (void)hipLaunchCooperativeKernel((const void*)mk_fwd, dim3(grid), dim3(512), args, LDS_BYTES, stream);
    p.ph_lo = PROBE_SPLIT; p.ph_hi = NPHASE; p.li = 1;
#else
    p.ph_lo = 0; p.ph_hi = NPHASE;
#endif
    hipError_t e = hipLaunchCooperativeKernel((const void*)mk_fwd, dim3(grid), dim3(512), args, LDS_BYTES, stream);
    if (e != hipSuccess) fprintf(stderr, "kernel_launch: cooperative launch failed: %s (grid %d)\n", hipGetErrorString(e), grid);
#else
    for (int ph = 0; ph < NPHASE; ++ph) { p.ph_lo = ph; p.ph_hi = ph + 1; hipLaunchKernelGGL(mk_fwd, dim3(grid), dim3(512), LDS_BYTES, stream, p); }
#endif
}
```

```cpp
#include <hip/hip_runtime.h>
#include <hip/hip_cooperative_groups.h>
#include <cstdio>
#include <cstdint>
namespace cg = cooperative_groups;
#ifndef MK_COOP
#define MK_COOP 1
#endif

namespace pg8 {
#define PG8_LAS __attribute__((address_space(3)))
typedef unsigned short bf16_t;
typedef short bf16x8 __attribute__((ext_vector_type(8)));
typedef float f32x4 __attribute__((ext_vector_type(4)));
typedef unsigned u32x4 __attribute__((ext_vector_type(4)));
constexpr int BM = 256, BK = 64, HALF = 128, HTB = HALF * BK * 2  , STAGE_BYTES = 8 * HTB, NXCD = 8, WGM = 8;

__host__ __device__ __forceinline__ int lds_byte(int r, int c) { const int st = (r >> 4) * 2 + (c >> 5), rr = r & 15, cc = c & 31, ob = rr * 64 + cc * 2; return st * 1024 + (ob ^ (((ob >> 9) & 1) << 5)); }
__host__ __device__ __forceinline__ void stage_rc(int b, int& R, int& C) { const int st = b / 1024, sb = b % 1024, swz = sb ^ (((sb >> 9) & 1) << 5); R = (st >> 1) * 16 + swz / 64; C = (st & 1) * 32 + (swz % 64) / 2; }
__host__ __device__ __forceinline__ int perm32(int rho) { const int n = rho >> 4, i = rho & 15; return 8 * (i >> 2) + 4 * n + (i & 3); }

struct Unit { int pm, pn; };
struct Gemm { const bf16_t* A; const bf16_t* Bt; int M, N, K; };

struct StaticOrder {
    int nM, nN, nwg, G, c;
    __host__ __device__ void init(int M, int N, int G_, int c_) { nM = M / BM; nN = N / BM; nwg = nM * nN; G = G_; c = c_; }
    __host__ __device__ bool next(int i, Unit& u) const {
        const long L = (long)i * G + c; if (L >= nwg) return false;
        int wgid = (int)L; { const int q = nwg / NXCD, r = nwg % NXCD, xcd = wgid % NXCD, off = wgid / NXCD; wgid = (xcd < r ? xcd * (q + 1) : r * (q + 1) + (xcd - r) * q) + off; }
        const int nig = WGM * nN, gid = wgid / nig, fm = gid * WGM, gsz = (nM - fm) < WGM ? (nM - fm) : WGM;
        u.pm = fm + ((wgid % nig) % gsz); u.pn = (wgid % nig) / gsz; return true;
    }
    __device__ __forceinline__ void a_ready(const Unit&) const {}
    __device__ __forceinline__ void done(const Unit&) const {}
};

__device__ __forceinline__ unsigned cvt_pk_bf16(float lo, float hi) { unsigned r; asm volatile("v_cvt_pk_bf16_f32 %0, %1, %2" : "=v"(r) : "v"(lo), "v"(hi)); return r; }

template <class Epi, class Sched>
__device__ __forceinline__ void gemm_phase(PG8_LAS unsigned char* lds, const Gemm g, const Sched& S, const Epi& E) {
    const int tid = threadIdx.x, wid = __builtin_amdgcn_readfirstlane(tid >> 6), lane = tid & 63, wr = wid >> 2, wc = wid & 3, fr = lane & 15, fq = lane >> 4;
    const int K = g.K, nt = K / BK;
    unsigned voffA[2], voffB[2];
#pragma unroll
    for (int i = 0; i < 2; ++i) { int R, C; stage_rc(tid * 16 + i * 8192, R, C); const int Rb = Epi::PERM ? ((R & ~31) + perm32(R & 31)) : R;
        voffA[i] = (unsigned)(R * K + C) * 2u; voffB[i] = (unsigned)(Rb * K + C) * 2u; }
    const size_t kstep = (size_t)(BK * 2);
    const size_t hstep = (size_t)HALF * K * 2;
    const size_t tstep = 2 * hstep;
    const unsigned ldsw = (unsigned)wid * 1024u;
    const int aoff = lds_byte(wr * 64 + fr, fq * 8), boff = lds_byte(wc * 32 + fr, fq * 8);
#define PG8_SA(b, h) (((b) * 2 + (h)) * HTB)
#define PG8_SB(b, h) ((4 + (b) * 2 + (h)) * HTB)
#define PG8_STAGE(bufoff, gbase, voff) do { _Pragma("unroll") for (int _i = 0; _i < 2; ++_i) \
        __builtin_amdgcn_global_load_lds((const unsigned*)((const char*)(gbase) + (voff)[_i]), (PG8_LAS unsigned*)(lds + (bufoff) + ldsw + _i * 8192), 16, 0, 0); } while (0)
#define PG8_LDA(dst, b, h) do { _Pragma("unroll") for (int m = 0; m < 4; ++m) _Pragma("unroll") for (int k = 0; k < 2; ++k) dst[m][k] = *(const PG8_LAS bf16x8*)(lds + PG8_SA(b, h) + aoff + m * 2048 + k * 1024); } while (0)
#define PG8_LDB(dst, b, h) do { _Pragma("unroll") for (int n = 0; n < 2; ++n) _Pragma("unroll") for (int k = 0; k < 2; ++k) dst[n][k] = *(const PG8_LAS bf16x8*)(lds + PG8_SB(b, h) + boff + n * 2048 + k * 1024); } while (0)
#define PG8_MMA(ai, bj, At, Bt) do { __builtin_amdgcn_s_setprio(1); _Pragma("unroll") for (int m = 0; m < 4; ++m) _Pragma("unroll") for (int n = 0; n < 2; ++n) _Pragma("unroll") for (int k = 0; k < 2; ++k) \
        acc[ai][bj][m][n] = __builtin_amdgcn_mfma_f32_16x16x32_bf16(Bt[n][k], At[m][k], acc[ai][bj][m][n], 0, 0, 0); __builtin_amdgcn_s_setprio(0); } while (0)
#define PG8_WAIT_V(n) asm volatile("s_waitcnt vmcnt(" #n ")" ::: "memory")
#define PG8_WAIT_L(n) asm volatile("s_waitcnt lgkmcnt(" #n ")" ::: "memory")
#define PG8_BAR __builtin_amdgcn_s_barrier()
#define PG8_SCHED __builtin_amdgcn_sched_barrier(0)
    Unit cur, nxt; int ui = 0;
    if (!S.next(0, cur)) return;
    f32x4 acc[2][2][4][2];
#pragma unroll
    for (int a = 0; a < 2; ++a)
#pragma unroll
        for (int b = 0; b < 2; ++b)
#pragma unroll
            for (int m = 0; m < 4; ++m)
#pragma unroll
                for (int n = 0; n < 2; ++n) acc[a][b][m][n] = (f32x4){0.f, 0.f, 0.f, 0.f};
    bf16x8 At[4][2], B0[2][2], B1[2][2];
    const char* cA = (const char*)g.A + (size_t)cur.pm * tstep; const char* cB = (const char*)g.Bt + (size_t)cur.pn * tstep;
    S.a_ready(cur);
    PG8_STAGE(PG8_SB(0, 0), cB, voffB); PG8_STAGE(PG8_SA(0, 0), cA, voffA); PG8_STAGE(PG8_SB(0, 1), cB + hstep, voffB); PG8_STAGE(PG8_SA(0, 1), cA + hstep, voffA);
    if (wr == 1) PG8_BAR;
    PG8_WAIT_V(4); PG8_BAR;
    PG8_STAGE(PG8_SB(1, 0), cB + kstep, voffB); PG8_STAGE(PG8_SA(1, 0), cA + kstep, voffA); PG8_STAGE(PG8_SB(1, 1), cB + hstep + kstep, voffB);
    PG8_WAIT_V(6); PG8_BAR;
    for (;;) {
        const bool has_next = S.next(ui + 1, nxt);
        const char* nA = has_next ? (const char*)g.A + (size_t)nxt.pm * tstep : cA; const char* nB = has_next ? (const char*)g.Bt + (size_t)nxt.pn * tstep : cB;
        for (int t = 0; t < nt; t += 2) {
            const bool last = (t == nt - 2);
            const char* a1 = cA + (size_t)(t + 1) * kstep;
            const char* a2 = last ? nA : cA + (size_t)(t + 2) * kstep; const char* b2 = last ? nB : cB + (size_t)(t + 2) * kstep;
            const char* a3 = a2 + kstep; const char* b3 = b2 + kstep;
            if (last && has_next) S.a_ready(nxt);
            PG8_LDB(B0, 0, 0); PG8_SCHED; PG8_LDA(At, 0, 0); PG8_STAGE(PG8_SA(1, 1), a1 + hstep, voffA);
            PG8_WAIT_L(8); PG8_BAR; PG8_WAIT_L(0); PG8_MMA(0, 0, At, B0); PG8_BAR; PG8_SCHED;
            PG8_LDB(B1, 0, 1); PG8_STAGE(PG8_SB(0, 0), b2, voffB);
            PG8_BAR; PG8_WAIT_L(0); PG8_MMA(0, 1, At, B1); PG8_BAR;
            PG8_LDA(At, 0, 1); PG8_STAGE(PG8_SA(0, 0), a2, voffA);
            PG8_BAR; PG8_WAIT_L(0); PG8_MMA(1, 0, At, B0); PG8_BAR; PG8_SCHED;
            PG8_STAGE(PG8_SB(0, 1), b2 + hstep, voffB);
            PG8_WAIT_V(6); PG8_BAR; PG8_MMA(1, 1, At, B1); PG8_BAR;
            PG8_LDB(B0, 1, 0); PG8_SCHED; PG8_LDA(At, 1, 0); PG8_STAGE(PG8_SA(0, 1), a2 + hstep, voffA);
            PG8_WAIT_L(8); PG8_BAR; PG8_WAIT_L(0); PG8_MMA(0, 0, At, B0); PG8_BAR; PG8_SCHED;
            PG8_LDB(B1, 1, 1); PG8_STAGE(PG8_SB(1, 0), b3, voffB);
            PG8_BAR; PG8_WAIT_L(0); PG8_MMA(0, 1, At, B1); PG8_BAR;
            PG8_LDA(At, 1, 1); PG8_STAGE(PG8_SA(1, 0), a3, voffA);
            PG8_BAR; PG8_WAIT_L(0); PG8_MMA(1, 0, At, B0); PG8_BAR; PG8_SCHED;
            PG8_STAGE(PG8_SB(1, 1), b3 + hstep, voffB);
            PG8_WAIT_V(6); PG8_BAR; PG8_MMA(1, 1, At, B1); PG8_BAR;
        }
        if constexpr (!Epi::AFTER_DRAIN) { E(acc, cur, wr, wc, fr, fq); S.done(cur); }
        if (!has_next) break;
#pragma unroll
        for (int a = 0; a < 2; ++a)
#pragma unroll
            for (int b = 0; b < 2; ++b)
#pragma unroll
                for (int m = 0; m < 4; ++m)
#pragma unroll
                    for (int n = 0; n < 2; ++n) acc[a][b][m][n] = (f32x4){0.f, 0.f, 0.f, 0.f};
        cur = nxt; cA = nA; cB = nB; ++ui;
    }
    PG8_WAIT_V(0);
    if (wr == 0) PG8_BAR;
    PG8_BAR;
    if constexpr (Epi::AFTER_DRAIN) { E.fused(acc, cur, wr, wc, fr, fq, lds, wid, lane); S.done(cur); }
#undef PG8_SA
#undef PG8_SB
#undef PG8_STAGE
#undef PG8_LDA
#undef PG8_LDB
#undef PG8_MMA
#undef PG8_WAIT_V
#undef PG8_WAIT_L
#undef PG8_BAR
#undef PG8_SCHED
}
}


#define LAS __attribute__((address_space(3)))
typedef unsigned short bf16_t;
typedef short bf16x8 __attribute__((ext_vector_type(8)));
typedef short s16x4 __attribute__((ext_vector_type(4)));
typedef float f32x4 __attribute__((ext_vector_type(4)));
typedef float f32x16 __attribute__((ext_vector_type(16)));
typedef unsigned u32x4 __attribute__((ext_vector_type(4)));
typedef unsigned u32x2 __attribute__((ext_vector_type(2)));

constexpr int D = 1024, MP = 8192, MS = 32768, M = 40960, NZ = 3584;
constexpr int ZQ = 0, ZF = 512, ZV = 1536, ZGA = 2048, ZU = 2560, ZGB = 3072;
constexpr float EPS = 1e-6f;
constexpr size_t MiB = 1u << 20;
constexpr size_t WS_MOD = 1 * MiB;
constexpr size_t WS_BSEG = 1 * MiB + 512 * 1024;
constexpr size_t WS_WIN_E = 2 * MiB;
constexpr size_t WS_WOUT_E = 10 * MiB;
constexpr size_t WS_WGLU = 12 * MiB;
constexpr size_t WS_WIN_O = 13 * MiB;
constexpr size_t WS_WOUT_O = 21 * MiB;
constexpr size_t WS_XLOC = 23 * MiB;
constexpr size_t WS_H = 32 * MiB;
constexpr size_t WS_Z = 112 * MiB;
constexpr size_t WS_A2 = 392 * MiB;
constexpr size_t WS_YBF = 472 * MiB;
constexpr size_t WS_END = 512 * MiB;
constexpr size_t OUT_YS = (size_t)MP * D, OUT_SH = (size_t)M * D, OUT_SRE = OUT_SH + 32 * 2 * 4 * 128 * 128, OUT_SIM = OUT_SRE + 32 * 2 * 32 * 64;

struct Params { const float* in[29]; float* out; unsigned char* ws; int ph_lo, ph_hi, li, pad; };
enum { I_XP = 0, I_XS, I_SH, I_SRE, I_SIM, I_C, I_CCTX, I_NORMG, I_WMOD, I_BMOD, I_WINE, I_WOUTE, I_LB, I_HG, I_LRE, I_LIM, I_LDT, I_BRE, I_BIM, I_CRE, I_CIM, I_S5D, I_WGLU, I_BGLU, I_WINO, I_WOUTO, I_CW, I_CB, I_FNG };

__device__ __forceinline__ float bf2f(unsigned x) { return __uint_as_float(x << 16); }
__device__ __forceinline__ float bflo(unsigned w) { return __uint_as_float(w << 16); }
__device__ __forceinline__ float bfhi(unsigned w) { return __uint_as_float(w & 0xffff0000u); }
typedef __bf16 bf16v2 __attribute__((ext_vector_type(2)));
__device__ __forceinline__ unsigned pk2(float lo, float hi) { bf16v2 v; v[0] = (__bf16)lo; v[1] = (__bf16)hi; return __builtin_bit_cast(unsigned, v); }
__device__ __forceinline__ float fsigmoid(float x) { return __builtin_amdgcn_rcpf(1.0f + __expf(-x)); }
__device__ __forceinline__ float fsilu(float x) { return x * fsigmoid(x); }
__device__ __forceinline__ float wave_sum(float v) {
#pragma unroll
    for (int o = 1; o < 64; o <<= 1) v += __shfl_xor(v, o);
    return v;
}
__device__ __forceinline__ void unpack8(const u32x4 w, float (&f)[8]) {
    f[0] = bflo(w.x); f[1] = bfhi(w.x); f[2] = bflo(w.y); f[3] = bfhi(w.y); f[4] = bflo(w.z); f[5] = bfhi(w.z); f[6] = bflo(w.w); f[7] = bfhi(w.w);
}
__device__ __forceinline__ u32x4 pack8(const float (&f)[8]) { u32x4 w; w.x = pk2(f[0], f[1]); w.y = pk2(f[2], f[3]); w.z = pk2(f[4], f[5]); w.w = pk2(f[6], f[7]); return w; }
#define LDS_WAIT() asm volatile("s_waitcnt lgkmcnt(0)" ::: "memory")

using pg8::Unit; using pg8::HALF; using pg8::BM;
struct EpiZ {
    static constexpr bool PERM = true, AFTER_DRAIN = false;
    bf16_t* Z; const float* lbl;
    __device__ __forceinline__ void operator()(const f32x4 (&acc)[2][2][4][2], const Unit& u, int wr, int wc, int fr, int fq) const {
        const int row0 = u.pm * BM + wr * 64 + fr, col0 = u.pn * BM + wc * 32 + 8 * fq, type = u.pn >> 1;
        float lb[2][8];
        if (type == 1 || type == 2) {
#pragma unroll
            for (int bj = 0; bj < 2; ++bj)
#pragma unroll
                for (int e = 0; e < 8; ++e) { const int c = (col0 + bj * HALF + e) & 511; lb[bj][e] = __builtin_amdgcn_rcpf(1.0f + __expf(lbl[512 + c] - lbl[c])); }
        }
#pragma unroll
        for (int ai = 0; ai < 2; ++ai)
#pragma unroll
            for (int m = 0; m < 4; ++m) { bf16_t* rowp = Z + (size_t)(row0 + ai * HALF + m * 16) * NZ + col0;
#pragma unroll
                for (int bj = 0; bj < 2; ++bj) { float v[8];
#pragma unroll
                    for (int e = 0; e < 4; ++e) { v[e] = acc[ai][bj][m][0][e]; v[4 + e] = acc[ai][bj][m][1][e]; }
                    if (type == 1 || type == 2) {
#pragma unroll
                        for (int e = 0; e < 8; ++e) v[e] = __logf(lb[bj][e] + (1.0f - lb[bj][e]) * fsigmoid(v[e]));
                    } else if (type == 4 || type == 6) {
#pragma unroll
                        for (int e = 0; e < 8; ++e) v[e] = fsilu(v[e]);
                    }
                    *(u32x4*)(rowp + bj * HALF) = pack8(v); } }
    }
};
struct EpiGlu {
    static constexpr bool PERM = true, AFTER_DRAIN = false;
    const bf16_t* Y; const bf16_t* Z; const float* bglu; bf16_t* A2;
    __device__ __forceinline__ void operator()(const f32x4 (&acc)[2][2][4][2], const Unit& u, int wr, int wc, int fr, int fq) const {
        const int row0 = u.pm * BM + wr * 64 + fr, col0 = u.pn * BM + wc * 32 + 8 * fq;
        float bv[2][8];
#pragma unroll
        for (int bj = 0; bj < 2; ++bj)
#pragma unroll
            for (int e = 0; e < 8; ++e) bv[bj][e] = bglu[col0 + bj * HALF + e];
#pragma unroll
        for (int ai = 0; ai < 2; ++ai) {
            u32x4 yv[4][2], zv[4][2];
#pragma unroll
            for (int m = 0; m < 4; ++m) { const size_t row = (size_t)(row0 + ai * HALF + m * 16);
#pragma unroll
                for (int bj = 0; bj < 2; ++bj) { const int col = col0 + bj * HALF; yv[m][bj] = *(const u32x4*)(Y + row * 512 + col); zv[m][bj] = *(const u32x4*)(Z + row * NZ + ZGB + col); } }
            asm volatile("" ::: "memory");
#pragma unroll
            for (int m = 0; m < 4; ++m) { const size_t row = (size_t)(row0 + ai * HALF + m * 16);
#pragma unroll
                for (int bj = 0; bj < 2; ++bj) { const int col = col0 + bj * HALF; float y[8], sg[8], o[8];
                    unpack8(yv[m][bj], y); unpack8(zv[m][bj], sg);
#pragma unroll
                    for (int e = 0; e < 8; ++e) { const float a = (e < 4 ? acc[ai][bj][m][0][e] : acc[ai][bj][m][1][e - 4]) + bv[bj][e]; o[e] = y[e] * fsigmoid(a) * sg[e]; }
                    *(u32x4*)(A2 + row * 1024 + 512 + col) = pack8(o); } }
            asm volatile("" ::: "memory");
        }
    }
};
struct EpiRes {
    static constexpr bool PERM = false, AFTER_DRAIN = false;
    const float* base_p; const float* base_s; const float* gate; float* out;
    __device__ __forceinline__ void operator()(const f32x4 (&acc)[2][2][4][2], const Unit& u, int wr, int wc, int fr, int fq) const {
        const int rowt = u.pm * BM, row0 = rowt + wr * 64 + fr, col0 = u.pn * BM + wc * 32 + 4 * fq;
        const int n = rowt < MP ? 0 : 1 + ((rowt - MP) >> 12);
        const float* base = rowt < MP ? base_p : base_s - (size_t)MP * D;
        f32x4 gv[2][2];
#pragma unroll
        for (int bj = 0; bj < 2; ++bj)
#pragma unroll
            for (int nn = 0; nn < 2; ++nn) gv[bj][nn] = *(const f32x4*)(gate + n * 3072 + col0 + bj * HALF + nn * 16);
#pragma unroll
        for (int ai = 0; ai < 2; ++ai) {
            f32x4 bv[4][2][2];
#pragma unroll
            for (int m = 0; m < 4; ++m) { const size_t off = (size_t)(row0 + ai * HALF + m * 16) * D + col0;
#pragma unroll
                for (int bj = 0; bj < 2; ++bj)
#pragma unroll
                    for (int nn = 0; nn < 2; ++nn) bv[m][bj][nn] = *(const f32x4*)(base + off + bj * HALF + nn * 16); }
            asm volatile("" ::: "memory");
#pragma unroll
            for (int m = 0; m < 4; ++m) { const size_t off = (size_t)(row0 + ai * HALF + m * 16) * D + col0;
#pragma unroll
                for (int bj = 0; bj < 2; ++bj)
#pragma unroll
                    for (int nn = 0; nn < 2; ++nn) *(f32x4*)(out + off + bj * HALF + nn * 16) = bv[m][bj][nn] + gv[bj][nn] * acc[ai][bj][m][nn]; }
            asm volatile("" ::: "memory");
        }
    }
};
struct EpiOdd {
    static constexpr bool PERM = false, AFTER_DRAIN = false;
    bf16_t* PB; bf16_t* GB;
    __device__ __forceinline__ void operator()(const f32x4 (&acc)[2][2][4][2], const Unit& u, int wr, int wc, int fr, int fq) const {
        const int row0 = u.pm * BM + wr * 64 + fr, ch0 = u.pn * 64 + 16 * wc + 4 * fq;
#pragma unroll
        for (int ai = 0; ai < 2; ++ai)
#pragma unroll
            for (int m = 0; m < 4; ++m) { const size_t off = (size_t)(row0 + ai * HALF + m * 16) * D + ch0;
                const f32x4 bg = acc[ai][0][m][0], cgv = acc[ai][0][m][1], vv = acc[ai][1][m][0], gg = acc[ai][1][m][1];
                const f32x4 p = cgv * vv; f32x4 g;
#pragma unroll
                for (int e = 0; e < 4; ++e) g[e] = bg[e] * fsilu(gg[e]);
                u32x2 wp, wg; wp.x = pk2(p[0], p[1]); wp.y = pk2(p[2], p[3]); wg.x = pk2(g[0], g[1]); wg.y = pk2(g[2], g[3]);
                *(u32x2*)(PB + off) = wp; *(u32x2*)(GB + off) = wg; }
    }
};

template <int MODE>
__device__ __forceinline__ void transpose_item(const float* W, int K, int N, bf16_t* WT, LAS float* scr, int item, int lane) {
    const int nblk = N / 32, kb = item / nblk, nb = item % nblk, k0 = 64 * kb, n0 = 32 * nb;
#pragma unroll 8
    for (int i = 0; i < 32; ++i) { const int kk = 2 * i + (lane >> 5); scr[kk * 33 + (lane & 31)] = W[(size_t)(k0 + kk) * N + n0 + (lane & 31)]; }
    LDS_WAIT();
    const int c = lane & 7;
#pragma unroll
    for (int j = 0; j < 4; ++j) { const int n = (lane >> 3) + 8 * j; const LAS float* s = scr + (8 * c) * 33 + n;
        u32x4 o; o.x = pk2(s[0 * 33], s[1 * 33]); o.y = pk2(s[2 * 33], s[3 * 33]); o.z = pk2(s[4 * 33], s[5 * 33]); o.w = pk2(s[6 * 33], s[7 * 33]);
        int dn = n0 + n;
        if (MODE == 1) { const int blk = dn >> 10, rem = dn & 1023, tile = rem >> 6, ch = rem & 63; dn = tile * 256 + 128 * (blk >> 1) + 32 * (ch >> 4) + 16 * (blk & 1) + (ch & 15); }
        *(u32x4*)(WT + (size_t)dn * K + k0 + 8 * c) = o; }
    LDS_WAIT();
}
__device__ __forceinline__ void phase0(const Params& P, LAS unsigned char* lds) {
    const int tid = threadIdx.x, lane = tid & 63, wave = tid >> 6;
    float* MOD = (float*)(P.ws + WS_MOD);
    if (blockIdx.x < 96) {
        LAS float* sc = (LAS float*)lds;
        LAS float* red = (LAS float*)(lds + 36864);
        for (int i = tid; i < 9 * 1024; i += 512) { const int n = i >> 10, k = i & 1023; const float c = n == 0 ? P.in[I_CCTX][k] : P.in[I_C][(n - 1) * 1024 + k]; sc[i] = fsilu(c); }
        __syncthreads();
        for (int item = blockIdx.x; item < 96; item += gridDim.x) {
            const int l = item / 48, jb = item % 48;
            const float* W = P.in[I_WMOD] + (size_t)l * 1024 * 3072 + jb * 64 + lane;
            float acc[9];
#pragma unroll
            for (int n = 0; n < 9; ++n) acc[n] = 0.f;
            for (int kk = 0; kk < 128; kk += 4) { const int k = wave * 128 + kk;
                const float w0 = W[(size_t)k * 3072], w1 = W[(size_t)(k + 1) * 3072], w2 = W[(size_t)(k + 2) * 3072], w3 = W[(size_t)(k + 3) * 3072];
#pragma unroll
                for (int n = 0; n < 9; ++n) { const f32x4 s = *(const LAS f32x4*)(sc + n * 1024 + k); acc[n] += s[0] * w0 + s[1] * w1 + s[2] * w2 + s[3] * w3; } }
#pragma unroll
            for (int n = 0; n < 9; ++n) red[(wave * 9 + n) * 64 + lane] = acc[n];
            __syncthreads();
            for (int i = tid; i < 576; i += 512) { const int n = i >> 6, jj = i & 63; float s = 0.f;
#pragma unroll
                for (int w = 0; w < 8; ++w) s += red[(w * 9 + n) * 64 + jj];
                MOD[(l * 9 + n) * 3072 + jb * 64 + jj] = s + P.in[I_BMOD][l * 3072 + jb * 64 + jj]; }
            __syncthreads();
        }
    }
    __syncthreads();
    LAS float* scr = (LAS float*)(lds + wave * 8448);
    const int gw = blockIdx.x * 8 + wave, NGW = gridDim.x * 8;
    constexpr int I1 = 16 * 112, I2 = 16 * 32, I3 = 8 * 16, I4 = 16 * 128, I5 = 16 * 32;
    for (int it = gw; it < I1 + I2 + I3 + I4 + I5; it += NGW) {
        int r = it;
        if (r < I1) { transpose_item<0>(P.in[I_WINE], 1024, 3584, (bf16_t*)(P.ws + WS_WIN_E), scr, r, lane); continue; } r -= I1;
        if (r < I2) { transpose_item<0>(P.in[I_WOUTE], 1024, 1024, (bf16_t*)(P.ws + WS_WOUT_E), scr, r, lane); continue; } r -= I2;
        if (r < I3) { transpose_item<0>(P.in[I_WGLU], 512, 512, (bf16_t*)(P.ws + WS_WGLU), scr, r, lane); continue; } r -= I3;
        if (r < I4) { transpose_item<1>(P.in[I_WINO], 1024, 4096, (bf16_t*)(P.ws + WS_WIN_O), scr, r, lane); continue; } r -= I4;
        transpose_item<0>(P.in[I_WOUTO], 1024, 1024, (bf16_t*)(P.ws + WS_WOUT_O), scr, r, lane);
    }
}

__device__ __forceinline__ void phase_norm(const float* xp, const float* xs, const float* ng, const float* mod, bf16_t* H) {
    const int lane = threadIdx.x & 63, gw = blockIdx.x * 8 + (threadIdx.x >> 6), NGW = gridDim.x * 8;
    for (int m = gw; m < M; m += NGW) {
        const float* xr = m < MP ? xp + (size_t)m * D : xs + (size_t)(m - MP) * D; const int n = m < MP ? 0 : 1 + ((m - MP) >> 12);
        f32x4 v[4]; float ss = 0.f;
#pragma unroll
        for (int j = 0; j < 4; ++j) { v[j] = *(const f32x4*)(xr + 4 * lane + 256 * j); ss += (v[j][0] * v[j][0] + v[j][1] * v[j][1]) + (v[j][2] * v[j][2] + v[j][3] * v[j][3]); }
        const float rstd = rsqrtf(wave_sum(ss) * (1.0f / D) + EPS);
#pragma unroll
        for (int j = 0; j < 4; ++j) { const int col = 4 * lane + 256 * j;
            const f32x4 g = *(const f32x4*)(ng + col), sh = *(const f32x4*)(mod + n * 3072 + col), sc = *(const f32x4*)(mod + n * 3072 + 1024 + col);
            const f32x4 y = v[j] * rstd * g * (sc + 1.0f) + sh;
            u32x2 w; w.x = pk2(y[0], y[1]); w.y = pk2(y[2], y[3]); *(u32x2*)(H + (size_t)m * D + col) = w; }
    }
}
__device__ __forceinline__ void phase_final_norm(float* out, const float* g) {
    const int lane = threadIdx.x & 63, gw = blockIdx.x * 8 + (threadIdx.x >> 6), NGW = gridDim.x * 8;
    for (int m = gw; m < M; m += NGW) { float* xr = out + (size_t)m * D;
        f32x4 v[4]; float ss = 0.f;
#pragma unroll
        for (int j = 0; j < 4; ++j) { v[j] = *(const f32x4*)(xr + 4 * lane + 256 * j); ss += (v[j][0] * v[j][0] + v[j][1] * v[j][1]) + (v[j][2] * v[j][2] + v[j][3] * v[j][3]); }
        const float rstd = rsqrtf(wave_sum(ss) * (1.0f / D) + EPS);
#pragma unroll
        for (int j = 0; j < 4; ++j) { const int col = 4 * lane + 256 * j; *(f32x4*)(xr + col) = v[j] * rstd * *(const f32x4*)(g + col); }
    }
}

constexpr int HG_QP = 272, HG_SP = 144;
constexpr int HG_Q = 0, HG_K = 17408, HG_KT = 34816, HG_VT = 53248, HG_P = 71680, HG_ST = 80896, HG_TAB = 115712;
__device__ __forceinline__ int seg_rowbase(int sg) { return sg < 32 ? sg * 256 : MP + (sg - 32) * 256; }
#define MFMA16(a, b, c) __builtin_amdgcn_mfma_f32_16x16x32_bf16((a), (b), (c), 0, 0, 0)
#define MFMA32(a, b, c) __builtin_amdgcn_mfma_f32_32x32x16_bf16((a), (b), (c), 0, 0, 0)

template <bool PASS2>
__device__ __forceinline__ void hgrn_task(const Params& P, LAS unsigned char* lds, int task) {
    const int tid = threadIdx.x, lane = tid & 63, w = __builtin_amdgcn_readfirstlane(tid >> 6), col = lane & 15, quad = lane >> 4;
    const int ch = tid & 127, qt = tid >> 7;
    const int d = task & 1, h = (task >> 1) & 3, sg = PASS2 ? (task >> 3) : 32 + (task >> 3);
    const int rowbase = seg_rowbase(sg), slot = ((sg - 32) << 3) | (h << 1) | d;
    const bf16_t* Z = (const bf16_t*)(P.ws + WS_Z);
    float* SLOC = (float*)(P.ws + WS_A2); float* BSEG = (float*)(P.ws + WS_BSEG);
    bf16_t* OB = (bf16_t*)(P.ws + WS_H) + (size_t)d * M * 512;
    LAS float* qtot = (LAS float*)(lds + HG_TAB); LAS float* ebm = qtot + 512; LAS float* e2t = qtot + 640;
    f32x4 S[8];
#pragma unroll
    for (int vt = 0; vt < 8; ++vt) {
        if (PASS2 && sg >= 32) {
#pragma unroll
            for (int j = 0; j < 4; ++j) S[vt][j] = SLOC[(size_t)slot * 16384 + (16 * w + 4 * quad + j) * 128 + 16 * vt + col];
        } else S[vt] = (f32x4){0.f, 0.f, 0.f, 0.f};
    }
    float bsum = 0.f;
    unsigned nlf[16], nv[16], nq[16];
#define HG_LOAD(cc) do { _Pragma("unroll") for (int e = 0; e < 16; ++e) { const int pos = 64 * (cc) + 16 * qt + e; const int row = rowbase + (d ? 255 - pos : pos); \
            const bf16_t* zr = Z + (size_t)row * NZ + 128 * h + ch; nlf[e] = zr[ZF + 512 * d]; nv[e] = zr[ZV]; if (PASS2) nq[e] = zr[ZQ]; } } while (0)
    HG_LOAD(0);
    for (int c = 0; c < 4; ++c) {
        float lf[16], cs[16], qq[16]; unsigned vraw[16];
#pragma unroll
        for (int e = 0; e < 16; ++e) { lf[e] = bf2f(nlf[e]); vraw[e] = nv[e]; if (PASS2) qq[e] = bf2f(nq[e]); }
        { float run = 0.f;
#pragma unroll
          for (int e = 0; e < 16; ++e) { run += lf[e]; cs[e] = run; } }
        qtot[qt * 128 + ch] = cs[15];
        __syncthreads();
        const float t0 = qtot[ch], t1 = qtot[128 + ch], t2 = qtot[256 + ch], t3 = qtot[384 + ch];
        const float off = qt == 0 ? 0.f : (qt == 1 ? t0 : (qt == 2 ? t0 + t1 : t0 + t1 + t2));
        const float bmid = t0 + t1, blast = (t0 + t1) + (t2 + t3);
        unsigned ktp[8], vtp[8];
#pragma unroll
        for (int e = 0; e < 16; e += 2) {
            float kt[2];
#pragma unroll
            for (int z = 0; z < 2; ++z) { const float b = off + cs[e + z]; const float kk = 1.0f - __expf(lf[e + z]); kt[z] = kk * __expf(fminf(bmid - b, 80.f));
                if (PASS2) { const int i = 16 * qt + e + z; const float qv = qq[e + z] * __expf(b - bmid);
                    *(LAS bf16_t*)(lds + HG_Q + i * HG_QP + ch * 2) = (bf16_t)(pk2(qv, 0.f) & 0xffffu);
                    *(LAS bf16_t*)(lds + HG_K + i * HG_QP + ch * 2) = (bf16_t)(pk2(kt[z], 0.f) & 0xffffu); } }
            ktp[e >> 1] = pk2(kt[0], kt[1]); vtp[e >> 1] = vraw[e] | (vraw[e + 1] << 16);
        }
        *(LAS u32x4*)(lds + HG_KT + ch * HG_SP + qt * 32) = (u32x4){ktp[0], ktp[1], ktp[2], ktp[3]};
        *(LAS u32x4*)(lds + HG_KT + ch * HG_SP + qt * 32 + 16) = (u32x4){ktp[4], ktp[5], ktp[6], ktp[7]};
        *(LAS u32x4*)(lds + HG_VT + ch * HG_SP + qt * 32) = (u32x4){vtp[0], vtp[1], vtp[2], vtp[3]};
        *(LAS u32x4*)(lds + HG_VT + ch * HG_SP + qt * 32 + 16) = (u32x4){vtp[4], vtp[5], vtp[6], vtp[7]};
        if (qt == 0) { ebm[ch] = __expf(bmid); e2t[ch] = __expf(blast - bmid); bsum += blast; }
        __syncthreads();
        if (c < 3) HG_LOAD(c + 1);
        const f32x4 eb = *(const LAS f32x4*)(ebm + 16 * w + 4 * quad), e2v = *(const LAS f32x4*)(e2t + 16 * w + 4 * quad);
#pragma unroll
        for (int vt = 0; vt < 8; ++vt) { S[vt] = S[vt] * eb;
            if (PASS2) { u32x2 sw; sw.x = pk2(S[vt][0], S[vt][1]); sw.y = pk2(S[vt][2], S[vt][3]);
                *(LAS u32x2*)(lds + HG_ST + (16 * vt + col) * HG_QP + (16 * w + 4 * quad) * 2) = sw; } }
        if (PASS2) {
#pragma unroll
            for (int ti = 0; ti < 2; ++ti) { const int id = 2 * w + ti, st = id >> 2, tt = id & 3;
                f32x4 ap = (f32x4){0.f, 0.f, 0.f, 0.f};
                if (st <= tt) {
#pragma unroll
                    for (int ks = 0; ks < 4; ++ks) { const bf16x8 a = *(const LAS bf16x8*)(lds + HG_K + (16 * st + col) * HG_QP + ks * 64 + quad * 16);
                        const bf16x8 b = *(const LAS bf16x8*)(lds + HG_Q + (16 * tt + col) * HG_QP + ks * 64 + quad * 16); ap = MFMA16(a, b, ap); }
                    const int tpos = 16 * tt + col, s0 = 16 * st + 4 * quad;
#pragma unroll
                    for (int j = 0; j < 4; ++j) ap[j] = (s0 + j <= tpos) ? ap[j] : 0.f;
                }
                u32x2 pw; pw.x = pk2(ap[0], ap[1]); pw.y = pk2(ap[2], ap[3]);
                *(LAS u32x2*)(lds + HG_P + (16 * tt + col) * HG_SP + (16 * st + 4 * quad) * 2) = pw; }
        }
        __syncthreads();
        if (PASS2) { const int tt = w >> 1;
#pragma unroll
            for (int vi = 0; vi < 4; ++vi) { const int vt = 4 * (w & 1) + vi; f32x4 ao = (f32x4){0.f, 0.f, 0.f, 0.f};
#pragma unroll
                for (int ks = 0; ks < 2; ++ks) { const bf16x8 a = *(const LAS bf16x8*)(lds + HG_VT + (16 * vt + col) * HG_SP + ks * 64 + quad * 16);
                    const bf16x8 b = *(const LAS bf16x8*)(lds + HG_P + (16 * tt + col) * HG_SP + ks * 64 + quad * 16); ao = MFMA16(a, b, ao); }
#pragma unroll
                for (int ks = 0; ks < 4; ++ks) { const bf16x8 a = *(const LAS bf16x8*)(lds + HG_ST + (16 * vt + col) * HG_QP + ks * 64 + quad * 16);
                    const bf16x8 b = *(const LAS bf16x8*)(lds + HG_Q + (16 * tt + col) * HG_QP + ks * 64 + quad * 16); ao = MFMA16(a, b, ao); }
                const int pos = 64 * c + 16 * tt + col; const int row = rowbase + (d ? 255 - pos : pos);
                u32x2 ow; ow.x = pk2(ao[0], ao[1]); ow.y = pk2(ao[2], ao[3]);
                *(u32x2*)(OB + (size_t)row * 512 + 128 * h + 16 * vt + 4 * quad) = ow; }
        }
#pragma unroll
        for (int vt = 0; vt < 8; ++vt) {
#pragma unroll
            for (int ks = 0; ks < 2; ++ks) { const bf16x8 a = *(const LAS bf16x8*)(lds + HG_KT + (16 * w + col) * HG_SP + ks * 64 + quad * 16);
                const bf16x8 b = *(const LAS bf16x8*)(lds + HG_VT + (16 * vt + col) * HG_SP + ks * 64 + quad * 16); S[vt] = MFMA16(a, b, S[vt]); }
            S[vt] = S[vt] * e2v; }
    }
#undef HG_LOAD
    if (!PASS2) {
#pragma unroll
        for (int vt = 0; vt < 8; ++vt)
#pragma unroll
            for (int j = 0; j < 4; ++j) SLOC[(size_t)slot * 16384 + (16 * w + 4 * quad + j) * 128 + 16 * vt + col] = S[vt][j];
        if (qt == 0) BSEG[slot * 128 + ch] = bsum;
    } else if (sg < 32) {
        float* o = P.out + OUT_SH + (size_t)((sg * 2 + d) * 4 + h) * 16384;
#pragma unroll
        for (int vt = 0; vt < 8; ++vt)
#pragma unroll
            for (int j = 0; j < 4; ++j) o[(16 * w + 4 * quad + j) * 128 + 16 * vt + col] = S[vt][j];
    }
    __syncthreads();
}
__device__ __forceinline__ void hgrn_carry(const Params& P) {
    float* SLOC = (float*)(P.ws + WS_A2); const float* BSEG = (const float*)(P.ws + WS_BSEG);
    const int gt = blockIdx.x * 512 + threadIdx.x, NT = gridDim.x * 512;
    for (int idx = gt; idx < 64 * 16384; idx += NT) { const int chain = idx >> 14, e = idx & 16383, b = chain >> 3, h = (chain >> 1) & 3, d = chain & 1, k = e >> 7;
        float run = P.in[I_SH][(size_t)((b * 2 + d) * 4 + h) * 16384 + e];
        for (int jj = 0; jj < 16; ++jj) { const int ks = d ? 15 - jj : jj; const int slot = ((b * 16 + ks) << 3) | (h << 1) | d;
            const float tmp = SLOC[(size_t)slot * 16384 + e]; SLOC[(size_t)slot * 16384 + e] = run; run = __expf(BSEG[slot * 128 + k]) * run + tmp; } }
}

template <bool PASS2>
__device__ __forceinline__ void s5_task(const Params& P, LAS unsigned char* img, int task) {
    const int lane = threadIdx.x & 63, n = lane & 31, hh = lane >> 5;
    const int d = task & 1, g = (task >> 1) & 31, pr = task >> 6;
    const int segA = PASS2 ? 2 * pr : 32 + 2 * pr, myseg = segA + hh;
    const bf16_t* Z = (const bf16_t*)(P.ws + WS_Z);
    float* XLOC = (float*)(P.ws + WS_XLOC);
    const int dg = d * 32 + g;
    const float dt = __expf(P.in[I_LDT][dg]);
    float lr[2], li[2], xr[2], xi[2]; bf16x8 Bf[4], Cf[4][2];
    float cre[2], cim[2];
#pragma unroll
    for (int pp = 0; pp < 2; ++pp) { const int p = 32 * pp + n; const float lre = P.in[I_LRE][dg * 64 + p], lim = P.in[I_LIM][dg * 64 + p];
        const float mag = expf(lre * dt); float sn, cs; sincosf(lim * dt, &sn, &cs); lr[pp] = mag * cs; li[pp] = mag * sn;
        const float den = lre * lre + lim * lim; cre[pp] = ((lr[pp] - 1.0f) * lre + li[pp] * lim) / den; cim[pp] = (li[pp] * lre - (lr[pp] - 1.0f) * lim) / den; }
#pragma unroll
    for (int jt = 0; jt < 4; ++jt) { const int pp = jt & 1, part = jt >> 1, p = 32 * pp + n; float v[8];
        const float* br = P.in[I_BRE] + (size_t)(dg * 64 + p) * 16 + 8 * hh; const float* bi = P.in[I_BIM] + (size_t)(dg * 64 + p) * 16 + 8 * hh;
#pragma unroll
        for (int j = 0; j < 8; ++j) v[j] = part ? (cre[pp] * bi[j] + cim[pp] * br[j]) : (cre[pp] * br[j] - cim[pp] * bi[j]);
        Bf[jt] = __builtin_bit_cast(bf16x8, pack8(v)); }
    if (PASS2) {
#pragma unroll
        for (int jt = 0; jt < 4; ++jt)
#pragma unroll
            for (int s = 0; s < 2; ++s) { const int part = jt >> 1, p0 = 32 * (jt & 1) + 16 * s + 8 * hh; float v[8];
                const float* cp = (part ? P.in[I_CIM] : P.in[I_CRE]) + (size_t)(dg * 16 + (n & 15)) * 64 + p0;
#pragma unroll
                for (int j = 0; j < 8; ++j) { const float c = cp[j]; v[j] = n < 16 ? (part ? -c : c) : 0.f; }
                Cf[jt][s] = __builtin_bit_cast(bf16x8, pack8(v)); }
    }
#pragma unroll
    for (int pp = 0; pp < 2; ++pp) { xr[pp] = 0.f; xi[pp] = 0.f; }
    if (PASS2 && myseg >= 32) { const int sb = (myseg - 32) >> 4, sk = (myseg - 32) & 15;
#pragma unroll
        for (int pp = 0; pp < 2; ++pp) { const int p = 32 * pp + n;
            float ar = lr[pp], ai = li[pp];
#pragma unroll
            for (int q = 0; q < 8; ++q) { const float nr = ar * ar - ai * ai, ni = 2.0f * ar * ai; ar = nr; ai = ni; }
            float sr = P.in[I_SRE][(size_t)((sb * 2 + d) * 32 + g) * 64 + p], si = P.in[I_SIM][(size_t)((sb * 2 + d) * 32 + g) * 64 + p];
            const int cnt = d ? 15 - sk : sk;
            for (int jj = 0; jj < cnt; ++jj) { const int ks = d ? 15 - jj : jj; const float* xl = XLOC + (size_t)(((sb * 16 + ks) * 32 + g) * 2 + d) * 128;
                const float nr = ar * sr - ai * si + xl[p], ni = ar * si + ai * sr + xl[64 + p]; sr = nr; si = ni; }
            xr[pp] = sr; xi[pp] = si; }
    }
    const int arow_seg = segA + ((n >> 2) & 1), arow_pos = (n & 3) + 4 * (n >> 3);
    const int abase = seg_rowbase(arow_seg), mybase = seg_rowbase(myseg);
    bf16_t* YD = (bf16_t*)P.out + (size_t)d * M * 512;
    const unsigned ibase = (unsigned)(uintptr_t)img;
    const int i16 = lane & 15, q4 = i16 >> 2, p4 = i16 & 3, blk = (lane >> 4) & 1;
    const bf16_t* zu = Z + ZU + g * 16 + 8 * hh;
    bf16x8 aq[4];
#pragma unroll
    for (int u = 0; u < 4; ++u) { const int apos = 16 * u + arow_pos; aq[u] = *(const bf16x8*)(zu + (size_t)(abase + (d ? 255 - apos : apos)) * NZ); }
#pragma nounroll
    for (int tl = 0; tl < 16; ++tl) {
        const bf16x8 a = aq[0];
        aq[0] = aq[1]; aq[1] = aq[2]; aq[2] = aq[3];
        { const int apos = 16 * (tl < 12 ? tl + 4 : 15) + arow_pos; aq[3] = *(const bf16x8*)(zu + (size_t)(abase + (d ? 255 - apos : apos)) * NZ); }
        f32x16 bu[4];
#pragma unroll
        for (int jt = 0; jt < 4; ++jt) { f32x16 z;
#pragma unroll
            for (int i = 0; i < 16; ++i) z[i] = 0.f;
            bu[jt] = MFMA32(a, Bf[jt], z); }
        asm volatile("s_nop 15" : "+v"(bu[0]), "+v"(bu[1]), "+v"(bu[2]), "+v"(bu[3]));
#pragma unroll
        for (int i = 0; i < 16; ++i)
#pragma unroll
            for (int pp = 0; pp < 2; ++pp) { const float nr = lr[pp] * xr[pp] - li[pp] * xi[pp] + bu[pp][i], ni = lr[pp] * xi[pp] + li[pp] * xr[pp] + bu[2 + pp][i];
                xr[pp] = nr; xi[pp] = ni; bu[pp][i] = nr; bu[2 + pp][i] = ni; }
        if (PASS2) {
#pragma unroll
            for (int jt = 0; jt < 4; ++jt)
#pragma unroll
                for (int g4 = 0; g4 < 4; ++g4) { u32x2 v; v.x = pk2(bu[jt][4 * g4], bu[jt][4 * g4 + 1]); v.y = pk2(bu[jt][4 * g4 + 2], bu[jt][4 * g4 + 3]);
                    *(LAS u32x2*)(img + jt * 2048 + n * 64 + 8 * (2 * g4 + hh)) = v; }
            LDS_WAIT();
            f32x16 y0, y1;
#pragma unroll
            for (int i = 0; i < 16; ++i) { y0[i] = 0.f; y1[i] = 0.f; }
            s16x4 r[16];
            { const unsigned b0 = ibase + 8 * (4 * blk + p4) + (8 * hh + q4) * 64;
              asm volatile("ds_read_b64_tr_b16 %0, %16\n\tds_read_b64_tr_b16 %1, %16 offset:256\n\tds_read_b64_tr_b16 %2, %16 offset:1024\n\tds_read_b64_tr_b16 %3, %16 offset:1280\n\t"
                           "ds_read_b64_tr_b16 %4, %16 offset:2048\n\tds_read_b64_tr_b16 %5, %16 offset:2304\n\tds_read_b64_tr_b16 %6, %16 offset:3072\n\tds_read_b64_tr_b16 %7, %16 offset:3328\n\t"
                           "ds_read_b64_tr_b16 %8, %16 offset:4096\n\tds_read_b64_tr_b16 %9, %16 offset:4352\n\tds_read_b64_tr_b16 %10, %16 offset:5120\n\tds_read_b64_tr_b16 %11, %16 offset:5376\n\t"
                           "ds_read_b64_tr_b16 %12, %16 offset:6144\n\tds_read_b64_tr_b16 %13, %16 offset:6400\n\tds_read_b64_tr_b16 %14, %16 offset:7168\n\tds_read_b64_tr_b16 %15, %16 offset:7424\n\ts_waitcnt lgkmcnt(0)"
                           : "=&v"(r[0]), "=&v"(r[1]), "=&v"(r[2]), "=&v"(r[3]), "=&v"(r[4]), "=&v"(r[5]), "=&v"(r[6]), "=&v"(r[7]),
                             "=&v"(r[8]), "=&v"(r[9]), "=&v"(r[10]), "=&v"(r[11]), "=&v"(r[12]), "=&v"(r[13]), "=&v"(r[14]), "=&v"(r[15])
                           : "v"(b0) : "memory"); }
#pragma unroll
            for (int jt = 0; jt < 4; ++jt) {
                const bf16x8 xa0 = __builtin_shufflevector(r[4 * jt], r[4 * jt + 1], 0, 1, 2, 3, 4, 5, 6, 7), xa1 = __builtin_shufflevector(r[4 * jt + 2], r[4 * jt + 3], 0, 1, 2, 3, 4, 5, 6, 7);
                y0 = MFMA32(Cf[jt][0], xa0, y0); y1 = MFMA32(Cf[jt][1], xa1, y1); }
            asm volatile("s_nop 15" : "+v"(y0), "+v"(y1));
            { const int ypos = 16 * tl + arow_pos; const int yrow = abase + (d ? 255 - ypos : ypos);
              bf16_t* yp = YD + (size_t)yrow * 512 + g * 16 + 4 * hh;
              u32x2 w0, w1; w0.x = pk2(y0[0] + y1[0], y0[1] + y1[1]); w0.y = pk2(y0[2] + y1[2], y0[3] + y1[3]); w1.x = pk2(y0[4] + y1[4], y0[5] + y1[5]); w1.y = pk2(y0[6] + y1[6], y0[7] + y1[7]);
              *(u32x2*)yp = w0; *(u32x2*)(yp + 8) = w1; }
        }
    }
    if (!PASS2) { float* xl = XLOC + (size_t)(((myseg - 32) * 32 + g) * 2 + d) * 128;
#pragma unroll
        for (int pp = 0; pp < 2; ++pp) { xl[32 * pp + n] = xr[pp]; xl[64 + 32 * pp + n] = xi[pp]; }
    } else if (myseg < 32) {
#pragma unroll
        for (int pp = 0; pp < 2; ++pp) { const size_t o = (size_t)((myseg * 2 + d) * 32 + g) * 64 + 32 * pp + n; P.out[OUT_SRE + o] = xr[pp]; P.out[OUT_SIM + o] = xi[pp]; }
    }
}

__device__ __forceinline__ float fgelu_tanh(float y) { const float z = 0.7978845608f * (y + 0.044715f * y * y * y); const float t = 1.0f - 2.0f * __builtin_amdgcn_rcpf(1.0f + __expf(2.0f * z)); return 0.5f * y * (1.0f + t); }
__device__ __forceinline__ void phase_combine(const Params& P) {
    const int lane = threadIdx.x & 63, gw = blockIdx.x * 8 + (threadIdx.x >> 6), NGW = gridDim.x * 8, c0 = lane * 8;
    const bf16_t* OF = (const bf16_t*)(P.ws + WS_H); const bf16_t* OBk = OF + (size_t)M * 512;
    const bf16_t* YF = (const bf16_t*)P.out; const bf16_t* YB = YF + (size_t)M * 512;
    const bf16_t* Z = (const bf16_t*)(P.ws + WS_Z); bf16_t* A2 = (bf16_t*)(P.ws + WS_A2); bf16_t* YBF = (bf16_t*)(P.ws + WS_YBF);
    float hg[8], dsk[8];
#pragma unroll
    for (int e = 0; e < 8; ++e) { hg[e] = P.in[I_HG][c0 + e]; dsk[e] = P.in[I_S5D][c0 + e]; }
    for (int m = gw; m < M; m += NGW) {
        float a[8], b[8], ga[8], o[8];
        unpack8(*(const u32x4*)(OF + (size_t)m * 512 + c0), a); unpack8(*(const u32x4*)(OBk + (size_t)m * 512 + c0), b); unpack8(*(const u32x4*)(Z + (size_t)m * NZ + ZGA + c0), ga);
        float ss = 0.f;
#pragma unroll
        for (int e = 0; e < 8; ++e) { a[e] += b[e]; ss += a[e] * a[e]; }
        ss += __shfl_xor(ss, 1); ss += __shfl_xor(ss, 2); ss += __shfl_xor(ss, 4); ss += __shfl_xor(ss, 8);
        const float r = rsqrtf(ss * (1.0f / 128.0f) + EPS);
#pragma unroll
        for (int e = 0; e < 8; ++e) o[e] = a[e] * r * hg[e] * ga[e];
        *(u32x4*)(A2 + (size_t)m * 1024 + c0) = pack8(o);
        float yf[8], yb[8], uu[8], y[8];
        unpack8(*(const u32x4*)(YF + (size_t)m * 512 + c0), yf); unpack8(*(const u32x4*)(YB + (size_t)m * 512 + c0), yb); unpack8(*(const u32x4*)(Z + (size_t)m * NZ + ZU + c0), uu);
#pragma unroll
        for (int e = 0; e < 8; ++e) y[e] = fgelu_tanh(yf[e] + yb[e] + dsk[e] * uu[e]);
        *(u32x4*)(YBF + (size_t)m * 512 + c0) = pack8(y);
    }
}
__device__ __forceinline__ void phase_conv(const Params& P) {
    const bf16_t* PB = (const bf16_t*)(P.ws + WS_Z + 160 * MiB); const bf16_t* GB = (const bf16_t*)(P.ws + WS_A2); bf16_t* A3 = (bf16_t*)(P.ws + WS_H);
    const int gt = blockIdx.x * 512 + threadIdx.x, NT = gridDim.x * 512;
    for (int idx = gt; idx < M * 128; idx += NT) { const int row = idx >> 7, c0 = (idx & 127) * 8;
        const int pos = row < MP ? (row & 255) : ((row - MP) & 63), L = row < MP ? 256 : 64;
        float p0[8], p1[8], p2[8], gg[8], o[8];
        const u32x4 zero = (u32x4){0u, 0u, 0u, 0u};
        unpack8(pos > 0 ? *(const u32x4*)(PB + (size_t)(row - 1) * D + c0) : zero, p0);
        unpack8(*(const u32x4*)(PB + (size_t)row * D + c0), p1);
        unpack8(pos < L - 1 ? *(const u32x4*)(PB + (size_t)(row + 1) * D + c0) : zero, p2);
        unpack8(*(const u32x4*)(GB + (size_t)row * D + c0), gg);
        const float* cw = P.in[I_CW] + c0; const float* cb = P.in[I_CB] + c0;
#pragma unroll
        for (int e = 0; e < 8; ++e) o[e] = gg[e] * (cw[e] * p0[e] + cw[1024 + e] * p1[e] + cw[2048 + e] * p2[e] + cb[e]);
        *(u32x4*)(A3 + (size_t)row * D + c0) = pack8(o); }
}

#define XB_TMO      128
#define XB_XCNT(j)  (256  + 64 * (j))
#define XB_XSUB(j)  (1280 + 64 * (j))
#define XB_XGEN(j)  (2304 + 64 * (j))
#define XB_TOP      3328
#define XB_TOPGEN   3392
#define XCD_BAR_WORDS 3456
#define XB_SPIN_CAP (1u << 18)

__device__ __forceinline__ unsigned xb_ld(unsigned* p)              { return __hip_atomic_load(p, __ATOMIC_RELAXED, __HIP_MEMORY_SCOPE_AGENT); }
__device__ __forceinline__ unsigned xb_add(unsigned* p, unsigned v) { return __hip_atomic_fetch_add(p, v, __ATOMIC_RELAXED, __HIP_MEMORY_SCOPE_AGENT); }
__device__ __forceinline__ unsigned xb_xcc_id() { return (unsigned)__builtin_amdgcn_s_getreg((3 << 11) | 20) & 0xFu; }
#define XB_SPIN(cond, bar) do { unsigned _sp = 0; while (cond) { __builtin_amdgcn_s_sleep(1); \
    if ((++_sp & 255u) == 0u) { if (xb_ld(&(bar)[XB_TMO])) break; if (_sp > XB_SPIN_CAP) { atomicAdd(&(bar)[XB_TMO], 1u); break; } } } } while (0)

struct XcdBarrier {
    unsigned* bar; unsigned x;
    volatile LAS unsigned* st;
};

__device__ __forceinline__ XcdBarrier xcd_barrier_post(unsigned* bar, volatile LAS unsigned* st) {
    XcdBarrier b; b.bar = bar; b.x = xb_xcc_id(); b.st = st;
    if (threadIdx.x == 0) (void)xb_add(&bar[XB_XCNT(b.x)], 1u);
    return b;
}
__device__ __forceinline__ void xcd_barrier_complete(unsigned* bar, unsigned x, unsigned& nloc, unsigned& nx) {
    const unsigned G = gridDim.x * gridDim.y * gridDim.z;
    unsigned sum, cnt, mine, sp = 0u;
    for (;;) {
        sum = 0u; cnt = 0u; mine = 0u;
#pragma unroll
        for (unsigned j = 0; j < 16; ++j) { const unsigned c = xb_ld(&bar[XB_XCNT(j)]); sum += c; cnt += (c > 0u) ? 1u : 0u; mine = (j == x) ? c : mine; }
        if (sum == G) break;
        __builtin_amdgcn_s_sleep(1);
        if ((++sp & 255u) == 0u) { if (xb_ld(&bar[XB_TMO])) break; if (sp > XB_SPIN_CAP) { atomicAdd(&bar[XB_TMO], 1u); break; } }
    }
    nloc = mine > 0u ? mine : 1u; nx = cnt > 0u ? cnt : 1u;
}

__device__ __forceinline__ void xcd_barrier(const XcdBarrier& b) {
    asm volatile("s_waitcnt vmcnt(0)" ::: "memory");
    __syncthreads();
    if (threadIdx.x == 0) {
        unsigned* bar = b.bar;
        __builtin_amdgcn_s_waitcnt(0);
        unsigned nloc = b.st[0], nx = b.st[1];
        if (nloc == 0u) { xcd_barrier_complete(bar, b.x, nloc, nx); b.st[0] = nloc; b.st[1] = nx; }
        const unsigned old = xb_add(&bar[XB_XSUB(b.x)], 1u);
        const unsigned gen = old / nloc;
        if (old + 1u == (gen + 1u) * nloc) {
            __builtin_amdgcn_fence(__ATOMIC_RELEASE, "agent");
            asm volatile("s_waitcnt vmcnt(0)" ::: "memory");
            const unsigned og = xb_add(&bar[XB_TOP], 1u);
            const unsigned tg = og / nx;
            if (og + 1u == (tg + 1u) * nx) xb_add(&bar[XB_TOPGEN], 1u);
            else XB_SPIN(xb_ld(&bar[XB_TOPGEN]) == tg, bar);
            __builtin_amdgcn_fence(__ATOMIC_ACQUIRE, "agent");
            xb_add(&bar[XB_XGEN(b.x)], 1u);
            asm volatile("s_waitcnt vmcnt(0)" ::: "memory");
        } else {
            XB_SPIN(xb_ld(&bar[XB_XGEN(b.x)]) == gen, bar);
            __builtin_amdgcn_fence(__ATOMIC_ACQUIRE, "agent");
            asm volatile("s_waitcnt vmcnt(0)" ::: "memory");
        }
    }
    __syncthreads();
}


constexpr int LDS_BYTES = 133120;
constexpr int NPHASE = 14;
__global__ void __launch_bounds__(512, 2) mk_fwd(Params P) {
    extern __shared__ __attribute__((aligned(16))) unsigned char lds_raw[];
    LAS unsigned char* lds = (LAS unsigned char*)lds_raw;
    cg::grid_group grid = cg::this_grid();
    const int lo = P.ph_lo, hi = P.ph_hi;
    if (threadIdx.x < 4) ((LAS unsigned*)(lds + 131072))[threadIdx.x] = 0u;
    __syncthreads();
    XcdBarrier bar = xcd_barrier_post((unsigned*)P.ws + P.li * XCD_BAR_WORDS, (volatile LAS unsigned*)(lds + 131072));
    if (hi < 0) grid.sync();
    const int wave = threadIdx.x >> 6;
    bf16_t* H = (bf16_t*)(P.ws + WS_H); bf16_t* Zb = (bf16_t*)(P.ws + WS_Z); bf16_t* A2 = (bf16_t*)(P.ws + WS_A2); bf16_t* YBF = (bf16_t*)(P.ws + WS_YBF);
    float* MOD = (float*)(P.ws + WS_MOD); float* Y1 = (float*)(P.ws + WS_Z);
#ifndef PHMASK
#define PHMASK 0x3fff
#endif
#ifndef DBLMASK
#define DBLMASK 0
#endif
#define IN(k) ((PHMASK & (1 << (k))) && lo <= (k) && (k) < hi)
#ifdef USE_CG_SYNC
#define SEAM(k) do { if (lo <= (k) && (k) + 1 < hi) grid.sync(); } while (0)
#else
#define SEAM(k) do { if (lo <= (k) && (k) + 1 < hi) xcd_barrier(bar); } while (0)
#endif
    if (IN(0)) _Pragma("nounroll") for (int rep_ = 0; rep_ < 1 + ((DBLMASK >> 0) & 1); ++rep_) phase0(P, lds);
    SEAM(0);
    if (IN(1)) _Pragma("nounroll") for (int rep_ = 0; rep_ < 1 + ((DBLMASK >> 1) & 1); ++rep_) phase_norm(P.in[I_XP], P.in[I_XS], P.in[I_NORMG], MOD, H);
    SEAM(1);
    if (IN(2)) _Pragma("nounroll") for (int rep_ = 0; rep_ < 1 + ((DBLMASK >> 2) & 1); ++rep_) { pg8::Gemm g{H, (const bf16_t*)(P.ws + WS_WIN_E), M, NZ, 1024}; pg8::StaticOrder S; S.init(M, NZ, gridDim.x, blockIdx.x);
        EpiZ E{Zb, P.in[I_LB]}; pg8::gemm_phase<EpiZ, pg8::StaticOrder>(lds, g, S, E); }
    SEAM(2);
    if (IN(3)) _Pragma("nounroll") for (int rep_ = 0; rep_ < 1 + ((DBLMASK >> 3) & 1); ++rep_) {
        _Pragma("nounroll") for (int r2_ = 0; r2_ < 1 + ((DBLMASK >> 14) & 1); ++r2_)
        for (int t = blockIdx.x; t < 1024; t += gridDim.x) hgrn_task<false>(P, lds, t);
        _Pragma("nounroll") for (int r2_ = 0; r2_ < 1 + ((DBLMASK >> 15) & 1); ++r2_)
        for (int t = blockIdx.x * 8 + wave; t < 4096; t += gridDim.x * 8) s5_task<false>(P, lds + wave * 8192, t);
    }
    SEAM(3);
    if (IN(4)) _Pragma("nounroll") for (int rep_ = 0; rep_ < 1 + ((DBLMASK >> 4) & 1); ++rep_) hgrn_carry(P);
    SEAM(4);
    if (IN(5)) _Pragma("nounroll") for (int rep_ = 0; rep_ < 1 + ((DBLMASK >> 5) & 1); ++rep_) {
        _Pragma("nounroll") for (int r2_ = 0; r2_ < 1 + ((DBLMASK >> 16) & 1); ++r2_)
        for (int t = blockIdx.x; t < 1280; t += gridDim.x) hgrn_task<true>(P, lds, t);
        _Pragma("nounroll") for (int r2_ = 0; r2_ < 1 + ((DBLMASK >> 17) & 1); ++r2_)
        for (int t = blockIdx.x * 8 + wave; t < 5120; t += gridDim.x * 8) s5_task<true>(P, lds + wave * 8192, t);
    }
    SEAM(5);
    if (IN(6)) _Pragma("nounroll") for (int rep_ = 0; rep_ < 1 + ((DBLMASK >> 6) & 1); ++rep_) phase_combine(P);
    SEAM(6);
    if (IN(7)) _Pragma("nounroll") for (int rep_ = 0; rep_ < 1 + ((DBLMASK >> 7) & 1); ++rep_) { pg8::Gemm g{YBF, (const bf16_t*)(P.ws + WS_WGLU), M, 512, 512}; pg8::StaticOrder S; S.init(M, 512, gridDim.x, blockIdx.x);
        EpiGlu E{YBF, Zb, P.in[I_BGLU], A2}; pg8::gemm_phase<EpiGlu, pg8::StaticOrder>(lds, g, S, E); }
    SEAM(7);
    if (IN(8)) _Pragma("nounroll") for (int rep_ = 0; rep_ < 1 + ((DBLMASK >> 8) & 1); ++rep_) { pg8::Gemm g{A2, (const bf16_t*)(P.ws + WS_WOUT_E), M, 1024, 1024}; pg8::StaticOrder S; S.init(M, 1024, gridDim.x, blockIdx.x);
        EpiRes E{P.in[I_XP], P.in[I_XS], MOD + 2048, Y1}; pg8::gemm_phase<EpiRes, pg8::StaticOrder>(lds, g, S, E); }
    SEAM(8);
    if (IN(9)) _Pragma("nounroll") for (int rep_ = 0; rep_ < 1 + ((DBLMASK >> 9) & 1); ++rep_) phase_norm(Y1, Y1 + (size_t)MP * D, P.in[I_NORMG] + 1024, MOD + 9 * 3072, H);
    SEAM(9);
    if (IN(10)) _Pragma("nounroll") for (int rep_ = 0; rep_ < 1 + ((DBLMASK >> 10) & 1); ++rep_) { pg8::Gemm g{H, (const bf16_t*)(P.ws + WS_WIN_O), M, 4096, 1024}; pg8::StaticOrder S; S.init(M, 4096, gridDim.x, blockIdx.x);
        EpiOdd E{(bf16_t*)(P.ws + WS_Z + 160 * MiB), A2}; pg8::gemm_phase<EpiOdd, pg8::StaticOrder>(lds, g, S, E); }
    SEAM(10);
    if (IN(11)) _Pragma("nounroll") for (int rep_ = 0; rep_ < 1 + ((DBLMASK >> 11) & 1); ++rep_) phase_conv(P);
    SEAM(11);
    if (IN(12)) _Pragma("nounroll") for (int rep_ = 0; rep_ < 1 + ((DBLMASK >> 12) & 1); ++rep_) { pg8::Gemm g{H, (const bf16_t*)(P.ws + WS_WOUT_O), M, 1024, 1024}; pg8::StaticOrder S; S.init(M, 1024, gridDim.x, blockIdx.x);
        EpiRes E{Y1, Y1 + (size_t)MP * D, MOD + 9 * 3072 + 2048, P.out}; pg8::gemm_phase<EpiRes, pg8::StaticOrder>(lds, g, S, E); }
    SEAM(12);
#ifdef PROBE_SYNCS
    for (int i_ = 0; i_ < PROBE_SYNCS; ++i_) xcd_barrier(bar);
#endif
    if (IN(13)) _Pragma("nounroll") for (int rep_ = 0; rep_ < 1 + ((DBLMASK >> 13) & 1); ++rep_) phase_final_norm(P.out, P.in[I_FNG]);
#undef IN
#undef SEAM
}

extern "C" void kernel_launch(void* const* d_in, const int* in_sizes, int n_in, void* d_out, int out_size, void* d_ws, size_t ws_size, hipStream_t stream) {
    static int grid = 0;
    if (grid == 0) {
        if (n_in != 29 || ws_size < WS_END) { fprintf(stderr, "kernel_launch: unexpected n_in %d / ws_size %zu (need %zu)\n", n_in, ws_size, (size_t)WS_END); grid = -1; return; }
        int dev = 0, cus = 0, per_cu = 0;
        hipGetDevice(&dev); hipDeviceGetAttribute(&cus, hipDeviceAttributeMultiprocessorCount, dev);
        if (hipFuncSetAttribute((const void*)mk_fwd, hipFuncAttributeMaxDynamicSharedMemorySize, LDS_BYTES) != hipSuccess) { fprintf(stderr, "kernel_launch: hipFuncSetAttribute failed\n"); grid = -1; return; }
        if (hipOccupancyMaxActiveBlocksPerMultiprocessor(&per_cu, (const void*)mk_fwd, 512, LDS_BYTES) != hipSuccess || per_cu < 1) { fprintf(stderr, "kernel_launch: occupancy query says %d\n", per_cu); per_cu = 1; }
        (void)hipGetLastError();
        grid = cus * per_cu;
        fprintf(stderr, "kernel_launch: grid %d (cus %d x %d)\n", grid, cus, per_cu);
    }
    if (grid < 0) return;
    Params p{};
    (void)hipMemsetAsync(d_ws, 0, 65536, stream);
    for (int i = 0; i < 29; ++i) p.in[i] = (const float*)d_in[i];
    p.out = (float*)d_out; p.ws = (unsigned char*)d_ws;
#if MK_COOP
    void* args[] = {&p};
#ifdef PROBE_SPLIT
    p.ph_lo = 0; p.ph_hi = PROBE_SPLIT + 1;
    (void)hipLaunchCooperativeKernel((const void*)mk_fwd, dim3(grid), dim3(512), args, LDS_BYTES, stream);
    p.ph_lo = PROBE_SPLIT; p.ph_hi = NPHASE; p.li = 1;
#else
    p.ph_lo = 0; p.ph_hi = NPHASE;
#endif
    hipError_t e = hipLaunchCooperativeKernel((const void*)mk_fwd, dim3(grid), dim3(512), args, LDS_BYTES, stream);
    if (e != hipSuccess) fprintf(stderr, "kernel_launch: cooperative launch failed: %s (grid %d)\n", hipGetErrorString(e), grid);
#else
    for (int ph = 0; ph < NPHASE; ++ph) { p.ph_lo = ph; p.ph_hi = ph + 1; hipLaunchKernelGGL(mk_fwd, dim3(grid), dim3(512), LDS_BYTES, stream, p); }
#endif
}
```

```cpp
#include <hip/hip_runtime.h>
#include <hip/hip_cooperative_groups.h>
#include <cstdio>
#include <cstdint>
namespace cg = cooperative_groups;
#ifndef MK_COOP
#define MK_COOP 1
#endif

namespace pg8 {
#define PG8_LAS __attribute__((address_space(3)))
typedef unsigned short bf16_t;
typedef short bf16x8 __attribute__((ext_vector_type(8)));
typedef float f32x4 __attribute__((ext_vector_type(4)));
typedef unsigned u32x4 __attribute__((ext_vector_type(4)));
constexpr int BM = 256, BK = 64, HALF = 128, HTB = HALF * BK * 2  , STAGE_BYTES = 8 * HTB, NXCD = 8, WGM = 8;

__host__ __device__ __forceinline__ int lds_byte(int r, int c) { const int st = (r >> 4) * 2 + (c >> 5), rr = r & 15, cc = c & 31, ob = rr * 64 + cc * 2; return st * 1024 + (ob ^ (((ob >> 9) & 1) << 5)); }
__host__ __device__ __forceinline__ void stage_rc(int b, int& R, int& C) { const int st = b / 1024, sb = b % 1024, swz = sb ^ (((sb >> 9) & 1) << 5); R = (st >> 1) * 16 + swz / 64; C = (st & 1) * 32 + (swz % 64) / 2; }
__host__ __device__ __forceinline__ int perm32(int rho) { const int n = rho >> 4, i = rho & 15; return 8 * (i >> 2) + 4 * n + (i & 3); }

struct Unit { int pm, pn; };
struct Gemm { const bf16_t* A; const bf16_t* Bt; int M, N, K; };

struct StaticOrder {
    int nM, nN, nwg, G, c;
    __host__ __device__ void init(int M, int N, int G_, int c_) { nM = M / BM; nN = N / BM; nwg = nM * nN; G = G_; c = c_; }
    __host__ __device__ bool next(int i, Unit& u) const {
        const long L = (long)i * G + c; if (L >= nwg) return false;
        int wgid = (int)L; { const int q = nwg / NXCD, r = nwg % NXCD, xcd = wgid % NXCD, off = wgid / NXCD; wgid = (xcd < r ? xcd * (q + 1) : r * (q + 1) + (xcd - r) * q) + off; }
        const int nig = WGM * nN, gid = wgid / nig, fm = gid * WGM, gsz = (nM - fm) < WGM ? (nM - fm) : WGM;
        u.pm = fm + ((wgid % nig) % gsz); u.pn = (wgid % nig) / gsz; return true;
    }
    __device__ __forceinline__ void a_ready(const Unit&) const {}
    __device__ __forceinline__ void done(const Unit&) const {}
};

__device__ __forceinline__ unsigned cvt_pk_bf16(float lo, float hi) { unsigned r; asm volatile("v_cvt_pk_bf16_f32 %0, %1, %2" : "=v"(r) : "v"(lo), "v"(hi)); return r; }

template <class Epi, class Sched>
__device__ __forceinline__ void gemm_phase(PG8_LAS unsigned char* lds, const Gemm g, const Sched& S, const Epi& E) {
    const int tid = threadIdx.x, wid = __builtin_amdgcn_readfirstlane(tid >> 6), lane = tid & 63, wr = wid >> 2, wc = wid & 3, fr = lane & 15, fq = lane >> 4;
    const int K = g.K, nt = K / BK;
    unsigned voffA[2], voffB[2];
#pragma unroll
    for (int i = 0; i < 2; ++i) { int R, C; stage_rc(tid * 16 + i * 8192, R, C); const int Rb = Epi::PERM ? ((R & ~31) + perm32(R & 31)) : R;
        voffA[i] = (unsigned)(R * K + C) * 2u; voffB[i] = (unsigned)(Rb * K + C) * 2u; }
    const size_t kstep = (size_t)(BK * 2);
    const size_t hstep = (size_t)HALF * K * 2;
    const size_t tstep = 2 * hstep;
    const unsigned ldsw = (unsigned)wid * 1024u;
    const int aoff = lds_byte(wr * 64 + fr, fq * 8), boff = lds_byte(wc * 32 + fr, fq * 8);
#define PG8_SA(b, h) (((b) * 2 + (h)) * HTB)
#define PG8_SB(b, h) ((4 + (b) * 2 + (h)) * HTB)
#define PG8_STAGE(bufoff, gbase, voff) do { _Pragma("unroll") for (int _i = 0; _i < 2; ++_i) \
        __builtin_amdgcn_global_load_lds((const unsigned*)((const char*)(gbase) + (voff)[_i]), (PG8_LAS unsigned*)(lds + (bufoff) + ldsw + _i * 8192), 16, 0, 0); } while (0)
#define PG8_LDA(dst, b, h) do { _Pragma("unroll") for (int m = 0; m < 4; ++m) _Pragma("unroll") for (int k = 0; k < 2; ++k) dst[m][k] = *(const PG8_LAS bf16x8*)(lds + PG8_SA(b, h) + aoff + m * 2048 + k * 1024); } while (0)
#define PG8_LDB(dst, b, h) do { _Pragma("unroll") for (int n = 0; n < 2; ++n) _Pragma("unroll") for (int k = 0; k < 2; ++k) dst[n][k] = *(const PG8_LAS bf16x8*)(lds + PG8_SB(b, h) + boff + n * 2048 + k * 1024); } while (0)
#define PG8_MMA(ai, bj, At, Bt) do { __builtin_amdgcn_s_setprio(1); _Pragma("unroll") for (int m = 0; m < 4; ++m) _Pragma("unroll") for (int n = 0; n < 2; ++n) _Pragma("unroll") for (int k = 0; k < 2; ++k) \
        acc[ai][bj][m][n] = __builtin_amdgcn_mfma_f32_16x16x32_bf16(Bt[n][k], At[m][k], acc[ai][bj][m][n], 0, 0, 0); __builtin_amdgcn_s_setprio(0); } while (0)
#define PG8_WAIT_V(n) asm volatile("s_waitcnt vmcnt(" #n ")" ::: "memory")
#define PG8_WAIT_L(n) asm volatile("s_waitcnt lgkmcnt(" #n ")" ::: "memory")
#define PG8_BAR __builtin_amdgcn_s_barrier()
#define PG8_SCHED __builtin_amdgcn_sched_barrier(0)
    Unit cur, nxt; int ui = 0;
    if (!S.next(0, cur)) return;
    f32x4 acc[2][2][4][2];
#pragma unroll
    for (int a = 0; a < 2; ++a)
#pragma unroll
        for (int b = 0; b < 2; ++b)
#pragma unroll
            for (int m = 0; m < 4; ++m)
#pragma unroll
                for (int n = 0; n < 2; ++n) acc[a][b][m][n] = (f32x4){0.f, 0.f, 0.f, 0.f};
    bf16x8 At[4][2], B0[2][2], B1[2][2];
    const char* cA = (const char*)g.A + (size_t)cur.pm * tstep; const char* cB = (const char*)g.Bt + (size_t)cur.pn * tstep;
    S.a_ready(cur);
    PG8_STAGE(PG8_SB(0, 0), cB, voffB); PG8_STAGE(PG8_SA(0, 0), cA, voffA); PG8_STAGE(PG8_SB(0, 1), cB + hstep, voffB); PG8_STAGE(PG8_SA(0, 1), cA + hstep, voffA);
    if (wr == 1) PG8_BAR;
    PG8_WAIT_V(4); PG8_BAR;
    PG8_STAGE(PG8_SB(1, 0), cB + kstep, voffB); PG8_STAGE(PG8_SA(1, 0), cA + kstep, voffA); PG8_STAGE(PG8_SB(1, 1), cB + hstep + kstep, voffB);
    PG8_WAIT_V(6); PG8_BAR;
    for (;;) {
        const bool has_next = S.next(ui + 1, nxt);
        const char* nA = has_next ? (const char*)g.A + (size_t)nxt.pm * tstep : cA; const char* nB = has_next ? (const char*)g.Bt + (size_t)nxt.pn * tstep : cB;
        for (int t = 0; t < nt; t += 2) {
            const bool last = (t == nt - 2);
            const char* a1 = cA + (size_t)(t + 1) * kstep;
            const char* a2 = last ? nA : cA + (size_t)(t + 2) * kstep; const char* b2 = last ? nB : cB + (size_t)(t + 2) * kstep;
            const char* a3 = a2 + kstep; const char* b3 = b2 + kstep;
            if (last && has_next) S.a_ready(nxt);
            PG8_LDB(B0, 0, 0); PG8_SCHED; PG8_LDA(At, 0, 0); PG8_STAGE(PG8_SA(1, 1), a1 + hstep, voffA);
            PG8_WAIT_L(8); PG8_BAR; PG8_WAIT_L(0); PG8_MMA(0, 0, At, B0); PG8_BAR; PG8_SCHED;
            PG8_LDB(B1, 0, 1); PG8_STAGE(PG8_SB(0, 0), b2, voffB);
            PG8_BAR; PG8_WAIT_L(0); PG8_MMA(0, 1, At, B1); PG8_BAR;
            PG8_LDA(At, 0, 1); PG8_STAGE(PG8_SA(0, 0), a2, voffA);
            PG8_BAR; PG8_WAIT_L(0); PG8_MMA(1, 0, At, B0); PG8_BAR; PG8_SCHED;
            PG8_STAGE(PG8_SB(0, 1), b2 + hstep, voffB);
            PG8_WAIT_V(6); PG8_BAR; PG8_MMA(1, 1, At, B1); PG8_BAR;
            PG8_LDB(B0, 1, 0); PG8_SCHED; PG8_LDA(At, 1, 0); PG8_STAGE(PG8_SA(0, 1), a2 + hstep, voffA);
            PG8_WAIT_L(8); PG8_BAR; PG8_WAIT_L(0); PG8_MMA(0, 0, At, B0); PG8_BAR; PG8_SCHED;
            PG8_LDB(B1, 1, 1); PG8_STAGE(PG8_SB(1, 0), b3, voffB);
            PG8_BAR; PG8_WAIT_L(0); PG8_MMA(0, 1, At, B1); PG8_BAR;
            PG8_LDA(At, 1, 1); PG8_STAGE(PG8_SA(1, 0), a3, voffA);
            PG8_BAR; PG8_WAIT_L(0); PG8_MMA(1, 0, At, B0); PG8_BAR; PG8_SCHED;
            PG8_STAGE(PG8_SB(1, 1), b3 + hstep, voffB);
            PG8_WAIT_V(6); PG8_BAR; PG8_MMA(1, 1, At, B1); PG8_BAR;
        }
        if constexpr (!Epi::AFTER_DRAIN) { E(acc, cur, wr, wc, fr, fq); S.done(cur); }
        if (!has_next) break;
#pragma unroll
        for (int a = 0; a < 2; ++a)
#pragma unroll
            for (int b = 0; b < 2; ++b)
#pragma unroll
                for (int m = 0; m < 4; ++m)
#pragma unroll
                    for (int n = 0; n < 2; ++n) acc[a][b][m][n] = (f32x4){0.f, 0.f, 0.f, 0.f};
        cur = nxt; cA = nA; cB = nB; ++ui;
    }
    PG8_WAIT_V(0);
    if (wr == 0) PG8_BAR;
    PG8_BAR;
    if constexpr (Epi::AFTER_DRAIN) { E.fused(acc, cur, wr, wc, fr, fq, lds, wid, lane); S.done(cur); }
#undef PG8_SA
#undef PG8_SB
#undef PG8_STAGE
#undef PG8_LDA
#undef PG8_LDB
#undef PG8_MMA
#undef PG8_WAIT_V
#undef PG8_WAIT_L
#undef PG8_BAR
#undef PG8_SCHED
}
}


#define LAS __attribute__((address_space(3)))
typedef unsigned short bf16_t;
typedef short bf16x8 __attribute__((ext_vector_type(8)));
typedef short s16x4 __attribute__((ext_vector_type(4)));
typedef float f32x4 __attribute__((ext_vector_type(4)));
typedef float f32x16 __attribute__((ext_vector_type(16)));
typedef unsigned u32x4 __attribute__((ext_vector_type(4)));
typedef unsigned u32x2 __attribute__((ext_vector_type(2)));

constexpr int D = 1024, MP = 8192, MS = 32768, M = 40960, NZ = 3584;
constexpr int ZQ = 0, ZF = 512, ZV = 1536, ZGA = 2048, ZU = 2560, ZGB = 3072;
constexpr float EPS = 1e-6f;
constexpr size_t MiB = 1u << 20;
constexpr size_t WS_MOD = 1 * MiB;
constexpr size_t WS_BSEG = 1 * MiB + 512 * 1024;
constexpr size_t WS_WIN_E = 2 * MiB;
constexpr size_t WS_WOUT_E = 10 * MiB;
constexpr size_t WS_WGLU = 12 * MiB;
constexpr size_t WS_WIN_O = 13 * MiB;
constexpr size_t WS_WOUT_O = 21 * MiB;
constexpr size_t WS_XLOC = 23 * MiB;
constexpr size_t WS_SSP = 27 * MiB;
constexpr size_t WS_RSTD = 30 * MiB;
constexpr size_t WS_SW = 31 * MiB;
constexpr size_t WS_H = 32 * MiB;
constexpr size_t WS_Z = 112 * MiB;
constexpr size_t WS_A2 = 392 * MiB;
constexpr size_t WS_YBF = 472 * MiB;
constexpr size_t WS_END = 512 * MiB;
constexpr size_t OUT_YS = (size_t)MP * D, OUT_SH = (size_t)M * D, OUT_SRE = OUT_SH + 32 * 2 * 4 * 128 * 128, OUT_SIM = OUT_SRE + 32 * 2 * 32 * 64;

struct Params { const float* in[29]; float* out; unsigned char* ws; int ph_lo, ph_hi, li, pad; };
enum { I_XP = 0, I_XS, I_SH, I_SRE, I_SIM, I_C, I_CCTX, I_NORMG, I_WMOD, I_BMOD, I_WINE, I_WOUTE, I_LB, I_HG, I_LRE, I_LIM, I_LDT, I_BRE, I_BIM, I_CRE, I_CIM, I_S5D, I_WGLU, I_BGLU, I_WINO, I_WOUTO, I_CW, I_CB, I_FNG };

__device__ __forceinline__ float bf2f(unsigned x) { return __uint_as_float(x << 16); }
__device__ __forceinline__ float bflo(unsigned w) { return __uint_as_float(w << 16); }
__device__ __forceinline__ float bfhi(unsigned w) { return __uint_as_float(w & 0xffff0000u); }
typedef __bf16 bf16v2 __attribute__((ext_vector_type(2)));
__device__ __forceinline__ unsigned pk2(float lo, float hi) { bf16v2 v; v[0] = (__bf16)lo; v[1] = (__bf16)hi; return __builtin_bit_cast(unsigned, v); }
__device__ __forceinline__ float fsigmoid(float x) { return __builtin_amdgcn_rcpf(1.0f + __expf(-x)); }
__device__ __forceinline__ float fsilu(float x) { return x * fsigmoid(x); }
__device__ __forceinline__ float wave_sum(float v) {
#pragma unroll
    for (int o = 1; o < 64; o <<= 1) v += __shfl_xor(v, o);
    return v;
}
__device__ __forceinline__ void unpack8(const u32x4 w, float (&f)[8]) {
    f[0] = bflo(w.x); f[1] = bfhi(w.x); f[2] = bflo(w.y); f[3] = bfhi(w.y); f[4] = bflo(w.z); f[5] = bfhi(w.z); f[6] = bflo(w.w); f[7] = bfhi(w.w);
}
__device__ __forceinline__ u32x4 pack8(const float (&f)[8]) { u32x4 w; w.x = pk2(f[0], f[1]); w.y = pk2(f[2], f[3]); w.z = pk2(f[4], f[5]); w.w = pk2(f[6], f[7]); return w; }
#define LDS_WAIT() asm volatile("s_waitcnt lgkmcnt(0)" ::: "memory")

using pg8::Unit; using pg8::HALF; using pg8::BM;
struct EpiZ {
    static constexpr bool PERM = true, AFTER_DRAIN = false;
    bf16_t* Z; const float* lbl;
    __device__ __forceinline__ void operator()(const f32x4 (&acc)[2][2][4][2], const Unit& u, int wr, int wc, int fr, int fq) const {
        const int row0 = u.pm * BM + wr * 64 + fr, col0 = u.pn * BM + wc * 32 + 8 * fq, type = u.pn >> 1;
        float lb[2][8];
        if (type == 1 || type == 2) {
#pragma unroll
            for (int bj = 0; bj < 2; ++bj)
#pragma unroll
                for (int e = 0; e < 8; ++e) { const int c = (col0 + bj * HALF + e) & 511; lb[bj][e] = __builtin_amdgcn_rcpf(1.0f + __expf(lbl[512 + c] - lbl[c])); }
        }
#pragma unroll
        for (int ai = 0; ai < 2; ++ai)
#pragma unroll
            for (int m = 0; m < 4; ++m) { bf16_t* rowp = Z + (size_t)(row0 + ai * HALF + m * 16) * NZ + col0;
#pragma unroll
                for (int bj = 0; bj < 2; ++bj) { float v[8];
#pragma unroll
                    for (int e = 0; e < 4; ++e) { v[e] = acc[ai][bj][m][0][e]; v[4 + e] = acc[ai][bj][m][1][e]; }
                    if (type == 1 || type == 2) {
#pragma unroll
                        for (int e = 0; e < 8; ++e) v[e] = __logf(lb[bj][e] + (1.0f - lb[bj][e]) * fsigmoid(v[e]));
                    } else if (type == 4 || type == 6) {
#pragma unroll
                        for (int e = 0; e < 8; ++e) v[e] = fsilu(v[e]);
                    }
                    *(u32x4*)(rowp + bj * HALF) = pack8(v); } }
    }
};
struct EpiGlu {
    static constexpr bool PERM = true, AFTER_DRAIN = false;
    const bf16_t* Y; const bf16_t* Z; const float* bglu; bf16_t* A2;
    __device__ __forceinline__ void operator()(const f32x4 (&acc)[2][2][4][2], const Unit& u, int wr, int wc, int fr, int fq) const {
        const int row0 = u.pm * BM + wr * 64 + fr, col0 = u.pn * BM + wc * 32 + 8 * fq;
        float bv[2][8];
#pragma unroll
        for (int bj = 0; bj < 2; ++bj)
#pragma unroll
            for (int e = 0; e < 8; ++e) bv[bj][e] = bglu[col0 + bj * HALF + e];
#pragma unroll
        for (int ai = 0; ai < 2; ++ai) {
            u32x4 yv[4][2], zv[4][2];
#pragma unroll
            for (int m = 0; m < 4; ++m) { const size_t row = (size_t)(row0 + ai * HALF + m * 16);
#pragma unroll
                for (int bj = 0; bj < 2; ++bj) { const int col = col0 + bj * HALF; yv[m][bj] = *(const u32x4*)(Y + row * 512 + col); zv[m][bj] = *(const u32x4*)(Z + row * NZ + ZGB + col); } }
            asm volatile("" ::: "memory");
#pragma unroll
            for (int m = 0; m < 4; ++m) { const size_t row = (size_t)(row0 + ai * HALF + m * 16);
#pragma unroll
                for (int bj = 0; bj < 2; ++bj) { const int col = col0 + bj * HALF; float y[8], sg[8], o[8];
                    unpack8(yv[m][bj], y); unpack8(zv[m][bj], sg);
#pragma unroll
                    for (int e = 0; e < 8; ++e) { const float a = (e < 4 ? acc[ai][bj][m][0][e] : acc[ai][bj][m][1][e - 4]) + bv[bj][e]; o[e] = y[e] * fsigmoid(a) * sg[e]; }
                    *(u32x4*)(A2 + row * 1024 + 512 + col) = pack8(o); } }
            asm volatile("" ::: "memory");
        }
    }
};
struct EpiRes3 {
    static constexpr bool PERM = false, AFTER_DRAIN = false;
    const float* xp; const float* xs; const float* mod0; const float* mod1; const float* ng1; bf16_t* Y1b; bf16_t* H; float* SSP;
    __device__ __forceinline__ void operator()(const f32x4 (&acc)[2][2][4][2], const Unit& u, int wr, int wc, int fr, int fq) const {
        const int rowt = u.pm * BM, row0 = rowt + wr * 64 + fr, col0 = u.pn * BM + wc * 32 + 4 * fq;
        const int n = rowt < MP ? 0 : 1 + ((rowt - MP) >> 12);
        const float* base = rowt < MP ? xp : xs - (size_t)MP * D;
        f32x4 gv[2][2], gm[2][2];
#pragma unroll
        for (int bj = 0; bj < 2; ++bj)
#pragma unroll
            for (int nn = 0; nn < 2; ++nn) { const int c = col0 + bj * HALF + nn * 16; gv[bj][nn] = *(const f32x4*)(mod0 + n * 3072 + 2048 + c);
                gm[bj][nn] = *(const f32x4*)(ng1 + c) * (*(const f32x4*)(mod1 + n * 3072 + 1024 + c) + 1.0f); }
#pragma unroll
        for (int ai = 0; ai < 2; ++ai)
#pragma unroll
            for (int mp = 0; mp < 2; ++mp) {
                f32x4 bv[2][2][2];
#pragma unroll
                for (int mm = 0; mm < 2; ++mm) { const size_t off = (size_t)(row0 + ai * HALF + (2 * mp + mm) * 16) * D + col0;
#pragma unroll
                    for (int bj = 0; bj < 2; ++bj)
#pragma unroll
                        for (int nn = 0; nn < 2; ++nn) bv[mm][bj][nn] = *(const f32x4*)(base + off + bj * HALF + nn * 16); }
                asm volatile("" ::: "memory");
#pragma unroll
                for (int mm = 0; mm < 2; ++mm) { const int m = 2 * mp + mm; const int row = row0 + ai * HALF + m * 16; const size_t off = (size_t)row * D + col0; float ss = 0.f;
#pragma unroll
                    for (int bj = 0; bj < 2; ++bj)
#pragma unroll
                        for (int nn = 0; nn < 2; ++nn) { const f32x4 y = bv[mm][bj][nn] + gv[bj][nn] * acc[ai][bj][m][nn]; const f32x4 hh = y * gm[bj][nn];
                            ss += (y[0] * y[0] + y[1] * y[1]) + (y[2] * y[2] + y[3] * y[3]);
                            u32x2 wy, wh; wy.x = pk2(y[0], y[1]); wy.y = pk2(y[2], y[3]); wh.x = pk2(hh[0], hh[1]); wh.y = pk2(hh[2], hh[3]);
                            *(u32x2*)(Y1b + off + bj * HALF + nn * 16) = wy; *(u32x2*)(H + off + bj * HALF + nn * 16) = wh; }
                    ss += __shfl_xor(ss, 16); ss += __shfl_xor(ss, 32);
                    if (fq == 0) SSP[((size_t)row * 4 + u.pn) * 4 + wc] = ss; }
                asm volatile("" ::: "memory");
            }
    }
};
struct EpiRes5 {
    static constexpr bool PERM = false, AFTER_DRAIN = false;
    const bf16_t* Y1b; const float* mod1; float* out;
    __device__ __forceinline__ void operator()(const f32x4 (&acc)[2][2][4][2], const Unit& u, int wr, int wc, int fr, int fq) const {
        const int rowt = u.pm * BM, row0 = rowt + wr * 64 + fr, col0 = u.pn * BM + wc * 32 + 4 * fq;
        const int n = rowt < MP ? 0 : 1 + ((rowt - MP) >> 12);
        f32x4 gv[2][2];
#pragma unroll
        for (int bj = 0; bj < 2; ++bj)
#pragma unroll
            for (int nn = 0; nn < 2; ++nn) gv[bj][nn] = *(const f32x4*)(mod1 + n * 3072 + 2048 + col0 + bj * HALF + nn * 16);
#pragma unroll
        for (int ai = 0; ai < 2; ++ai) {
            u32x2 bv[4][2][2];
#pragma unroll
            for (int m = 0; m < 4; ++m) { const size_t off = (size_t)(row0 + ai * HALF + m * 16) * D + col0;
#pragma unroll
                for (int bj = 0; bj < 2; ++bj)
#pragma unroll
                    for (int nn = 0; nn < 2; ++nn) bv[m][bj][nn] = *(const u32x2*)(Y1b + off + bj * HALF + nn * 16); }
            asm volatile("" ::: "memory");
#pragma unroll
            for (int m = 0; m < 4; ++m) { const size_t off = (size_t)(row0 + ai * HALF + m * 16) * D + col0;
#pragma unroll
                for (int bj = 0; bj < 2; ++bj)
#pragma unroll
                    for (int nn = 0; nn < 2; ++nn) { const u32x2 w = bv[m][bj][nn]; const f32x4 b = (f32x4){bflo(w.x), bfhi(w.x), bflo(w.y), bfhi(w.y)};
                        *(f32x4*)(out + off + bj * HALF + nn * 16) = b + gv[bj][nn] * acc[ai][bj][m][nn]; } }
            asm volatile("" ::: "memory");
        }
    }
};
struct EpiOdd {
    static constexpr bool PERM = false, AFTER_DRAIN = false;
    bf16_t* PB; bf16_t* GB; const float* RSTD; const float* SW;
    __device__ __forceinline__ void operator()(const f32x4 (&acc)[2][2][4][2], const Unit& u, int wr, int wc, int fr, int fq) const {
        const int rowt = u.pm * BM, row0 = rowt + wr * 64 + fr, ch0 = u.pn * 64 + 16 * wc + 4 * fq;
        const int n = rowt < MP ? 0 : 1 + ((rowt - MP) >> 12);
        f32x4 sw[4]; float rs[2][4];
#pragma unroll
        for (int blk = 0; blk < 4; ++blk) sw[blk] = *(const f32x4*)(SW + n * 4096 + blk * 1024 + ch0);
#pragma unroll
        for (int ai = 0; ai < 2; ++ai)
#pragma unroll
            for (int m = 0; m < 4; ++m) rs[ai][m] = RSTD[row0 + ai * HALF + m * 16];
#pragma unroll
        for (int ai = 0; ai < 2; ++ai)
#pragma unroll
            for (int m = 0; m < 4; ++m) { const size_t off = (size_t)(row0 + ai * HALF + m * 16) * D + ch0; const float r = rs[ai][m];
                const f32x4 bg = acc[ai][0][m][0] * r + sw[0], cgv = acc[ai][0][m][1] * r + sw[1], vv = acc[ai][1][m][0] * r + sw[2], gg = acc[ai][1][m][1] * r + sw[3];
                const f32x4 p = cgv * vv; f32x4 g;
#pragma unroll
                for (int e = 0; e < 4; ++e) g[e] = bg[e] * fsilu(gg[e]);
                u32x2 wp, wg; wp.x = pk2(p[0], p[1]); wp.y = pk2(p[2], p[3]); wg.x = pk2(g[0], g[1]); wg.y = pk2(g[2], g[3]);
                *(u32x2*)(PB + off) = wp; *(u32x2*)(GB + off) = wg; }
    }
};

template <int MODE>
__device__ __forceinline__ void transpose_item(const float* W, int K, int N, bf16_t* WT, LAS float* scr, int item, int lane) {
    const int nblk = N / 32, kb = item / nblk, nb = item % nblk, k0 = 64 * kb, n0 = 32 * nb;
#pragma unroll 8
    for (int i = 0; i < 32; ++i) { const int kk = 2 * i + (lane >> 5); scr[kk * 33 + (lane & 31)] = W[(size_t)(k0 + kk) * N + n0 + (lane & 31)]; }
    LDS_WAIT();
    const int c = lane & 7;
#pragma unroll
    for (int j = 0; j < 4; ++j) { const int n = (lane >> 3) + 8 * j; const LAS float* s = scr + (8 * c) * 33 + n;
        u32x4 o; o.x = pk2(s[0 * 33], s[1 * 33]); o.y = pk2(s[2 * 33], s[3 * 33]); o.z = pk2(s[4 * 33], s[5 * 33]); o.w = pk2(s[6 * 33], s[7 * 33]);
        int dn = n0 + n;
        if (MODE == 1) { const int blk = dn >> 10, rem = dn & 1023, tile = rem >> 6, ch = rem & 63; dn = tile * 256 + 128 * (blk >> 1) + 32 * (ch >> 4) + 16 * (blk & 1) + (ch & 15); }
        *(u32x4*)(WT + (size_t)dn * K + k0 + 8 * c) = o; }
    LDS_WAIT();
}
__device__ __forceinline__ void gemv9_item(LAS unsigned char* lds, const float* W, int ldw, int jb, const float* bias, float* out, int ldo) {
    const int tid = threadIdx.x, lane = tid & 63, wave = tid >> 6;
    const LAS float* sc = (const LAS float*)lds; LAS float* red = (LAS float*)(lds + 36864);
    const float* Wc = W + jb * 64 + lane;
    float acc[9];
#pragma unroll
    for (int n = 0; n < 9; ++n) acc[n] = 0.f;
    for (int kk = 0; kk < 128; kk += 4) { const int k = wave * 128 + kk;
        const float w0 = Wc[(size_t)k * ldw], w1 = Wc[(size_t)(k + 1) * ldw], w2 = Wc[(size_t)(k + 2) * ldw], w3 = Wc[(size_t)(k + 3) * ldw];
#pragma unroll
        for (int n = 0; n < 9; ++n) { const f32x4 sv = *(const LAS f32x4*)(sc + n * 1024 + k); acc[n] += sv[0] * w0 + sv[1] * w1 + sv[2] * w2 + sv[3] * w3; } }
#pragma unroll
    for (int n = 0; n < 9; ++n) red[(wave * 9 + n) * 64 + lane] = acc[n];
    __syncthreads();
    for (int i = tid; i < 576; i += 512) { const int n = i >> 6, jj = i & 63; float sum = 0.f;
#pragma unroll
        for (int w = 0; w < 8; ++w) sum += red[(w * 9 + n) * 64 + jj];
        out[n * ldo + jb * 64 + jj] = sum + (bias ? bias[jb * 64 + jj] : 0.f); }
    __syncthreads();
}
__device__ __forceinline__ void phase0(const Params& P, LAS unsigned char* lds) {
    const int tid = threadIdx.x, lane = tid & 63, wave = tid >> 6;
    float* MOD = (float*)(P.ws + WS_MOD);
    if (blockIdx.x < 96) {
        LAS float* sc = (LAS float*)lds;
        for (int i = tid; i < 9 * 1024; i += 512) { const int n = i >> 10, k = i & 1023; const float c = n == 0 ? P.in[I_CCTX][k] : P.in[I_C][(n - 1) * 1024 + k]; sc[i] = fsilu(c); }
        __syncthreads();
        for (int item = blockIdx.x; item < 96; item += gridDim.x) { const int l = item / 48, jb = item % 48;
            gemv9_item(lds, P.in[I_WMOD] + (size_t)l * 1024 * 3072, 3072, jb, P.in[I_BMOD] + l * 3072, MOD + l * 9 * 3072, 3072); }
    }
    __syncthreads();
    LAS float* scr = (LAS float*)(lds + wave * 8448);
    const int gw = blockIdx.x * 8 + wave, NGW = gridDim.x * 8;
    constexpr int I1 = 16 * 112, I2 = 16 * 32, I3 = 8 * 16, I4 = 16 * 128, I5 = 16 * 32;
    for (int it = gw; it < I1 + I2 + I3 + I4 + I5; it += NGW) {
        int r = it;
        if (r < I1) { transpose_item<0>(P.in[I_WINE], 1024, 3584, (bf16_t*)(P.ws + WS_WIN_E), scr, r, lane); continue; } r -= I1;
        if (r < I2) { transpose_item<0>(P.in[I_WOUTE], 1024, 1024, (bf16_t*)(P.ws + WS_WOUT_E), scr, r, lane); continue; } r -= I2;
        if (r < I3) { transpose_item<0>(P.in[I_WGLU], 512, 512, (bf16_t*)(P.ws + WS_WGLU), scr, r, lane); continue; } r -= I3;
        if (r < I4) { transpose_item<1>(P.in[I_WINO], 1024, 4096, (bf16_t*)(P.ws + WS_WIN_O), scr, r, lane); continue; } r -= I4;
        transpose_item<0>(P.in[I_WOUTO], 1024, 1024, (bf16_t*)(P.ws + WS_WOUT_O), scr, r, lane);
    }
}

__device__ __forceinline__ void phase_norm(const float* xp, const float* xs, const float* ng, const float* mod, bf16_t* H) {
    const int lane = threadIdx.x & 63, gw = blockIdx.x * 8 + (threadIdx.x >> 6), NGW = gridDim.x * 8;
    for (int m = gw; m < M; m += NGW) {
        const float* xr = m < MP ? xp + (size_t)m * D : xs + (size_t)(m - MP) * D; const int n = m < MP ? 0 : 1 + ((m - MP) >> 12);
        f32x4 v[4]; float ss = 0.f;
#pragma unroll
        for (int j = 0; j < 4; ++j) { v[j] = *(const f32x4*)(xr + 4 * lane + 256 * j); ss += (v[j][0] * v[j][0] + v[j][1] * v[j][1]) + (v[j][2] * v[j][2] + v[j][3] * v[j][3]); }
        const float rstd = rsqrtf(wave_sum(ss) * (1.0f / D) + EPS);
#pragma unroll
        for (int j = 0; j < 4; ++j) { const int col = 4 * lane + 256 * j;
            const f32x4 g = *(const f32x4*)(ng + col), sh = *(const f32x4*)(mod + n * 3072 + col), sc = *(const f32x4*)(mod + n * 3072 + 1024 + col);
            const f32x4 y = v[j] * rstd * g * (sc + 1.0f) + sh;
            u32x2 w; w.x = pk2(y[0], y[1]); w.y = pk2(y[2], y[3]); *(u32x2*)(H + (size_t)m * D + col) = w; }
    }
}
__device__ __forceinline__ void phase_final_norm(float* out, const float* g) {
    const int lane = threadIdx.x & 63, gw = blockIdx.x * 8 + (threadIdx.x >> 6), NGW = gridDim.x * 8;
    for (int m = gw; m < M; m += NGW) { float* xr = out + (size_t)m * D;
        f32x4 v[4]; float ss = 0.f;
#pragma unroll
        for (int j = 0; j < 4; ++j) { v[j] = *(const f32x4*)(xr + 4 * lane + 256 * j); ss += (v[j][0] * v[j][0] + v[j][1] * v[j][1]) + (v[j][2] * v[j][2] + v[j][3] * v[j][3]); }
        const float rstd = rsqrtf(wave_sum(ss) * (1.0f / D) + EPS);
#pragma unroll
        for (int j = 0; j < 4; ++j) { const int col = 4 * lane + 256 * j; *(f32x4*)(xr + col) = v[j] * rstd * *(const f32x4*)(g + col); }
    }
}

constexpr int HG_QP = 272, HG_SP = 144;
constexpr int HG_Q = 0, HG_K = 17408, HG_KT = 34816, HG_VT = 53248, HG_P = 71680, HG_ST = 80896, HG_TAB = 115712;
__device__ __forceinline__ int seg_rowbase(int sg) { return sg < 32 ? sg * 256 : MP + (sg - 32) * 256; }
#define MFMA16(a, b, c) __builtin_amdgcn_mfma_f32_16x16x32_bf16((a), (b), (c), 0, 0, 0)
#define MFMA32(a, b, c) __builtin_amdgcn_mfma_f32_32x32x16_bf16((a), (b), (c), 0, 0, 0)

template <bool PASS2>
__device__ __forceinline__ void hgrn_task(const Params& P, LAS unsigned char* lds, int task) {
    const int tid = threadIdx.x, lane = tid & 63, w = __builtin_amdgcn_readfirstlane(tid >> 6), col = lane & 15, quad = lane >> 4;
    const int ch = tid & 127, qt = tid >> 7;
    const int d = task & 1, h = (task >> 1) & 3, sg = PASS2 ? (task >> 3) : 32 + (task >> 3);
    const int rowbase = seg_rowbase(sg), slot = ((sg - 32) << 3) | (h << 1) | d;
    const bf16_t* Z = (const bf16_t*)(P.ws + WS_Z);
    float* SLOC = (float*)(P.ws + WS_A2); float* BSEG = (float*)(P.ws + WS_BSEG);
    bf16_t* OB = (bf16_t*)(P.ws + WS_H) + (size_t)d * M * 512;
    LAS float* qtot = (LAS float*)(lds + HG_TAB); LAS float* ebm = qtot + 512; LAS float* e2t = qtot + 640;
    f32x4 S[8];
#pragma unroll
    for (int vt = 0; vt < 8; ++vt) {
        if (PASS2 && sg >= 32) {
#pragma unroll
            for (int j = 0; j < 4; ++j) S[vt][j] = SLOC[(size_t)slot * 16384 + (16 * w + 4 * quad + j) * 128 + 16 * vt + col];
        } else S[vt] = (f32x4){0.f, 0.f, 0.f, 0.f};
    }
    float bsum = 0.f;
    unsigned nlf[16], nv[16], nq[16];
#define HG_LOAD(cc) do { _Pragma("unroll") for (int e = 0; e < 16; ++e) { const int pos = 64 * (cc) + 16 * qt + e; const int row = rowbase + (d ? 255 - pos : pos); \
            const bf16_t* zr = Z + (size_t)row * NZ + 128 * h + ch; nlf[e] = zr[ZF + 512 * d]; nv[e] = zr[ZV]; if (PASS2) nq[e] = zr[ZQ]; } } while (0)
    HG_LOAD(0);
    for (int c = 0; c < 4; ++c) {
        float lf[16], cs[16], qq[16]; unsigned vraw[16];
#pragma unroll
        for (int e = 0; e < 16; ++e) { lf[e] = bf2f(nlf[e]); vraw[e] = nv[e]; if (PASS2) qq[e] = bf2f(nq[e]); }
        { float run = 0.f;
#pragma unroll
          for (int e = 0; e < 16; ++e) { run += lf[e]; cs[e] = run; } }
        qtot[qt * 128 + ch] = cs[15];
        __syncthreads();
        const float t0 = qtot[ch], t1 = qtot[128 + ch], t2 = qtot[256 + ch], t3 = qtot[384 + ch];
        const float off = qt == 0 ? 0.f : (qt == 1 ? t0 : (qt == 2 ? t0 + t1 : t0 + t1 + t2));
        const float bmid = t0 + t1, blast = (t0 + t1) + (t2 + t3);
        unsigned ktp[8], vtp[8];
#pragma unroll
        for (int e = 0; e < 16; e += 2) {
            float kt[2];
#pragma unroll
            for (int z = 0; z < 2; ++z) { const float b = off + cs[e + z]; const float kk = 1.0f - __expf(lf[e + z]); kt[z] = kk * __expf(fminf(bmid - b, 80.f));
                if (PASS2) { const int i = 16 * qt + e + z; const float qv = qq[e + z] * __expf(b - bmid);
                    *(LAS bf16_t*)(lds + HG_Q + i * HG_QP + ch * 2) = (bf16_t)(pk2(qv, 0.f) & 0xffffu);
                    *(LAS bf16_t*)(lds + HG_K + i * HG_QP + ch * 2) = (bf16_t)(pk2(kt[z], 0.f) & 0xffffu); } }
            ktp[e >> 1] = pk2(kt[0], kt[1]); vtp[e >> 1] = vraw[e] | (vraw[e + 1] << 16);
        }
        *(LAS u32x4*)(lds + HG_KT + ch * HG_SP + qt * 32) = (u32x4){ktp[0], ktp[1], ktp[2], ktp[3]};
        *(LAS u32x4*)(lds + HG_KT + ch * HG_SP + qt * 32 + 16) = (u32x4){ktp[4], ktp[5], ktp[6], ktp[7]};
        *(LAS u32x4*)(lds + HG_VT + ch * HG_SP + qt * 32) = (u32x4){vtp[0], vtp[1], vtp[2], vtp[3]};
        *(LAS u32x4*)(lds + HG_VT + ch * HG_SP + qt * 32 + 16) = (u32x4){vtp[4], vtp[5], vtp[6], vtp[7]};
        if (qt == 0) { ebm[ch] = __expf(bmid); e2t[ch] = __expf(blast - bmid); bsum += blast; }
        __syncthreads();
        if (c < 3) HG_LOAD(c + 1);
        const f32x4 eb = *(const LAS f32x4*)(ebm + 16 * w + 4 * quad), e2v = *(const LAS f32x4*)(e2t + 16 * w + 4 * quad);
#pragma unroll
        for (int vt = 0; vt < 8; ++vt) { S[vt] = S[vt] * eb;
            if (PASS2) { u32x2 sw; sw.x = pk2(S[vt][0], S[vt][1]); sw.y = pk2(S[vt][2], S[vt][3]);
                *(LAS u32x2*)(lds + HG_ST + (16 * vt + col) * HG_QP + (16 * w + 4 * quad) * 2) = sw; } }
        if (PASS2) {
#pragma unroll
            for (int ti = 0; ti < 2; ++ti) { const int id = 2 * w + ti, st = id >> 2, tt = id & 3;
                f32x4 ap = (f32x4){0.f, 0.f, 0.f, 0.f};
                if (st <= tt) {
#pragma unroll
                    for (int ks = 0; ks < 4; ++ks) { const bf16x8 a = *(const LAS bf16x8*)(lds + HG_K + (16 * st + col) * HG_QP + ks * 64 + quad * 16);
                        const bf16x8 b = *(const LAS bf16x8*)(lds + HG_Q + (16 * tt + col) * HG_QP + ks * 64 + quad * 16); ap = MFMA16(a, b, ap); }
                    const int tpos = 16 * tt + col, s0 = 16 * st + 4 * quad;
#pragma unroll
                    for (int j = 0; j < 4; ++j) ap[j] = (s0 + j <= tpos) ? ap[j] : 0.f;
                }
                u32x2 pw; pw.x = pk2(ap[0], ap[1]); pw.y = pk2(ap[2], ap[3]);
                *(LAS u32x2*)(lds + HG_P + (16 * tt + col) * HG_SP + (16 * st + 4 * quad) * 2) = pw; }
        }
        __syncthreads();
        if (PASS2) { const int tt = w >> 1;
#pragma unroll
            for (int vi = 0; vi < 4; ++vi) { const int vt = 4 * (w & 1) + vi; f32x4 ao = (f32x4){0.f, 0.f, 0.f, 0.f};
#pragma unroll
                for (int ks = 0; ks < 2; ++ks) { const bf16x8 a = *(const LAS bf16x8*)(lds + HG_VT + (16 * vt + col) * HG_SP + ks * 64 + quad * 16);
                    const bf16x8 b = *(const LAS bf16x8*)(lds + HG_P + (16 * tt + col) * HG_SP + ks * 64 + quad * 16); ao = MFMA16(a, b, ao); }
#pragma unroll
                for (int ks = 0; ks < 4; ++ks) { const bf16x8 a = *(const LAS bf16x8*)(lds + HG_ST + (16 * vt + col) * HG_QP + ks * 64 + quad * 16);
                    const bf16x8 b = *(const LAS bf16x8*)(lds + HG_Q + (16 * tt + col) * HG_QP + ks * 64 + quad * 16); ao = MFMA16(a, b, ao); }
                const int pos = 64 * c + 16 * tt + col; const int row = rowbase + (d ? 255 - pos : pos);
                u32x2 ow; ow.x = pk2(ao[0], ao[1]); ow.y = pk2(ao[2], ao[3]);
                *(u32x2*)(OB + (size_t)row * 512 + 128 * h + 16 * vt + 4 * quad) = ow; }
        }
#pragma unroll
        for (int vt = 0; vt < 8; ++vt) {
#pragma unroll
            for (int ks = 0; ks < 2; ++ks) { const bf16x8 a = *(const LAS bf16x8*)(lds + HG_KT + (16 * w + col) * HG_SP + ks * 64 + quad * 16);
                const bf16x8 b = *(const LAS bf16x8*)(lds + HG_VT + (16 * vt + col) * HG_SP + ks * 64 + quad * 16); S[vt] = MFMA16(a, b, S[vt]); }
            S[vt] = S[vt] * e2v; }
    }
#undef HG_LOAD
    if (!PASS2) {
#pragma unroll
        for (int vt = 0; vt < 8; ++vt)
#pragma unroll
            for (int j = 0; j < 4; ++j) SLOC[(size_t)slot * 16384 + (16 * w + 4 * quad + j) * 128 + 16 * vt + col] = S[vt][j];
        if (qt == 0) BSEG[slot * 128 + ch] = bsum;
    } else if (sg < 32) {
        float* o = P.out + OUT_SH + (size_t)((sg * 2 + d) * 4 + h) * 16384;
#pragma unroll
        for (int vt = 0; vt < 8; ++vt)
#pragma unroll
            for (int j = 0; j < 4; ++j) o[(16 * w + 4 * quad + j) * 128 + 16 * vt + col] = S[vt][j];
    }
    __syncthreads();
}
__device__ __forceinline__ void sw_items(const Params& P, LAS unsigned char* lds) {
    if (blockIdx.x < 64) { LAS float* sc = (LAS float*)lds; const float* mod1 = (const float*)(P.ws + WS_MOD) + 9 * 3072;
        for (int i = threadIdx.x; i < 9 * 1024; i += 512) sc[i] = mod1[(i >> 10) * 3072 + (i & 1023)];
        __syncthreads();
        for (int item = blockIdx.x; item < 64; item += gridDim.x) gemv9_item(lds, P.in[I_WINO], 4096, item, nullptr, (float*)(P.ws + WS_SW), 4096);
    }
}
__device__ __forceinline__ void phase_rstd(const Params& P) {
    const float* SSP = (const float*)(P.ws + WS_SSP); float* RSTD = (float*)(P.ws + WS_RSTD);
    for (int row = blockIdx.x * 512 + threadIdx.x; row < M; row += gridDim.x * 512) { const f32x4* p = (const f32x4*)(SSP + (size_t)row * 16);
        const f32x4 a = p[0], b = p[1], c = p[2], d = p[3];
        const float ss = ((a[0] + a[1]) + (a[2] + a[3])) + ((b[0] + b[1]) + (b[2] + b[3])) + ((c[0] + c[1]) + (c[2] + c[3])) + ((d[0] + d[1]) + (d[2] + d[3]));
        RSTD[row] = rsqrtf(ss * (1.0f / D) + EPS); }
}
__device__ __forceinline__ void hgrn_carry(const Params& P) {
    float* SLOC = (float*)(P.ws + WS_A2); const float* BSEG = (const float*)(P.ws + WS_BSEG);
    const int gt = blockIdx.x * 512 + threadIdx.x, NT = gridDim.x * 512;
    for (int idx = gt; idx < 64 * 16384; idx += NT) { const int chain = idx >> 14, e = idx & 16383, b = chain >> 3, h = (chain >> 1) & 3, d = chain & 1, k = e >> 7;
        float run = P.in[I_SH][(size_t)((b * 2 + d) * 4 + h) * 16384 + e];
        for (int jj = 0; jj < 16; ++jj) { const int ks = d ? 15 - jj : jj; const int slot = ((b * 16 + ks) << 3) | (h << 1) | d;
            const float tmp = SLOC[(size_t)slot * 16384 + e]; SLOC[(size_t)slot * 16384 + e] = run; run = __expf(BSEG[slot * 128 + k]) * run + tmp; } }
}

template <bool PASS2>
__device__ __forceinline__ void s5_task(const Params& P, LAS unsigned char* img, int task) {
    const int lane = threadIdx.x & 63, n = lane & 31, hh = lane >> 5;
    const int d = task & 1, g = (task >> 1) & 31, pr = task >> 6;
    const int segA = PASS2 ? 2 * pr : 32 + 2 * pr, myseg = segA + hh;
    const bf16_t* Z = (const bf16_t*)(P.ws + WS_Z);
    float* XLOC = (float*)(P.ws + WS_XLOC);
    const int dg = d * 32 + g;
    const float dt = __expf(P.in[I_LDT][dg]);
    float lr[2], li[2], xr[2], xi[2]; bf16x8 Bf[4], Cf[4][2];
    float cre[2], cim[2];
#pragma unroll
    for (int pp = 0; pp < 2; ++pp) { const int p = 32 * pp + n; const float lre = P.in[I_LRE][dg * 64 + p], lim = P.in[I_LIM][dg * 64 + p];
        const float mag = expf(lre * dt); float sn, cs; sincosf(lim * dt, &sn, &cs); lr[pp] = mag * cs; li[pp] = mag * sn;
        const float den = lre * lre + lim * lim; cre[pp] = ((lr[pp] - 1.0f) * lre + li[pp] * lim) / den; cim[pp] = (li[pp] * lre - (lr[pp] - 1.0f) * lim) / den; }
#pragma unroll
    for (int jt = 0; jt < 4; ++jt) { const int pp = jt & 1, part = jt >> 1, p = 32 * pp + n; float v[8];
        const float* br = P.in[I_BRE] + (size_t)(dg * 64 + p) * 16 + 8 * hh; const float* bi = P.in[I_BIM] + (size_t)(dg * 64 + p) * 16 + 8 * hh;
#pragma unroll
        for (int j = 0; j < 8; ++j) v[j] = part ? (cre[pp] * bi[j] + cim[pp] * br[j]) : (cre[pp] * br[j] - cim[pp] * bi[j]);
        Bf[jt] = __builtin_bit_cast(bf16x8, pack8(v)); }
    if (PASS2) {
#pragma unroll
        for (int jt = 0; jt < 4; ++jt)
#pragma unroll
            for (int s = 0; s < 2; ++s) { const int part = jt >> 1, p0 = 32 * (jt & 1) + 16 * s + 8 * hh; float v[8];
                const float* cp = (part ? P.in[I_CIM] : P.in[I_CRE]) + (size_t)(dg * 16 + (n & 15)) * 64 + p0;
#pragma unroll
                for (int j = 0; j < 8; ++j) { const float c = cp[j]; v[j] = n < 16 ? (part ? -c : c) : 0.f; }
                Cf[jt][s] = __builtin_bit_cast(bf16x8, pack8(v)); }
    }
#pragma unroll
    for (int pp = 0; pp < 2; ++pp) { xr[pp] = 0.f; xi[pp] = 0.f; }
    if (PASS2 && myseg >= 32) { const int sb = (myseg - 32) >> 4, sk = (myseg - 32) & 15;
#pragma unroll
        for (int pp = 0; pp < 2; ++pp) { const int p = 32 * pp + n;
            float ar = lr[pp], ai = li[pp];
#pragma unroll
            for (int q = 0; q < 8; ++q) { const float nr = ar * ar - ai * ai, ni = 2.0f * ar * ai; ar = nr; ai = ni; }
            float sr = P.in[I_SRE][(size_t)((sb * 2 + d) * 32 + g) * 64 + p], si = P.in[I_SIM][(size_t)((sb * 2 + d) * 32 + g) * 64 + p];
            const int cnt = d ? 15 - sk : sk;
            for (int jj = 0; jj < cnt; ++jj) { const int ks = d ? 15 - jj : jj; const float* xl = XLOC + (size_t)(((sb * 16 + ks) * 32 + g) * 2 + d) * 128;
                const float nr = ar * sr - ai * si + xl[p], ni = ar * si + ai * sr + xl[64 + p]; sr = nr; si = ni; }
            xr[pp] = sr; xi[pp] = si; }
    }
    const int arow_seg = segA + ((n >> 2) & 1), arow_pos = (n & 3) + 4 * (n >> 3);
    const int abase = seg_rowbase(arow_seg), mybase = seg_rowbase(myseg);
    bf16_t* YD = (bf16_t*)P.out + (size_t)d * M * 512;
    const unsigned ibase = (unsigned)(uintptr_t)img;
    const int i16 = lane & 15, q4 = i16 >> 2, p4 = i16 & 3, blk = (lane >> 4) & 1;
    const bf16_t* zu = Z + ZU + g * 16 + 8 * hh;
    bf16x8 aq[4];
#pragma unroll
    for (int u = 0; u < 4; ++u) { const int apos = 16 * u + arow_pos; aq[u] = *(const bf16x8*)(zu + (size_t)(abase + (d ? 255 - apos : apos)) * NZ); }
#pragma nounroll
    for (int tl = 0; tl < 16; ++tl) {
        const bf16x8 a = aq[0];
        aq[0] = aq[1]; aq[1] = aq[2]; aq[2] = aq[3];
        { const int apos = 16 * (tl < 12 ? tl + 4 : 15) + arow_pos; aq[3] = *(const bf16x8*)(zu + (size_t)(abase + (d ? 255 - apos : apos)) * NZ); }
        f32x16 bu[4];
#pragma unroll
        for (int jt = 0; jt < 4; ++jt) { f32x16 z;
#pragma unroll
            for (int i = 0; i < 16; ++i) z[i] = 0.f;
            bu[jt] = MFMA32(a, Bf[jt], z); }
        asm volatile("s_nop 15" : "+v"(bu[0]), "+v"(bu[1]), "+v"(bu[2]), "+v"(bu[3]));
#pragma unroll
        for (int i = 0; i < 16; ++i)
#pragma unroll
            for (int pp = 0; pp < 2; ++pp) { const float nr = lr[pp] * xr[pp] - li[pp] * xi[pp] + bu[pp][i], ni = lr[pp] * xi[pp] + li[pp] * xr[pp] + bu[2 + pp][i];
                xr[pp] = nr; xi[pp] = ni; bu[pp][i] = nr; bu[2 + pp][i] = ni; }
        if (PASS2) {
#pragma unroll
            for (int jt = 0; jt < 4; ++jt)
#pragma unroll
                for (int g4 = 0; g4 < 4; ++g4) { u32x2 v; v.x = pk2(bu[jt][4 * g4], bu[jt][4 * g4 + 1]); v.y = pk2(bu[jt][4 * g4 + 2], bu[jt][4 * g4 + 3]);
                    *(LAS u32x2*)(img + jt * 2048 + n * 64 + 8 * (2 * g4 + hh)) = v; }
            LDS_WAIT();
            f32x16 y0, y1;
#pragma unroll
            for (int i = 0; i < 16; ++i) { y0[i] = 0.f; y1[i] = 0.f; }
            s16x4 r[16];
            { const unsigned b0 = ibase + 8 * (4 * blk + p4) + (8 * hh + q4) * 64;
              asm volatile("ds_read_b64_tr_b16 %0, %16\n\tds_read_b64_tr_b16 %1, %16 offset:256\n\tds_read_b64_tr_b16 %2, %16 offset:1024\n\tds_read_b64_tr_b16 %3, %16 offset:1280\n\t"
                           "ds_read_b64_tr_b16 %4, %16 offset:2048\n\tds_read_b64_tr_b16 %5, %16 offset:2304\n\tds_read_b64_tr_b16 %6, %16 offset:3072\n\tds_read_b64_tr_b16 %7, %16 offset:3328\n\t"
                           "ds_read_b64_tr_b16 %8, %16 offset:4096\n\tds_read_b64_tr_b16 %9, %16 offset:4352\n\tds_read_b64_tr_b16 %10, %16 offset:5120\n\tds_read_b64_tr_b16 %11, %16 offset:5376\n\t"
                           "ds_read_b64_tr_b16 %12, %16 offset:6144\n\tds_read_b64_tr_b16 %13, %16 offset:6400\n\tds_read_b64_tr_b16 %14, %16 offset:7168\n\tds_read_b64_tr_b16 %15, %16 offset:7424\n\ts_waitcnt lgkmcnt(0)"
                           : "=&v"(r[0]), "=&v"(r[1]), "=&v"(r[2]), "=&v"(r[3]), "=&v"(r[4]), "=&v"(r[5]), "=&v"(r[6]), "=&v"(r[7]),
                             "=&v"(r[8]), "=&v"(r[9]), "=&v"(r[10]), "=&v"(r[11]), "=&v"(r[12]), "=&v"(r[13]), "=&v"(r[14]), "=&v"(r[15])
                           : "v"(b0) : "memory"); }
#pragma unroll
            for (int jt = 0; jt < 4; ++jt) {
                const bf16x8 xa0 = __builtin_shufflevector(r[4 * jt], r[4 * jt + 1], 0, 1, 2, 3, 4, 5, 6, 7), xa1 = __builtin_shufflevector(r[4 * jt + 2], r[4 * jt + 3], 0, 1, 2, 3, 4, 5, 6, 7);
                y0 = MFMA32(Cf[jt][0], xa0, y0); y1 = MFMA32(Cf[jt][1], xa1, y1); }
            asm volatile("s_nop 15" : "+v"(y0), "+v"(y1));
            { const int ypos = 16 * tl + arow_pos; const int yrow = abase + (d ? 255 - ypos : ypos);
              bf16_t* yp = YD + (size_t)yrow * 512 + g * 16 + 4 * hh;
              u32x2 w0, w1; w0.x = pk2(y0[0] + y1[0], y0[1] + y1[1]); w0.y = pk2(y0[2] + y1[2], y0[3] + y1[3]); w1.x = pk2(y0[4] + y1[4], y0[5] + y1[5]); w1.y = pk2(y0[6] + y1[6], y0[7] + y1[7]);
              *(u32x2*)yp = w0; *(u32x2*)(yp + 8) = w1; }
        }
    }
    if (!PASS2) { float* xl = XLOC + (size_t)(((myseg - 32) * 32 + g) * 2 + d) * 128;
#pragma unroll
        for (int pp = 0; pp < 2; ++pp) { xl[32 * pp + n] = xr[pp]; xl[64 + 32 * pp + n] = xi[pp]; }
    } else if (myseg < 32) {
#pragma unroll
        for (int pp = 0; pp < 2; ++pp) { const size_t o = (size_t)((myseg * 2 + d) * 32 + g) * 64 + 32 * pp + n; P.out[OUT_SRE + o] = xr[pp]; P.out[OUT_SIM + o] = xi[pp]; }
    }
}

__device__ __forceinline__ float fgelu_tanh(float y) { const float z = 0.7978845608f * (y + 0.044715f * y * y * y); const float t = 1.0f - 2.0f * __builtin_amdgcn_rcpf(1.0f + __expf(2.0f * z)); return 0.5f * y * (1.0f + t); }
__device__ __forceinline__ void phase_combine(const Params& P) {
    const int lane = threadIdx.x & 63, gw = blockIdx.x * 8 + (threadIdx.x >> 6), NGW = gridDim.x * 8, c0 = lane * 8;
    const bf16_t* OF = (const bf16_t*)(P.ws + WS_H); const bf16_t* OBk = OF + (size_t)M * 512;
    const bf16_t* YF = (const bf16_t*)P.out; const bf16_t* YB = YF + (size_t)M * 512;
    const bf16_t* Z = (const bf16_t*)(P.ws + WS_Z); bf16_t* A2 = (bf16_t*)(P.ws + WS_A2); bf16_t* YBF = (bf16_t*)(P.ws + WS_YBF);
    float hg[8], dsk[8];
#pragma unroll
    for (int e = 0; e < 8; ++e) { hg[e] = P.in[I_HG][c0 + e]; dsk[e] = P.in[I_S5D][c0 + e]; }
    for (int m = gw; m < M; m += NGW) {
        float a[8], b[8], ga[8], o[8];
        unpack8(*(const u32x4*)(OF + (size_t)m * 512 + c0), a); unpack8(*(const u32x4*)(OBk + (size_t)m * 512 + c0), b); unpack8(*(const u32x4*)(Z + (size_t)m * NZ + ZGA + c0), ga);
        float ss = 0.f;
#pragma unroll
        for (int e = 0; e < 8; ++e) { a[e] += b[e]; ss += a[e] * a[e]; }
        ss += __shfl_xor(ss, 1); ss += __shfl_xor(ss, 2); ss += __shfl_xor(ss, 4); ss += __shfl_xor(ss, 8);
        const float r = rsqrtf(ss * (1.0f / 128.0f) + EPS);
#pragma unroll
        for (int e = 0; e < 8; ++e) o[e] = a[e] * r * hg[e] * ga[e];
        *(u32x4*)(A2 + (size_t)m * 1024 + c0) = pack8(o);
        float yf[8], yb[8], uu[8], y[8];
        unpack8(*(const u32x4*)(YF + (size_t)m * 512 + c0), yf); unpack8(*(const u32x4*)(YB + (size_t)m * 512 + c0), yb); unpack8(*(const u32x4*)(Z + (size_t)m * NZ + ZU + c0), uu);
#pragma unroll
        for (int e = 0; e < 8; ++e) y[e] = fgelu_tanh(yf[e] + yb[e] + dsk[e] * uu[e]);
        *(u32x4*)(YBF + (size_t)m * 512 + c0) = pack8(y);
    }
}
__device__ __forceinline__ void phase_conv(const Params& P) {
    const bf16_t* PB = (const bf16_t*)(P.ws + WS_Z + 160 * MiB); const bf16_t* GB = (const bf16_t*)(P.ws + WS_A2); bf16_t* A3 = (bf16_t*)(P.ws + WS_H);
    const int gt = blockIdx.x * 512 + threadIdx.x, NT = gridDim.x * 512;
    for (int idx = gt; idx < M * 128; idx += NT) { const int row = idx >> 7, c0 = (idx & 127) * 8;
        const int pos = row < MP ? (row & 255) : ((row - MP) & 63), L = row < MP ? 256 : 64;
        float p0[8], p1[8], p2[8], gg[8], o[8];
        const u32x4 zero = (u32x4){0u, 0u, 0u, 0u};
        unpack8(pos > 0 ? *(const u32x4*)(PB + (size_t)(row - 1) * D + c0) : zero, p0);
        unpack8(*(const u32x4*)(PB + (size_t)row * D + c0), p1);
        unpack8(pos < L - 1 ? *(const u32x4*)(PB + (size_t)(row + 1) * D + c0) : zero, p2);
        unpack8(*(const u32x4*)(GB + (size_t)row * D + c0), gg);
        const float* cw = P.in[I_CW] + c0; const float* cb = P.in[I_CB] + c0;
#pragma unroll
        for (int e = 0; e < 8; ++e) o[e] = gg[e] * (cw[e] * p0[e] + cw[1024 + e] * p1[e] + cw[2048 + e] * p2[e] + cb[e]);
        *(u32x4*)(A3 + (size_t)row * D + c0) = pack8(o); }
}

#define XB_TMO      128
#define XB_XCNT(j)  (256  + 64 * (j))
#define XB_XSUB(j)  (1280 + 64 * (j))
#define XB_XGEN(j)  (2304 + 64 * (j))
#define XB_TOP      3328
#define XB_TOPGEN   3392
#define XCD_BAR_WORDS 3456
#define XB_SPIN_CAP (1u << 18)

__device__ __forceinline__ unsigned xb_ld(unsigned* p)              { return __hip_atomic_load(p, __ATOMIC_RELAXED, __HIP_MEMORY_SCOPE_AGENT); }
__device__ __forceinline__ unsigned xb_add(unsigned* p, unsigned v) { return __hip_atomic_fetch_add(p, v, __ATOMIC_RELAXED, __HIP_MEMORY_SCOPE_AGENT); }
__device__ __forceinline__ unsigned xb_xcc_id() { return (unsigned)__builtin_amdgcn_s_getreg((3 << 11) | 20) & 0xFu; }
#define XB_SPIN(cond, bar) do { unsigned _sp = 0; while (cond) { __builtin_amdgcn_s_sleep(1); \
    if ((++_sp & 255u) == 0u) { if (xb_ld(&(bar)[XB_TMO])) break; if (_sp > XB_SPIN_CAP) { atomicAdd(&(bar)[XB_TMO], 1u); break; } } } } while (0)

struct XcdBarrier {
    unsigned* bar; unsigned x;
    volatile LAS unsigned* st;
};

__device__ __forceinline__ XcdBarrier xcd_barrier_post(unsigned* bar, volatile LAS unsigned* st) {
    XcdBarrier b; b.bar = bar; b.x = xb_xcc_id(); b.st = st;
    if (threadIdx.x == 0) (void)xb_add(&bar[XB_XCNT(b.x)], 1u);
    return b;
}
__device__ __forceinline__ void xcd_barrier_complete(unsigned* bar, unsigned x, unsigned& nloc, unsigned& nx) {
    const unsigned G = gridDim.x * gridDim.y * gridDim.z;
    unsigned sum, cnt, mine, sp = 0u;
    for (;;) {
        sum = 0u; cnt = 0u; mine = 0u;
#pragma unroll
        for (unsigned j = 0; j < 16; ++j) { const unsigned c = xb_ld(&bar[XB_XCNT(j)]); sum += c; cnt += (c > 0u) ? 1u : 0u; mine = (j == x) ? c : mine; }
        if (sum == G) break;
        __builtin_amdgcn_s_sleep(1);
        if ((++sp & 255u) == 0u) { if (xb_ld(&bar[XB_TMO])) break; if (sp > XB_SPIN_CAP) { atomicAdd(&bar[XB_TMO], 1u); break; } }
    }
    nloc = mine > 0u ? mine : 1u; nx = cnt > 0u ? cnt : 1u;
}

__device__ __forceinline__ void xcd_barrier(const XcdBarrier& b) {
    asm volatile("s_waitcnt vmcnt(0)" ::: "memory");
    __syncthreads();
    if (threadIdx.x == 0) {
        unsigned* bar = b.bar;
        __builtin_amdgcn_s_waitcnt(0);
        unsigned nloc = b.st[0], nx = b.st[1];
        if (nloc == 0u) { xcd_barrier_complete(bar, b.x, nloc, nx); b.st[0] = nloc; b.st[1] = nx; }
        const unsigned old = xb_add(&bar[XB_XSUB(b.x)], 1u);
        const unsigned gen = old / nloc;
        if (old + 1u == (gen + 1u) * nloc) {
            __builtin_amdgcn_fence(__ATOMIC_RELEASE, "agent");
            asm volatile("s_waitcnt vmcnt(0)" ::: "memory");
            const unsigned og = xb_add(&bar[XB_TOP], 1u);
            const unsigned tg = og / nx;
            if (og + 1u == (tg + 1u) * nx) xb_add(&bar[XB_TOPGEN], 1u);
            else XB_SPIN(xb_ld(&bar[XB_TOPGEN]) == tg, bar);
            __builtin_amdgcn_fence(__ATOMIC_ACQUIRE, "agent");
            xb_add(&bar[XB_XGEN(b.x)], 1u);
            asm volatile("s_waitcnt vmcnt(0)" ::: "memory");
        } else {
            XB_SPIN(xb_ld(&bar[XB_XGEN(b.x)]) == gen, bar);
            __builtin_amdgcn_fence(__ATOMIC_ACQUIRE, "agent");
            asm volatile("s_waitcnt vmcnt(0)" ::: "memory");
        }
    }
    __syncthreads();
}


constexpr int LDS_BYTES = 133120;
constexpr int NPHASE = 14;
__global__ void __launch_bounds__(512, 2) mk_fwd(Params P) {
    extern __shared__ __attribute__((aligned(16))) unsigned char lds_raw[];
    LAS unsigned char* lds = (LAS unsigned char*)lds_raw;
    cg::grid_group grid = cg::this_grid();
    const int lo = P.ph_lo, hi = P.ph_hi;
    if (threadIdx.x < 4) ((LAS unsigned*)(lds + 131072))[threadIdx.x] = 0u;
    __syncthreads();
    XcdBarrier bar = xcd_barrier_post((unsigned*)P.ws + P.li * XCD_BAR_WORDS, (volatile LAS unsigned*)(lds + 131072));
    if (hi < 0) grid.sync();
    const int wave = threadIdx.x >> 6;
    bf16_t* H = (bf16_t*)(P.ws + WS_H); bf16_t* Zb = (bf16_t*)(P.ws + WS_Z); bf16_t* A2 = (bf16_t*)(P.ws + WS_A2); bf16_t* YBF = (bf16_t*)(P.ws + WS_YBF);
    float* MOD = (float*)(P.ws + WS_MOD); bf16_t* Y1b = (bf16_t*)(P.ws + WS_Z);
#ifndef PHMASK
#define PHMASK 0x3fff
#endif
#ifndef DBLMASK
#define DBLMASK 0
#endif
#define IN(k) ((PHMASK & (1 << (k))) && lo <= (k) && (k) < hi)
#ifdef USE_CG_SYNC
#define SEAM(k) do { if (lo <= (k) && (k) + 1 < hi) grid.sync(); } while (0)
#else
#define SEAM(k) do { if (lo <= (k) && (k) + 1 < hi) xcd_barrier(bar); } while (0)
#endif
    if (IN(0)) _Pragma("nounroll") for (int rep_ = 0; rep_ < 1 + ((DBLMASK >> 0) & 1); ++rep_) phase0(P, lds);
    SEAM(0);
    if (IN(1)) _Pragma("nounroll") for (int rep_ = 0; rep_ < 1 + ((DBLMASK >> 1) & 1); ++rep_) phase_norm(P.in[I_XP], P.in[I_XS], P.in[I_NORMG], MOD, H);
    SEAM(1);
    if (IN(2)) _Pragma("nounroll") for (int rep_ = 0; rep_ < 1 + ((DBLMASK >> 2) & 1); ++rep_) { pg8::Gemm g{H, (const bf16_t*)(P.ws + WS_WIN_E), M, NZ, 1024}; pg8::StaticOrder S; S.init(M, NZ, gridDim.x, blockIdx.x);
        EpiZ E{Zb, P.in[I_LB]}; pg8::gemm_phase<EpiZ, pg8::StaticOrder>(lds, g, S, E); }
    SEAM(2);
    if (IN(3)) _Pragma("nounroll") for (int rep_ = 0; rep_ < 1 + ((DBLMASK >> 3) & 1); ++rep_) {
        _Pragma("nounroll") for (int r2_ = 0; r2_ < 1 + ((DBLMASK >> 14) & 1); ++r2_)
        for (int t = blockIdx.x; t < 1024; t += gridDim.x) hgrn_task<false>(P, lds, t);
        _Pragma("nounroll") for (int r2_ = 0; r2_ < 1 + ((DBLMASK >> 15) & 1); ++r2_)
        for (int t = blockIdx.x * 8 + wave; t < 4096; t += gridDim.x * 8) s5_task<false>(P, lds + wave * 8192, t);
    }
    SEAM(3);
    if (IN(4)) _Pragma("nounroll") for (int rep_ = 0; rep_ < 1 + ((DBLMASK >> 4) & 1); ++rep_) { sw_items(P, lds); hgrn_carry(P); }
    SEAM(4);
    if (IN(5)) _Pragma("nounroll") for (int rep_ = 0; rep_ < 1 + ((DBLMASK >> 5) & 1); ++rep_) {
        _Pragma("nounroll") for (int r2_ = 0; r2_ < 1 + ((DBLMASK >> 16) & 1); ++r2_)
        for (int t = blockIdx.x; t < 1280; t += gridDim.x) hgrn_task<true>(P, lds, t);
        _Pragma("nounroll") for (int r2_ = 0; r2_ < 1 + ((DBLMASK >> 17) & 1); ++r2_)
        for (int t = blockIdx.x * 8 + wave; t < 5120; t += gridDim.x * 8) s5_task<true>(P, lds + wave * 8192, t);
    }
    SEAM(5);
    if (IN(6)) _Pragma("nounroll") for (int rep_ = 0; rep_ < 1 + ((DBLMASK >> 6) & 1); ++rep_) phase_combine(P);
    SEAM(6);
    if (IN(7)) _Pragma("nounroll") for (int rep_ = 0; rep_ < 1 + ((DBLMASK >> 7) & 1); ++rep_) { pg8::Gemm g{YBF, (const bf16_t*)(P.ws + WS_WGLU), M, 512, 512}; pg8::StaticOrder S; S.init(M, 512, gridDim.x, blockIdx.x);
        EpiGlu E{YBF, Zb, P.in[I_BGLU], A2}; pg8::gemm_phase<EpiGlu, pg8::StaticOrder>(lds, g, S, E); }
    SEAM(7);
    if (IN(8)) _Pragma("nounroll") for (int rep_ = 0; rep_ < 1 + ((DBLMASK >> 8) & 1); ++rep_) { pg8::Gemm g{A2, (const bf16_t*)(P.ws + WS_WOUT_E), M, 1024, 1024}; pg8::StaticOrder S; S.init(M, 1024, gridDim.x, blockIdx.x);
        EpiRes3 E{P.in[I_XP], P.in[I_XS], MOD, MOD + 9 * 3072, P.in[I_NORMG] + 1024, Y1b, H, (float*)(P.ws + WS_SSP)}; pg8::gemm_phase<EpiRes3, pg8::StaticOrder>(lds, g, S, E); }
    SEAM(8);
    if (IN(9)) _Pragma("nounroll") for (int rep_ = 0; rep_ < 1 + ((DBLMASK >> 9) & 1); ++rep_) phase_rstd(P);
    SEAM(9);
    if (IN(10)) _Pragma("nounroll") for (int rep_ = 0; rep_ < 1 + ((DBLMASK >> 10) & 1); ++rep_) { pg8::Gemm g{H, (const bf16_t*)(P.ws + WS_WIN_O), M, 4096, 1024}; pg8::StaticOrder S; S.init(M, 4096, gridDim.x, blockIdx.x);
        EpiOdd E{(bf16_t*)(P.ws + WS_Z + 160 * MiB), A2, (const float*)(P.ws + WS_RSTD), (const float*)(P.ws + WS_SW)}; pg8::gemm_phase<EpiOdd, pg8::StaticOrder>(lds, g, S, E); }
    SEAM(10);
    if (IN(11)) _Pragma("nounroll") for (int rep_ = 0; rep_ < 1 + ((DBLMASK >> 11) & 1); ++rep_) phase_conv(P);
    SEAM(11);
    if (IN(12)) _Pragma("nounroll") for (int rep_ = 0; rep_ < 1 + ((DBLMASK >> 12) & 1); ++rep_) { pg8::Gemm g{H, (const bf16_t*)(P.ws + WS_WOUT_O), M, 1024, 1024}; pg8::StaticOrder S; S.init(M, 1024, gridDim.x, blockIdx.x);
        EpiRes5 E{Y1b, MOD + 9 * 3072, P.out}; pg8::gemm_phase<EpiRes5, pg8::StaticOrder>(lds, g, S, E); }
    SEAM(12);
#ifdef PROBE_SYNCS
    for (int i_ = 0; i_ < PROBE_SYNCS; ++i_) xcd_barrier(bar);
#endif
    if (IN(13)) _Pragma("nounroll") for (int rep_ = 0; rep_ < 1 + ((DBLMASK >> 13) & 1); ++rep_) phase_final_norm(P.out, P.in[I_FNG]);
#undef IN
#undef SEAM
}

extern "C" void kernel_launch(void* const* d_in, const int* in_sizes, int n_in, void* d_out, int out_size, void* d_ws, size_t ws_size, hipStream_t stream) {
    static int grid = 0;
    if (grid == 0) {
        if (n_in != 29 || ws_size < WS_END) { fprintf(stderr, "kernel_launch: unexpected n_in %d / ws_size %zu (need %zu)\n", n_in, ws_size, (size_t)WS_END); grid = -1; return; }
        int dev = 0, cus = 0, per_cu = 0;
        hipGetDevice(&dev); hipDeviceGetAttribute(&cus, hipDeviceAttributeMultiprocessorCount, dev);
        if (hipFuncSetAttribute((const void*)mk_fwd, hipFuncAttributeMaxDynamicSharedMemorySize, LDS_BYTES) != hipSuccess) { fprintf(stderr, "kernel_launch: hipFuncSetAttribute failed\n"); grid = -1; return; }
        if (hipOccupancyMaxActiveBlocksPerMultiprocessor(&per_cu, (const void*)mk_fwd, 512, LDS_BYTES) != hipSuccess || per_cu < 1) { fprintf(stderr, "kernel_launch: occupancy query says %d\n", per_cu); per_cu = 1; }
        (void)hipGetLastError();
        grid = cus * per_cu;
        fprintf(stderr, "kernel_launch: grid %d (cus %d x %d)\n", grid, cus, per_cu);
    }
    if (grid < 0) return;
    Params p{};
    (void)hipMemsetAsync(d_ws, 0, 65536, stream);
    for (int i = 0; i < 29; ++i) p.in[i] = (const float*)d_in[i];
    p.out = (float*)d_out; p.ws = (unsigned char*)d_ws;
#if MK_COOP
    void* args[] = {&p};
#ifdef PROBE_SPLIT
    p.ph_lo = 0; p.ph_hi = PROBE_SPLIT + 1;
    (void)hipLaunchCooperativeKernel((const void*)mk_fwd, dim3(grid), dim3(512), args, LDS_BYTES, stream);
    p.ph_lo = PROBE_SPLIT; p.ph_hi = NPHASE; p.li = 1;
#else
    p.ph_lo = 0; p.ph_hi = NPHASE;
#endif
    hipError_t e = hipLaunchCooperativeKernel((const void*)mk_fwd, dim3(grid), dim3(512), args, LDS_BYTES, stream);
    if (e != hipSuccess) fprintf(stderr, "kernel_launch: cooperative launch failed: %s (grid %d)\n", hipGetErrorString(e), grid);
#else
    for (int ph = 0; ph < NPHASE; ++ph) { p.ph_lo = ph; p.ph_hi = ph + 1; hipLaunchKernelGGL(mk_fwd, dim3(grid), dim3(512), LDS_BYTES, stream, p); }
#endif
}
```

```cpp
#include <hip/hip_runtime.h>
#include <hip/hip_cooperative_groups.h>
#include <cstdio>
#include <cstdint>
namespace cg = cooperative_groups;
#ifndef MK_COOP
#define MK_COOP 1
#endif

namespace pg8 {
#define PG8_LAS __attribute__((address_space(3)))
typedef unsigned short bf16_t;
typedef short bf16x8 __attribute__((ext_vector_type(8)));
typedef float f32x4 __attribute__((ext_vector_type(4)));
typedef unsigned u32x4 __attribute__((ext_vector_type(4)));
constexpr int BM = 256, BK = 64, HALF = 128, HTB = HALF * BK * 2  , STAGE_BYTES = 8 * HTB, NXCD = 8, WGM = 8;

__host__ __device__ __forceinline__ int lds_byte(int r, int c) { const int st = (r >> 4) * 2 + (c >> 5), rr = r & 15, cc = c & 31, ob = rr * 64 + cc * 2; return st * 1024 + (ob ^ (((ob >> 9) & 1) << 5)); }
__host__ __device__ __forceinline__ void stage_rc(int b, int& R, int& C) { const int st = b / 1024, sb = b % 1024, swz = sb ^ (((sb >> 9) & 1) << 5); R = (st >> 1) * 16 + swz / 64; C = (st & 1) * 32 + (swz % 64) / 2; }
__host__ __device__ __forceinline__ int perm32(int rho) { const int n = rho >> 4, i = rho & 15; return 8 * (i >> 2) + 4 * n + (i & 3); }

struct Unit { int pm, pn; };
struct Gemm { const bf16_t* A; const bf16_t* Bt; int M, N, K; };

struct StaticOrder {
    int nM, nN, nwg, G, c;
    __host__ __device__ void init(int M, int N, int G_, int c_) { nM = M / BM; nN = N / BM; nwg = nM * nN; G = G_; c = c_; }
    __host__ __device__ bool next(int i, Unit& u) const {
        const long L = (long)i * G + c; if (L >= nwg) return false;
        int wgid = (int)L; { const int q = nwg / NXCD, r = nwg % NXCD, xcd = wgid % NXCD, off = wgid / NXCD; wgid = (xcd < r ? xcd * (q + 1) : r * (q + 1) + (xcd - r) * q) + off; }
        const int nig = WGM * nN, gid = wgid / nig, fm = gid * WGM, gsz = (nM - fm) < WGM ? (nM - fm) : WGM;
        u.pm = fm + ((wgid % nig) % gsz); u.pn = (wgid % nig) / gsz; return true;
    }
    __device__ __forceinline__ void a_ready(const Unit&) const {}
    __device__ __forceinline__ void done(const Unit&) const {}
};

__device__ __forceinline__ unsigned cvt_pk_bf16(float lo, float hi) { unsigned r; asm volatile("v_cvt_pk_bf16_f32 %0, %1, %2" : "=v"(r) : "v"(lo), "v"(hi)); return r; }

template <class Epi, class Sched>
__device__ __forceinline__ void gemm_phase(PG8_LAS unsigned char* lds, const Gemm g, const Sched& S, const Epi& E) {
    const int tid = threadIdx.x, wid = __builtin_amdgcn_readfirstlane(tid >> 6), lane = tid & 63, wr = wid >> 2, wc = wid & 3, fr = lane & 15, fq = lane >> 4;
    const int K = g.K, nt = K / BK;
    unsigned voffA[2], voffB[2];
#pragma unroll
    for (int i = 0; i < 2; ++i) { int R, C; stage_rc(tid * 16 + i * 8192, R, C); const int Rb = Epi::PERM ? ((R & ~31) + perm32(R & 31)) : R;
        voffA[i] = (unsigned)(R * K + C) * 2u; voffB[i] = (unsigned)(Rb * K + C) * 2u; }
    const size_t kstep = (size_t)(BK * 2);
    const size_t hstep = (size_t)HALF * K * 2;
    const size_t tstep = 2 * hstep;
    const unsigned ldsw = (unsigned)wid * 1024u;
    const int aoff = lds_byte(wr * 64 + fr, fq * 8), boff = lds_byte(wc * 32 + fr, fq * 8);
#define PG8_SA(b, h) (((b) * 2 + (h)) * HTB)
#define PG8_SB(b, h) ((4 + (b) * 2 + (h)) * HTB)
#define PG8_STAGE(bufoff, gbase, voff) do { _Pragma("unroll") for (int _i = 0; _i < 2; ++_i) \
        __builtin_amdgcn_global_load_lds((const unsigned*)((const char*)(gbase) + (voff)[_i]), (PG8_LAS unsigned*)(lds + (bufoff) + ldsw + _i * 8192), 16, 0, 0); } while (0)
#define PG8_LDA(dst, b, h) do { _Pragma("unroll") for (int m = 0; m < 4; ++m) _Pragma("unroll") for (int k = 0; k < 2; ++k) dst[m][k] = *(const PG8_LAS bf16x8*)(lds + PG8_SA(b, h) + aoff + m * 2048 + k * 1024); } while (0)
#define PG8_LDB(dst, b, h) do { _Pragma("unroll") for (int n = 0; n < 2; ++n) _Pragma("unroll") for (int k = 0; k < 2; ++k) dst[n][k] = *(const PG8_LAS bf16x8*)(lds + PG8_SB(b, h) + boff + n * 2048 + k * 1024); } while (0)
#define PG8_MMA(ai, bj, At, Bt) do { __builtin_amdgcn_s_setprio(1); _Pragma("unroll") for (int m = 0; m < 4; ++m) _Pragma("unroll") for (int n = 0; n < 2; ++n) _Pragma("unroll") for (int k = 0; k < 2; ++k) \
        acc[ai][bj][m][n] = __builtin_amdgcn_mfma_f32_16x16x32_bf16(Bt[n][k], At[m][k], acc[ai][bj][m][n], 0, 0, 0); __builtin_amdgcn_s_setprio(0); } while (0)
#define PG8_WAIT_V(n) asm volatile("s_waitcnt vmcnt(" #n ")" ::: "memory")
#define PG8_WAIT_L(n) asm volatile("s_waitcnt lgkmcnt(" #n ")" ::: "memory")
#define PG8_BAR __builtin_amdgcn_s_barrier()
#define PG8_SCHED __builtin_amdgcn_sched_barrier(0)
    Unit cur, nxt; int ui = 0;
    if (!S.next(0, cur)) return;
    f32x4 acc[2][2][4][2];
#pragma unroll
    for (int a = 0; a < 2; ++a)
#pragma unroll
        for (int b = 0; b < 2; ++b)
#pragma unroll
            for (int m = 0; m < 4; ++m)
#pragma unroll
                for (int n = 0; n < 2; ++n) acc[a][b][m][n] = (f32x4){0.f, 0.f, 0.f, 0.f};
    bf16x8 At[4][2], B0[2][2], B1[2][2];
    const char* cA = (const char*)g.A + (size_t)cur.pm * tstep; const char* cB = (const char*)g.Bt + (size_t)cur.pn * tstep;
    S.a_ready(cur);
    PG8_STAGE(PG8_SB(0, 0), cB, voffB); PG8_STAGE(PG8_SA(0, 0), cA, voffA); PG8_STAGE(PG8_SB(0, 1), cB + hstep, voffB); PG8_STAGE(PG8_SA(0, 1), cA + hstep, voffA);
    if (wr == 1) PG8_BAR;
    PG8_WAIT_V(4); PG8_BAR;
    PG8_STAGE(PG8_SB(1, 0), cB + kstep, voffB); PG8_STAGE(PG8_SA(1, 0), cA + kstep, voffA); PG8_STAGE(PG8_SB(1, 1), cB + hstep + kstep, voffB);
    PG8_WAIT_V(6); PG8_BAR;
    for (;;) {
        const bool has_next = S.next(ui + 1, nxt);
        const char* nA = has_next ? (const char*)g.A + (size_t)nxt.pm * tstep : cA; const char* nB = has_next ? (const char*)g.Bt + (size_t)nxt.pn * tstep : cB;
        for (int t = 0; t < nt; t += 2) {
            const bool last = (t == nt - 2);
            const char* a1 = cA + (size_t)(t + 1) * kstep;
            const char* a2 = last ? nA : cA + (size_t)(t + 2) * kstep; const char* b2 = last ? nB : cB + (size_t)(t + 2) * kstep;
            const char* a3 = a2 + kstep; const char* b3 = b2 + kstep;
            if (last && has_next) S.a_ready(nxt);
            PG8_LDB(B0, 0, 0); PG8_SCHED; PG8_LDA(At, 0, 0); PG8_STAGE(PG8_SA(1, 1), a1 + hstep, voffA);
            PG8_WAIT_L(8); PG8_BAR; PG8_WAIT_L(0); PG8_MMA(0, 0, At, B0); PG8_BAR; PG8_SCHED;
            PG8_LDB(B1, 0, 1); PG8_STAGE(PG8_SB(0, 0), b2, voffB);
            PG8_BAR; PG8_WAIT_L(0); PG8_MMA(0, 1, At, B1); PG8_BAR;
            PG8_LDA(At, 0, 1); PG8_STAGE(PG8_SA(0, 0), a2, voffA);
            PG8_BAR; PG8_WAIT_L(0); PG8_MMA(1, 0, At, B0); PG8_BAR; PG8_SCHED;
            PG8_STAGE(PG8_SB(0, 1), b2 + hstep, voffB);
            PG8_WAIT_V(6); PG8_BAR; PG8_MMA(1, 1, At, B1); PG8_BAR;
            PG8_LDB(B0, 1, 0); PG8_SCHED; PG8_LDA(At, 1, 0); PG8_STAGE(PG8_SA(0, 1), a2 + hstep, voffA);
            PG8_WAIT_L(8); PG8_BAR; PG8_WAIT_L(0); PG8_MMA(0, 0, At, B0); PG8_BAR; PG8_SCHED;
            PG8_LDB(B1, 1, 1); PG8_STAGE(PG8_SB(1, 0), b3, voffB);
            PG8_BAR; PG8_WAIT_L(0); PG8_MMA(0, 1, At, B1); PG8_BAR;
            PG8_LDA(At, 1, 1); PG8_STAGE(PG8_SA(1, 0), a3, voffA);
            PG8_BAR; PG8_WAIT_L(0); PG8_MMA(1, 0, At, B0); PG8_BAR; PG8_SCHED;
            PG8_STAGE(PG8_SB(1, 1), b3 + hstep, voffB);
            PG8_WAIT_V(6); PG8_BAR; PG8_MMA(1, 1, At, B1); PG8_BAR;
        }
        if constexpr (!Epi::AFTER_DRAIN) { E(acc, cur, wr, wc, fr, fq); S.done(cur); }
        if (!has_next) break;
#pragma unroll
        for (int a = 0; a < 2; ++a)
#pragma unroll
            for (int b = 0; b < 2; ++b)
#pragma unroll
                for (int m = 0; m < 4; ++m)
#pragma unroll
                    for (int n = 0; n < 2; ++n) acc[a][b][m][n] = (f32x4){0.f, 0.f, 0.f, 0.f};
        cur = nxt; cA = nA; cB = nB; ++ui;
    }
    PG8_WAIT_V(0);
    if (wr == 0) PG8_BAR;
    PG8_BAR;
    if constexpr (Epi::AFTER_DRAIN) { E.fused(acc, cur, wr, wc, fr, fq, lds, wid, lane); S.done(cur); }
#undef PG8_SA
#undef PG8_SB
#undef PG8_STAGE
#undef PG8_LDA
#undef PG8_LDB
#undef PG8_MMA
#undef PG8_WAIT_V
#undef PG8_WAIT_L
#undef PG8_BAR
#undef PG8_SCHED
}
}


#define LAS __attribute__((address_space(3)))
typedef unsigned short bf16_t;
typedef short bf16x8 __attribute__((ext_vector_type(8)));
typedef short s16x4 __attribute__((ext_vector_type(4)));
typedef float f32x4 __attribute__((ext_vector_type(4)));
typedef float f32x16 __attribute__((ext_vector_type(16)));
typedef unsigned u32x4 __attribute__((ext_vector_type(4)));
typedef unsigned u32x2 __attribute__((ext_vector_type(2)));

constexpr int D = 1024, MP = 8192, MS = 32768, M = 40960, NZ = 3584;
constexpr int ZQ = 0, ZF = 512, ZV = 1536, ZGA = 2048, ZU = 2560, ZGB = 3072;
constexpr float EPS = 1e-6f;
constexpr size_t MiB = 1u << 20;
constexpr size_t WS_S5T = 128 * 1024;
constexpr size_t S5T_STRIDE = 13312;
constexpr size_t WS_MOD = 1 * MiB;
constexpr size_t WS_BSEG = 1 * MiB + 512 * 1024;
constexpr size_t WS_WIN_E = 2 * MiB;
constexpr size_t WS_WOUT_E = 10 * MiB;
constexpr size_t WS_WGLU = 12 * MiB;
constexpr size_t WS_WIN_O = 13 * MiB;
constexpr size_t WS_WOUT_O = 21 * MiB;
constexpr size_t WS_XLOC = 23 * MiB;
constexpr size_t WS_SSP = 27 * MiB;
constexpr size_t WS_RSTD = 30 * MiB;
constexpr size_t WS_SW = 31 * MiB;
constexpr size_t WS_H = 32 * MiB;
constexpr size_t WS_Z = 112 * MiB;
constexpr size_t WS_A2 = 392 * MiB;
constexpr size_t WS_YBF = 472 * MiB;
constexpr size_t WS_END = 512 * MiB;
constexpr size_t OUT_YS = (size_t)MP * D, OUT_SH = (size_t)M * D, OUT_SRE = OUT_SH + 32 * 2 * 4 * 128 * 128, OUT_SIM = OUT_SRE + 32 * 2 * 32 * 64;

struct Params { const float* in[29]; float* out; unsigned char* ws; int ph_lo, ph_hi, li, pad; };
enum { I_XP = 0, I_XS, I_SH, I_SRE, I_SIM, I_C, I_CCTX, I_NORMG, I_WMOD, I_BMOD, I_WINE, I_WOUTE, I_LB, I_HG, I_LRE, I_LIM, I_LDT, I_BRE, I_BIM, I_CRE, I_CIM, I_S5D, I_WGLU, I_BGLU, I_WINO, I_WOUTO, I_CW, I_CB, I_FNG };

__device__ __forceinline__ float bf2f(unsigned x) { return __uint_as_float(x << 16); }
__device__ __forceinline__ float bflo(unsigned w) { return __uint_as_float(w << 16); }
__device__ __forceinline__ float bfhi(unsigned w) { return __uint_as_float(w & 0xffff0000u); }
typedef __bf16 bf16v2 __attribute__((ext_vector_type(2)));
__device__ __forceinline__ unsigned pk2(float lo, float hi) { bf16v2 v; v[0] = (__bf16)lo; v[1] = (__bf16)hi; return __builtin_bit_cast(unsigned, v); }
__device__ __forceinline__ float fsigmoid(float x) { return __builtin_amdgcn_rcpf(1.0f + __expf(-x)); }
__device__ __forceinline__ float fsilu(float x) { return x * fsigmoid(x); }
__device__ __forceinline__ float wave_sum(float v) {
#pragma unroll
    for (int o = 1; o < 64; o <<= 1) v += __shfl_xor(v, o);
    return v;
}
__device__ __forceinline__ void unpack8(const u32x4 w, float (&f)[8]) {
    f[0] = bflo(w.x); f[1] = bfhi(w.x); f[2] = bflo(w.y); f[3] = bfhi(w.y); f[4] = bflo(w.z); f[5] = bfhi(w.z); f[6] = bflo(w.w); f[7] = bfhi(w.w);
}
__device__ __forceinline__ u32x4 pack8(const float (&f)[8]) { u32x4 w; w.x = pk2(f[0], f[1]); w.y = pk2(f[2], f[3]); w.z = pk2(f[4], f[5]); w.w = pk2(f[6], f[7]); return w; }
#define LDS_WAIT() asm volatile("s_waitcnt lgkmcnt(0)" ::: "memory")

using pg8::Unit; using pg8::HALF; using pg8::BM;
struct EpiZ {
    static constexpr bool PERM = true, AFTER_DRAIN = false;
    bf16_t* Z; const float* lbl;
    __device__ __forceinline__ void operator()(const f32x4 (&acc)[2][2][4][2], const Unit& u, int wr, int wc, int fr, int fq) const {
        const int row0 = u.pm * BM + wr * 64 + fr, col0 = u.pn * BM + wc * 32 + 8 * fq, type = u.pn >> 1;
        float lb[2][8];
        if (type == 1 || type == 2) {
#pragma unroll
            for (int bj = 0; bj < 2; ++bj)
#pragma unroll
                for (int e = 0; e < 8; ++e) { const int c = (col0 + bj * HALF + e) & 511; lb[bj][e] = __builtin_amdgcn_rcpf(1.0f + __expf(lbl[512 + c] - lbl[c])); }
        }
#pragma unroll
        for (int ai = 0; ai < 2; ++ai)
#pragma unroll
            for (int m = 0; m < 4; ++m) { bf16_t* rowp = Z + (size_t)(row0 + ai * HALF + m * 16) * NZ + col0;
#pragma unroll
                for (int bj = 0; bj < 2; ++bj) { float v[8];
#pragma unroll
                    for (int e = 0; e < 4; ++e) { v[e] = acc[ai][bj][m][0][e]; v[4 + e] = acc[ai][bj][m][1][e]; }
                    if (type == 1 || type == 2) {
#pragma unroll
                        for (int e = 0; e < 8; ++e) v[e] = __logf(lb[bj][e] + (1.0f - lb[bj][e]) * fsigmoid(v[e]));
                    } else if (type == 4 || type == 6) {
#pragma unroll
                        for (int e = 0; e < 8; ++e) v[e] = fsilu(v[e]);
                    }
                    *(u32x4*)(rowp + bj * HALF) = pack8(v); } }
    }
};
struct EpiGlu {
    static constexpr bool PERM = true, AFTER_DRAIN = false;
    const bf16_t* Y; const bf16_t* Z; const float* bglu; bf16_t* A2;
    __device__ __forceinline__ void operator()(const f32x4 (&acc)[2][2][4][2], const Unit& u, int wr, int wc, int fr, int fq) const {
        const int row0 = u.pm * BM + wr * 64 + fr, col0 = u.pn * BM + wc * 32 + 8 * fq;
        float bv[2][8];
#pragma unroll
        for (int bj = 0; bj < 2; ++bj)
#pragma unroll
            for (int e = 0; e < 8; ++e) bv[bj][e] = bglu[col0 + bj * HALF + e];
#pragma unroll
        for (int ai = 0; ai < 2; ++ai) {
            u32x4 yv[4][2], zv[4][2];
#pragma unroll
            for (int m = 0; m < 4; ++m) { const size_t row = (size_t)(row0 + ai * HALF + m * 16);
#pragma unroll
                for (int bj = 0; bj < 2; ++bj) { const int col = col0 + bj * HALF; yv[m][bj] = *(const u32x4*)(Y + row * 512 + col); zv[m][bj] = *(const u32x4*)(Z + row * NZ + ZGB + col); } }
            asm volatile("" ::: "memory");
#pragma unroll
            for (int m = 0; m < 4; ++m) { const size_t row = (size_t)(row0 + ai * HALF + m * 16);
#pragma unroll
                for (int bj = 0; bj < 2; ++bj) { const int col = col0 + bj * HALF; float y[8], sg[8], o[8];
                    unpack8(yv[m][bj], y); unpack8(zv[m][bj], sg);
#pragma unroll
                    for (int e = 0; e < 8; ++e) { const float a = (e < 4 ? acc[ai][bj][m][0][e] : acc[ai][bj][m][1][e - 4]) + bv[bj][e]; o[e] = y[e] * fsigmoid(a) * sg[e]; }
                    *(u32x4*)(A2 + row * 1024 + 512 + col) = pack8(o); } }
            asm volatile("" ::: "memory");
        }
    }
};
struct EpiRes3 {
    static constexpr bool PERM = true, AFTER_DRAIN = false;
    const float* xp; const float* xs; const float* mod0; const float* mod1; const float* ng1; bf16_t* Y1b; bf16_t* H; float* SSP; LAS unsigned char* escr;
    __device__ __forceinline__ void operator()(const f32x4 (&acc)[2][2][4][2], const Unit& u, int wr, int wc, int fr, int fq) const {
        const int rowt = u.pm * BM, row0 = rowt + wr * 64 + fr, col0 = u.pn * BM + wc * 32 + 8 * fq;
        const int n = rowt < MP ? 0 : 1 + ((rowt - MP) >> 12);
        const float* base = rowt < MP ? xp : xs - (size_t)MP * D;
        LAS f32x4* slot = (LAS f32x4*)(escr + ((wr * 4 + wc) * 4 + fq) * 128);
        if (fr == 0) {
#pragma unroll
            for (int bj = 0; bj < 2; ++bj)
#pragma unroll
                for (int nn = 0; nn < 2; ++nn) { const int c = col0 + bj * HALF + nn * 4; slot[(bj * 2 + nn) * 2] = *(const f32x4*)(mod0 + n * 3072 + 2048 + c);
                    slot[(bj * 2 + nn) * 2 + 1] = *(const f32x4*)(ng1 + c) * (*(const f32x4*)(mod1 + n * 3072 + 1024 + c) + 1.0f); }
        }
        LDS_WAIT();
#pragma unroll
        for (int ai = 0; ai < 2; ++ai)
#pragma unroll
            for (int mp = 0; mp < 2; ++mp) {
                f32x4 bv[2][2][2];
#pragma unroll
                for (int mm = 0; mm < 2; ++mm) { const size_t off = (size_t)(row0 + ai * HALF + (2 * mp + mm) * 16) * D + col0;
#pragma unroll
                    for (int bj = 0; bj < 2; ++bj)
#pragma unroll
                        for (int nn = 0; nn < 2; ++nn) bv[mm][bj][nn] = *(const f32x4*)(base + off + bj * HALF + nn * 4); }
                asm volatile("" ::: "memory");
#pragma unroll
                for (int mm = 0; mm < 2; ++mm) { const int m = 2 * mp + mm; const int row = row0 + ai * HALF + m * 16; const size_t off = (size_t)row * D + col0; float ss = 0.f;
#pragma unroll
                    for (int bj = 0; bj < 2; ++bj) { u32x4 wy, wh;
#pragma unroll
                        for (int nn = 0; nn < 2; ++nn) { const f32x4 gvv = slot[(bj * 2 + nn) * 2], gmm = slot[(bj * 2 + nn) * 2 + 1];
                            const f32x4 y = bv[mm][bj][nn] + gvv * acc[ai][bj][m][nn]; const f32x4 hh = y * gmm;
                            ss += (y[0] * y[0] + y[1] * y[1]) + (y[2] * y[2] + y[3] * y[3]);
                            wy[2 * nn] = pk2(y[0], y[1]); wy[2 * nn + 1] = pk2(y[2], y[3]); wh[2 * nn] = pk2(hh[0], hh[1]); wh[2 * nn + 1] = pk2(hh[2], hh[3]); }
                        *(u32x4*)(Y1b + off + bj * HALF) = wy; *(u32x4*)(H + off + bj * HALF) = wh; }
                    ss += __shfl_xor(ss, 16); ss += __shfl_xor(ss, 32);
                    if (fq == 0) SSP[((size_t)row * 4 + u.pn) * 4 + wc] = ss; }
                asm volatile("" ::: "memory");
            }
    }
};
struct EpiRes5 {
    static constexpr bool PERM = true, AFTER_DRAIN = false;
    const bf16_t* Y1b; const float* mod1; const float* gF; bf16_t* T; float* SSP;
    __device__ __forceinline__ void operator()(const f32x4 (&acc)[2][2][4][2], const Unit& u, int wr, int wc, int fr, int fq) const {
        const int rowt = u.pm * BM, row0 = rowt + wr * 64 + fr, col0 = u.pn * BM + wc * 32 + 8 * fq;
        const int n = rowt < MP ? 0 : 1 + ((rowt - MP) >> 12);
        f32x4 gv[2][2], gf[2][2];
#pragma unroll
        for (int bj = 0; bj < 2; ++bj)
#pragma unroll
            for (int nn = 0; nn < 2; ++nn) { const int c = col0 + bj * HALF + nn * 4; gv[bj][nn] = *(const f32x4*)(mod1 + n * 3072 + 2048 + c); gf[bj][nn] = *(const f32x4*)(gF + c); }
#pragma unroll
        for (int ai = 0; ai < 2; ++ai) {
            u32x4 bv[4][2];
#pragma unroll
            for (int m = 0; m < 4; ++m) { const size_t off = (size_t)(row0 + ai * HALF + m * 16) * D + col0;
#pragma unroll
                for (int bj = 0; bj < 2; ++bj) bv[m][bj] = *(const u32x4*)(Y1b + off + bj * HALF); }
            asm volatile("" ::: "memory");
#pragma unroll
            for (int m = 0; m < 4; ++m) { const int row = row0 + ai * HALF + m * 16; const size_t off = (size_t)row * D + col0; float ss = 0.f;
#pragma unroll
                for (int bj = 0; bj < 2; ++bj) { const u32x4 w = bv[m][bj]; u32x4 wt;
#pragma unroll
                    for (int nn = 0; nn < 2; ++nn) { const f32x4 b = (f32x4){bflo(w[2 * nn]), bfhi(w[2 * nn]), bflo(w[2 * nn + 1]), bfhi(w[2 * nn + 1])};
                        const f32x4 y = b + gv[bj][nn] * acc[ai][bj][m][nn], t = y * gf[bj][nn];
                        ss += (y[0] * y[0] + y[1] * y[1]) + (y[2] * y[2] + y[3] * y[3]);
                        wt[2 * nn] = pk2(t[0], t[1]); wt[2 * nn + 1] = pk2(t[2], t[3]); }
                    *(u32x4*)(T + off + bj * HALF) = wt; }
                ss += __shfl_xor(ss, 16); ss += __shfl_xor(ss, 32);
                if (fq == 0) SSP[((size_t)row * 4 + u.pn) * 4 + wc] = ss; }
            asm volatile("" ::: "memory");
        }
    }
};
struct EpiOdd {
    static constexpr bool PERM = false, AFTER_DRAIN = false;
    bf16_t* PB; bf16_t* GB; const float* RSTD; const float* SW; bf16_t* A3; const float* cw; const float* cb;
    __device__ __forceinline__ void operator()(const f32x4 (&acc)[2][2][4][2], const Unit& u, int wr, int wc, int fr, int fq) const {
        const int rowt = u.pm * BM, row0 = rowt + wr * 64 + fr, ch0 = u.pn * 64 + 16 * wc + 4 * fq;
        const int n = rowt < MP ? 0 : 1 + ((rowt - MP) >> 12);
        f32x4 sw[4]; float rs[2][4];
#pragma unroll
        for (int blk = 0; blk < 4; ++blk) sw[blk] = *(const f32x4*)(SW + n * 4096 + blk * 1024 + ch0);
#pragma unroll
        for (int ai = 0; ai < 2; ++ai)
#pragma unroll
            for (int m = 0; m < 4; ++m) rs[ai][m] = RSTD[row0 + ai * HALF + m * 16];
        if (rowt >= MP) {
            const f32x4 w0 = *(const f32x4*)(cw + ch0), w1 = *(const f32x4*)(cw + 1024 + ch0), w2 = *(const f32x4*)(cw + 2048 + ch0), bb = *(const f32x4*)(cb + ch0);
#pragma unroll
            for (int ai = 0; ai < 2; ++ai) { f32x4 p[4], gm[4];
#pragma unroll
                for (int m = 0; m < 4; ++m) { const float r = rs[ai][m];
                    const f32x4 bg = acc[ai][0][m][0] * r + sw[0], cgv = acc[ai][0][m][1] * r + sw[1], vv = acc[ai][1][m][0] * r + sw[2], gg = acc[ai][1][m][1] * r + sw[3];
                    p[m] = cgv * vv;
#pragma unroll
                    for (int e = 0; e < 4; ++e) gm[m][e] = bg[e] * fsilu(gg[e]); }
#pragma unroll
                for (int m = 0; m < 4; ++m) { f32x4 pv, nx;
#pragma unroll
                    for (int e = 0; e < 4; ++e) {
                        const float us = __shfl_up(p[m][e], 1, 16), uc = m > 0 ? __shfl(p[m > 0 ? m - 1 : 0][e], 15, 16) : 0.f;
                        const float ds = __shfl_down(p[m][e], 1, 16), dc = m < 3 ? __shfl(p[m < 3 ? m + 1 : 3][e], 0, 16) : 0.f;
                        pv[e] = fr > 0 ? us : uc; nx[e] = fr < 15 ? ds : dc; }
                    const f32x4 y = gm[m] * (w0 * pv + w1 * p[m] + w2 * nx + bb);
                    u32x2 wy; wy.x = pk2(y[0], y[1]); wy.y = pk2(y[2], y[3]);
                    *(u32x2*)(A3 + (size_t)(row0 + ai * HALF + m * 16) * D + ch0) = wy; }
            }
        } else {
#pragma unroll
        for (int ai = 0; ai < 2; ++ai)
#pragma unroll
            for (int m = 0; m < 4; ++m) { const size_t off = (size_t)(row0 + ai * HALF + m * 16) * D + ch0; const float r = rs[ai][m];
                const f32x4 bg = acc[ai][0][m][0] * r + sw[0], cgv = acc[ai][0][m][1] * r + sw[1], vv = acc[ai][1][m][0] * r + sw[2], gg = acc[ai][1][m][1] * r + sw[3];
                const f32x4 p = cgv * vv; f32x4 g;
#pragma unroll
                for (int e = 0; e < 4; ++e) g[e] = bg[e] * fsilu(gg[e]);
                u32x2 wp, wg; wp.x = pk2(p[0], p[1]); wp.y = pk2(p[2], p[3]); wg.x = pk2(g[0], g[1]); wg.y = pk2(g[2], g[3]);
                *(u32x2*)(PB + off) = wp; *(u32x2*)(GB + off) = wg; }
        }
    }
};

__device__ __forceinline__ void s5_build_tables(const Params& P, int dg);
template <int MODE>
__device__ __forceinline__ void transpose_item(const float* W, int K, int N, bf16_t* WT, LAS float* scr, int item, int lane) {
    const int nblk = N / 32, kb = item / nblk, nb = item % nblk, k0 = 64 * kb, n0 = 32 * nb;
#pragma unroll 8
    for (int i = 0; i < 32; ++i) { const int kk = 2 * i + (lane >> 5); scr[kk * 33 + (lane & 31)] = W[(size_t)(k0 + kk) * N + n0 + (lane & 31)]; }
    LDS_WAIT();
    const int c = lane & 7;
#pragma unroll
    for (int j = 0; j < 4; ++j) { const int n = (lane >> 3) + 8 * j; const LAS float* s = scr + (8 * c) * 33 + n;
        u32x4 o; o.x = pk2(s[0 * 33], s[1 * 33]); o.y = pk2(s[2 * 33], s[3 * 33]); o.z = pk2(s[4 * 33], s[5 * 33]); o.w = pk2(s[6 * 33], s[7 * 33]);
        int dn = n0 + n;
        if (MODE == 1) { const int blk = dn >> 10, rem = dn & 1023, tile = rem >> 6, ch = rem & 63; dn = tile * 256 + 128 * (blk >> 1) + 32 * (ch >> 4) + 16 * (blk & 1) + (ch & 15); }
        *(u32x4*)(WT + (size_t)dn * K + k0 + 8 * c) = o; }
    LDS_WAIT();
}
__device__ __forceinline__ void gemv9_item(LAS unsigned char* lds, const float* W, int ldw, int jb, const float* bias, float* out, int ldo) {
    const int tid = threadIdx.x, lane = tid & 63, wave = tid >> 6;
    const LAS float* sc = (const LAS float*)lds; LAS float* red = (LAS float*)(lds + 36864);
    const float* Wc = W + jb * 64 + lane;
    float acc[9];
#pragma unroll
    for (int n = 0; n < 9; ++n) acc[n] = 0.f;
    for (int kk = 0; kk < 128; kk += 16) { const int k0 = wave * 128 + kk;
        float wv[16];
#pragma unroll
        for (int q = 0; q < 16; ++q) wv[q] = Wc[(size_t)(k0 + q) * ldw];
#pragma unroll
        for (int q = 0; q < 16; q += 4)
#pragma unroll
            for (int n = 0; n < 9; ++n) { const f32x4 sv = *(const LAS f32x4*)(sc + n * 1024 + k0 + q); acc[n] += sv[0] * wv[q] + sv[1] * wv[q + 1] + sv[2] * wv[q + 2] + sv[3] * wv[q + 3]; } }
#pragma unroll
    for (int n = 0; n < 9; ++n) red[(wave * 9 + n) * 64 + lane] = acc[n];
    __syncthreads();
    for (int i = tid; i < 576; i += 512) { const int n = i >> 6, jj = i & 63; float sum = 0.f;
#pragma unroll
        for (int w = 0; w < 8; ++w) sum += red[(w * 9 + n) * 64 + jj];
        out[n * ldo + jb * 64 + jj] = sum + (bias ? bias[jb * 64 + jj] : 0.f); }
    __syncthreads();
}
__device__ __forceinline__ void phase0(const Params& P, LAS unsigned char* lds) {
    const int tid = threadIdx.x, lane = tid & 63, wave = tid >> 6;
    float* MOD = (float*)(P.ws + WS_MOD);
    if (blockIdx.x < 96) {
        LAS float* sc = (LAS float*)lds;
        for (int i = tid; i < 9 * 1024; i += 512) { const int n = i >> 10, k = i & 1023; const float c = n == 0 ? P.in[I_CCTX][k] : P.in[I_C][(n - 1) * 1024 + k]; sc[i] = fsilu(c); }
        __syncthreads();
        for (int item = blockIdx.x; item < 96; item += gridDim.x) { const int l = item / 48, jb = item % 48;
            gemv9_item(lds, P.in[I_WMOD] + (size_t)l * 1024 * 3072, 3072, jb, P.in[I_BMOD] + l * 3072, MOD + l * 9 * 3072, 3072); }
    }
    __syncthreads();
    LAS float* scr = (LAS float*)(lds + wave * 8448);
    const int tw0 = gridDim.x >= 192 ? 96 : 0;
    if ((int)blockIdx.x < tw0) return;
    const int gw = (blockIdx.x - tw0) * 8 + wave, NGW = (gridDim.x - tw0) * 8;
    constexpr int I1 = 16 * 112, I2 = 16 * 32, I3 = 8 * 16, I4 = 16 * 128, I5 = 16 * 32;
    for (int it = gw; it < 64 + I1 + I2 + I3 + I4 + I5; it += NGW) {
        int r = it;
        if (r < 64) { s5_build_tables(P, r); continue; } r -= 64;
        if (r < I1) { transpose_item<0>(P.in[I_WINE], 1024, 3584, (bf16_t*)(P.ws + WS_WIN_E), scr, r, lane); continue; } r -= I1;
        if (r < I2) { transpose_item<0>(P.in[I_WOUTE], 1024, 1024, (bf16_t*)(P.ws + WS_WOUT_E), scr, r, lane); continue; } r -= I2;
        if (r < I3) { transpose_item<0>(P.in[I_WGLU], 512, 512, (bf16_t*)(P.ws + WS_WGLU), scr, r, lane); continue; } r -= I3;
        if (r < I4) { transpose_item<1>(P.in[I_WINO], 1024, 4096, (bf16_t*)(P.ws + WS_WIN_O), scr, r, lane); continue; } r -= I4;
        transpose_item<0>(P.in[I_WOUTO], 1024, 1024, (bf16_t*)(P.ws + WS_WOUT_O), scr, r, lane);
    }
}

__device__ __forceinline__ void phase_norm(const float* xp, const float* xs, const float* ng, const float* mod, bf16_t* H) {
    const int lane = threadIdx.x & 63, gw = blockIdx.x * 8 + (threadIdx.x >> 6), NGW = gridDim.x * 8;
    for (int m = gw; m < M; m += NGW) {
        const float* xr = m < MP ? xp + (size_t)m * D : xs + (size_t)(m - MP) * D; const int n = m < MP ? 0 : 1 + ((m - MP) >> 12);
        f32x4 v[4]; float ss = 0.f;
#pragma unroll
        for (int j = 0; j < 4; ++j) { v[j] = __builtin_nontemporal_load((const f32x4*)(xr + 4 * lane + 256 * j)); ss += (v[j][0] * v[j][0] + v[j][1] * v[j][1]) + (v[j][2] * v[j][2] + v[j][3] * v[j][3]); }
        const float rstd = rsqrtf(wave_sum(ss) * (1.0f / D) + EPS);
#pragma unroll
        for (int j = 0; j < 4; ++j) { const int col = 4 * lane + 256 * j;
            const f32x4 g = *(const f32x4*)(ng + col), sh = *(const f32x4*)(mod + n * 3072 + col), sc = *(const f32x4*)(mod + n * 3072 + 1024 + col);
            const f32x4 y = v[j] * rstd * g * (sc + 1.0f) + sh;
            u32x2 w; w.x = pk2(y[0], y[1]); w.y = pk2(y[2], y[3]); *(u32x2*)(H + (size_t)m * D + col) = w; }
    }
}
__device__ __forceinline__ void phase_final_norm(float* out, const bf16_t* T, const float* SSP) {
    const int lane = threadIdx.x & 63, gw = blockIdx.x * 8 + (threadIdx.x >> 6), NGW = gridDim.x * 8;
    for (int m = gw; m < M; m += NGW) {
        const u32x4 t0 = __builtin_nontemporal_load((const u32x4*)(T + (size_t)m * D + 8 * lane)), t1 = __builtin_nontemporal_load((const u32x4*)(T + (size_t)m * D + 512 + 8 * lane));
        const float rstd = rsqrtf(wave_sum(lane < 16 ? SSP[(size_t)m * 16 + lane] : 0.f) * (1.0f / D) + EPS);
        float a[8], b[8]; unpack8(t0, a); unpack8(t1, b);
        float* o = out + (size_t)m * D + 8 * lane;
        __builtin_nontemporal_store((f32x4){a[0], a[1], a[2], a[3]} * rstd, (f32x4*)o); __builtin_nontemporal_store((f32x4){a[4], a[5], a[6], a[7]} * rstd, (f32x4*)(o + 4));
        __builtin_nontemporal_store((f32x4){b[0], b[1], b[2], b[3]} * rstd, (f32x4*)(o + 512)); __builtin_nontemporal_store((f32x4){b[4], b[5], b[6], b[7]} * rstd, (f32x4*)(o + 516));
    }
}

constexpr int HG_QP = 272, HG_SP = 144;
constexpr int HG_Q = 0, HG_K = 17408, HG_KT = 34816, HG_VT = 53248, HG_P = 71680, HG_ST = 80896, HG_TAB = 115712;
__device__ __forceinline__ int seg_rowbase(int sg) { return sg < 32 ? sg * 256 : MP + (sg - 32) * 256; }
#define MFMA16(a, b, c) __builtin_amdgcn_mfma_f32_16x16x32_bf16((a), (b), (c), 0, 0, 0)
#define MFMA32(a, b, c) __builtin_amdgcn_mfma_f32_32x32x16_bf16((a), (b), (c), 0, 0, 0)

template <bool PASS2>
__device__ __forceinline__ void hgrn_task(const Params& P, LAS unsigned char* lds, int task) {
    const int tid = threadIdx.x, lane = tid & 63, w = __builtin_amdgcn_readfirstlane(tid >> 6), col = lane & 15, quad = lane >> 4;
    const int ch = tid & 127, qt = tid >> 7;
    const int d = task & 1, h = (task >> 1) & 3, sg = PASS2 ? (task >> 3) : 32 + (task >> 3);
    const int rowbase = seg_rowbase(sg), slot = ((sg - 32) << 3) | (h << 1) | d;
    const bf16_t* Z = (const bf16_t*)(P.ws + WS_Z);
    float* SLOC = (float*)(P.ws + WS_A2); float* BSEG = (float*)(P.ws + WS_BSEG);
    bf16_t* OB = (bf16_t*)(P.ws + WS_H) + (size_t)d * M * 512;
    LAS float* qtot = (LAS float*)(lds + HG_TAB); LAS float* ebm = qtot + 512; LAS float* e2t = qtot + 640;
    f32x4 S[8];
#pragma unroll
    for (int vt = 0; vt < 8; ++vt) {
        if (PASS2 && sg >= 32) {
#pragma unroll
            for (int j = 0; j < 4; ++j) S[vt][j] = SLOC[(size_t)slot * 16384 + (16 * w + 4 * quad + j) * 128 + 16 * vt + col];
        } else S[vt] = (f32x4){0.f, 0.f, 0.f, 0.f};
    }
    float bsum = 0.f;
    unsigned nlf[16], nv[16], nq[16];
    const char* Zlf = (const char*)(Z + ZF + 512 * d + 128 * h); const char* Zvv = (const char*)(Z + ZV + 128 * h); const char* Zqq = (const char*)(Z + ZQ + 128 * h);
    const int bstep = d ? -(NZ * 2) : NZ * 2;
    const unsigned boff0 = ((unsigned)(rowbase + (d ? 255 - 16 * qt : 16 * qt)) * (unsigned)NZ + (unsigned)ch) * 2u;
#define HG_LOAD(cc) do { unsigned bo = boff0 + (unsigned)(64 * (cc) * bstep); _Pragma("unroll") for (int e = 0; e < 16; ++e) { \
            nlf[e] = *(const bf16_t*)(Zlf + bo); nv[e] = *(const bf16_t*)(Zvv + bo); if (PASS2) nq[e] = *(const bf16_t*)(Zqq + bo); bo += (unsigned)bstep; } } while (0)
    HG_LOAD(0);
    for (int c = 0; c < 4; ++c) {
        float lf[16], cs[16], qq[16]; unsigned vraw[16];
#pragma unroll
        for (int e = 0; e < 16; ++e) { lf[e] = bf2f(nlf[e]); vraw[e] = nv[e]; if (PASS2) qq[e] = bf2f(nq[e]); }
        { float run = 0.f;
#pragma unroll
          for (int e = 0; e < 16; ++e) { run += lf[e]; cs[e] = run; } }
        qtot[qt * 128 + ch] = cs[15];
        __syncthreads();
        const float t0 = qtot[ch], t1 = qtot[128 + ch], t2 = qtot[256 + ch], t3 = qtot[384 + ch];
        const float off = qt == 0 ? 0.f : (qt == 1 ? t0 : (qt == 2 ? t0 + t1 : t0 + t1 + t2));
        const float bmid = t0 + t1, blast = (t0 + t1) + (t2 + t3);
        unsigned ktp[8], vtp[8];
#pragma unroll
        for (int e = 0; e < 16; e += 2) {
            float kt[2];
#pragma unroll
            for (int z = 0; z < 2; ++z) { const float b = off + cs[e + z]; const float kk = 1.0f - __expf(lf[e + z]); kt[z] = kk * __expf(fminf(bmid - b, 80.f));
                if (PASS2) { const int i = 16 * qt + e + z; const float qv = qq[e + z] * __expf(b - bmid);
                    *(LAS bf16_t*)(lds + HG_Q + i * HG_QP + ch * 2) = (bf16_t)(pk2(qv, 0.f) & 0xffffu);
                    *(LAS bf16_t*)(lds + HG_K + i * HG_QP + ch * 2) = (bf16_t)(pk2(kt[z], 0.f) & 0xffffu); } }
            ktp[e >> 1] = pk2(kt[0], kt[1]); vtp[e >> 1] = vraw[e] | (vraw[e + 1] << 16);
        }
        *(LAS u32x4*)(lds + HG_KT + ch * HG_SP + qt * 32) = (u32x4){ktp[0], ktp[1], ktp[2], ktp[3]};
        *(LAS u32x4*)(lds + HG_KT + ch * HG_SP + qt * 32 + 16) = (u32x4){ktp[4], ktp[5], ktp[6], ktp[7]};
        *(LAS u32x4*)(lds + HG_VT + ch * HG_SP + qt * 32) = (u32x4){vtp[0], vtp[1], vtp[2], vtp[3]};
        *(LAS u32x4*)(lds + HG_VT + ch * HG_SP + qt * 32 + 16) = (u32x4){vtp[4], vtp[5], vtp[6], vtp[7]};
        if (qt == 0) { ebm[ch] = __expf(bmid); e2t[ch] = __expf(blast - bmid); bsum += blast; }
        __syncthreads();
        if (c < 3) HG_LOAD(c + 1);
        const f32x4 eb = *(const LAS f32x4*)(ebm + 16 * w + 4 * quad), e2v = *(const LAS f32x4*)(e2t + 16 * w + 4 * quad);
#pragma unroll
        for (int vt = 0; vt < 8; ++vt) { S[vt] = S[vt] * eb;
            if (PASS2) { u32x2 sw; sw.x = pk2(S[vt][0], S[vt][1]); sw.y = pk2(S[vt][2], S[vt][3]);
                *(LAS u32x2*)(lds + HG_ST + (16 * vt + col) * HG_QP + (16 * w + 4 * quad) * 2) = sw; } }
        if (PASS2) {
#pragma unroll
            for (int ti = 0; ti < 2; ++ti) { const int id = 2 * w + ti, st = id >> 2, tt = id & 3;
                f32x4 ap = (f32x4){0.f, 0.f, 0.f, 0.f};
                if (st <= tt) {
#pragma unroll
                    for (int ks = 0; ks < 4; ++ks) { const bf16x8 a = *(const LAS bf16x8*)(lds + HG_K + (16 * st + col) * HG_QP + ks * 64 + quad * 16);
                        const bf16x8 b = *(const LAS bf16x8*)(lds + HG_Q + (16 * tt + col) * HG_QP + ks * 64 + quad * 16); ap = MFMA16(a, b, ap); }
                    const int tpos = 16 * tt + col, s0 = 16 * st + 4 * quad;
#pragma unroll
                    for (int j = 0; j < 4; ++j) ap[j] = (s0 + j <= tpos) ? ap[j] : 0.f;
                }
                u32x2 pw; pw.x = pk2(ap[0], ap[1]); pw.y = pk2(ap[2], ap[3]);
                *(LAS u32x2*)(lds + HG_P + (16 * tt + col) * HG_SP + (16 * st + 4 * quad) * 2) = pw; }
        }
        __syncthreads();
        if (PASS2) { const int tt = w >> 1;
#pragma unroll
            for (int vi = 0; vi < 4; ++vi) { const int vt = 4 * (w & 1) + vi; f32x4 ao = (f32x4){0.f, 0.f, 0.f, 0.f};
#pragma unroll
                for (int ks = 0; ks < 2; ++ks) { const bf16x8 a = *(const LAS bf16x8*)(lds + HG_VT + (16 * vt + col) * HG_SP + ks * 64 + quad * 16);
                    const bf16x8 b = *(const LAS bf16x8*)(lds + HG_P + (16 * tt + col) * HG_SP + ks * 64 + quad * 16); ao = MFMA16(a, b, ao); }
#pragma unroll
                for (int ks = 0; ks < 4; ++ks) { const bf16x8 a = *(const LAS bf16x8*)(lds + HG_ST + (16 * vt + col) * HG_QP + ks * 64 + quad * 16);
                    const bf16x8 b = *(const LAS bf16x8*)(lds + HG_Q + (16 * tt + col) * HG_QP + ks * 64 + quad * 16); ao = MFMA16(a, b, ao); }
                const int pos = 64 * c + 16 * tt + col; const int row = rowbase + (d ? 255 - pos : pos);
                u32x2 ow; ow.x = pk2(ao[0], ao[1]); ow.y = pk2(ao[2], ao[3]);
                *(u32x2*)(OB + (size_t)row * 512 + 128 * h + 16 * vt + 4 * quad) = ow; }
        }
#pragma unroll
        for (int vt = 0; vt < 8; ++vt) {
#pragma unroll
            for (int ks = 0; ks < 2; ++ks) { const bf16x8 a = *(const LAS bf16x8*)(lds + HG_KT + (16 * w + col) * HG_SP + ks * 64 + quad * 16);
                const bf16x8 b = *(const LAS bf16x8*)(lds + HG_VT + (16 * vt + col) * HG_SP + ks * 64 + quad * 16); S[vt] = MFMA16(a, b, S[vt]); }
            S[vt] = S[vt] * e2v; }
    }
#undef HG_LOAD
    if (!PASS2) {
#pragma unroll
        for (int vt = 0; vt < 8; ++vt)
#pragma unroll
            for (int j = 0; j < 4; ++j) SLOC[(size_t)slot * 16384 + (16 * w + 4 * quad + j) * 128 + 16 * vt + col] = S[vt][j];
        if (qt == 0) BSEG[slot * 128 + ch] = bsum;
    } else if (sg < 32) {
        float* o = P.out + OUT_SH + (size_t)((sg * 2 + d) * 4 + h) * 16384;
#pragma unroll
        for (int vt = 0; vt < 8; ++vt)
#pragma unroll
            for (int j = 0; j < 4; ++j) o[(16 * w + 4 * quad + j) * 128 + 16 * vt + col] = S[vt][j];
    }
    __syncthreads();
}
__device__ __forceinline__ void hgrn_pass1_task(const Params& P, LAS unsigned char* lds, int task) {
    const int tid = threadIdx.x, lane = tid & 63, w = __builtin_amdgcn_readfirstlane(tid >> 6), col = lane & 15, quad = lane >> 4;
    const int ch = tid & 127, qt = tid >> 7;
    const int d = task & 1, h = (task >> 1) & 3, sg = 32 + (task >> 3), rowbase = seg_rowbase(sg), slot = task;
    const bf16_t* Z = (const bf16_t*)(P.ws + WS_Z);
    float* SLOC = (float*)(P.ws + WS_A2); float* BSEG = (float*)(P.ws + WS_BSEG);
    LAS float* qtot = (LAS float*)(lds + 131072 + 64);
    unsigned lfp[32], vp[32]; float tot = 0.f;
    const long zstep = d ? -(long)NZ : (long)NZ;
    const bf16_t* zl = Z + (size_t)(rowbase + (d ? 255 - 64 * qt : 64 * qt)) * NZ + 128 * h + ch + ZF + 512 * d; const bf16_t* zv = zl + (ZV - ZF - 512 * d);
#pragma unroll
    for (int e2 = 0; e2 < 32; ++e2) {
        const unsigned l0 = zl[0], v0 = zv[0]; zl += zstep; zv += zstep;
        const unsigned l1 = zl[0], v1 = zv[0]; zl += zstep; zv += zstep;
        if ((e2 & 3) == 3) asm volatile("" : "+v"(zl), "+v"(zv));
        lfp[e2] = l0 | (l1 << 16); vp[e2] = v0 | (v1 << 16); tot += bflo(lfp[e2]) + bfhi(lfp[e2]); }
    qtot[qt * 128 + ch] = tot;
    __syncthreads();
    const float t0 = qtot[ch], t1 = qtot[128 + ch], t2 = qtot[256 + ch], t3 = qtot[384 + ch];
    float run = qt == 3 ? 0.f : (qt == 2 ? t3 : (qt == 1 ? t2 + t3 : t1 + t2 + t3));
#pragma unroll
    for (int e2 = 31; e2 >= 0; --e2) { const float l1 = bfhi(lfp[e2]), l0 = bflo(lfp[e2]);
        const float k1 = (1.0f - __expf(l1)) * __expf(run); run += l1;
        const float k0 = (1.0f - __expf(l0)) * __expf(run); run += l0;
        lfp[e2] = pk2(k0, k1); }
#pragma unroll
    for (int c8 = 0; c8 < 8; ++c8) { const int cx = ((8 * qt + c8) ^ (ch & 31)) << 4;
        *(LAS u32x4*)(lds + ch * 512 + cx) = (u32x4){lfp[4 * c8], lfp[4 * c8 + 1], lfp[4 * c8 + 2], lfp[4 * c8 + 3]};
        *(LAS u32x4*)(lds + 65536 + ch * 512 + cx) = (u32x4){vp[4 * c8], vp[4 * c8 + 1], vp[4 * c8 + 2], vp[4 * c8 + 3]}; }
    __syncthreads();
    f32x4 S[8];
#pragma unroll
    for (int vt = 0; vt < 8; ++vt) S[vt] = (f32x4){0.f, 0.f, 0.f, 0.f};
    const int ar = 16 * w + col;
#pragma unroll
    for (int ks = 0; ks < 8; ++ks) { const bf16x8 a = *(const LAS bf16x8*)(lds + ar * 512 + (((4 * ks + quad) ^ (ar & 31)) << 4));
#pragma unroll
        for (int vt = 0; vt < 8; ++vt) { const int br = 16 * vt + col; const bf16x8 b = *(const LAS bf16x8*)(lds + 65536 + br * 512 + (((4 * ks + quad) ^ (br & 31)) << 4)); S[vt] = MFMA16(a, b, S[vt]); } }
#pragma unroll
    for (int vt = 0; vt < 8; ++vt)
#pragma unroll
        for (int j = 0; j < 4; ++j) SLOC[(size_t)slot * 16384 + (16 * w + 4 * quad + j) * 128 + 16 * vt + col] = S[vt][j];
    if (qt == 0) BSEG[slot * 128 + ch] = (t0 + t1) + (t2 + t3);
    __syncthreads();
}
__device__ __forceinline__ void sw_items(const Params& P, LAS unsigned char* lds, int wg0) {
    const int b = (int)blockIdx.x - wg0;
    if (b >= 0 && b < 64) { LAS float* sc = (LAS float*)lds; const float* mod1 = (const float*)(P.ws + WS_MOD) + 9 * 3072;
        for (int i = threadIdx.x; i < 9 * 1024; i += 512) sc[i] = mod1[(i >> 10) * 3072 + (i & 1023)];
        __syncthreads();
        for (int item = b; item < 64; item += (int)gridDim.x - wg0) gemv9_item(lds, P.in[I_WINO], 4096, item, nullptr, (float*)(P.ws + WS_SW), 4096);
    }
}
__device__ __forceinline__ void phase_rstd(const Params& P) {
    const float* SSP = (const float*)(P.ws + WS_SSP); float* RSTD = (float*)(P.ws + WS_RSTD);
    for (int row = blockIdx.x * 512 + threadIdx.x; row < M; row += gridDim.x * 512) { const f32x4* p = (const f32x4*)(SSP + (size_t)row * 16);
        const f32x4 a = p[0], b = p[1], c = p[2], d = p[3];
        const float ss = ((a[0] + a[1]) + (a[2] + a[3])) + ((b[0] + b[1]) + (b[2] + b[3])) + ((c[0] + c[1]) + (c[2] + c[3])) + ((d[0] + d[1]) + (d[2] + d[3]));
        RSTD[row] = rsqrtf(ss * (1.0f / D) + EPS); }
}
__device__ __forceinline__ void hgrn_carry(const Params& P) {
    float* SLOC = (float*)(P.ws + WS_A2); const float* BSEG = (const float*)(P.ws + WS_BSEG);
    const int gt = blockIdx.x * 512 + threadIdx.x, NT = gridDim.x * 512;
    for (int idx = gt; idx < 64 * 16384; idx += NT) { const int chain = idx >> 14, e = idx & 16383, b = chain >> 3, h = (chain >> 1) & 3, d = chain & 1, k = e >> 7;
        float run = P.in[I_SH][(size_t)((b * 2 + d) * 4 + h) * 16384 + e];
        for (int jj = 0; jj < 16; ++jj) { const int ks = d ? 15 - jj : jj; const int slot = ((b * 16 + ks) << 3) | (h << 1) | d;
            const float tmp = SLOC[(size_t)slot * 16384 + e]; SLOC[(size_t)slot * 16384 + e] = run; run = __expf(BSEG[slot * 128 + k]) * run + tmp; } }
}

__device__ __forceinline__ void s5_build_tables(const Params& P, int dg) {
    const int lane = threadIdx.x & 63, n = lane & 31, hh = lane >> 5;
    unsigned char* tab = P.ws + WS_S5T + (size_t)dg * S5T_STRIDE;
    const float dt = __expf(P.in[I_LDT][dg]);
    float lr[2], li[2], cre[2], cim[2];
#pragma unroll
    for (int pp = 0; pp < 2; ++pp) { const int p = 32 * pp + n; const float lre = P.in[I_LRE][dg * 64 + p], lim = P.in[I_LIM][dg * 64 + p];
        const float mag = expf(lre * dt); float sn, cs; sincosf(lim * dt, &sn, &cs); lr[pp] = mag * cs; li[pp] = mag * sn;
        const float den = lre * lre + lim * lim; cre[pp] = ((lr[pp] - 1.0f) * lre + li[pp] * lim) / den; cim[pp] = (li[pp] * lre - (lr[pp] - 1.0f) * lim) / den;
        float ar = lr[pp], ai = li[pp];
#pragma unroll
        for (int q = 0; q < 8; ++q) { const float nr = ar * ar - ai * ai, ni = 2.0f * ar * ai; ar = nr; ai = ni; }
        if (hh == 0) { float* lam = (float*)(tab + 12288); lam[p] = lr[pp]; lam[64 + p] = li[pp]; lam[128 + p] = ar; lam[192 + p] = ai; } }
#pragma unroll
    for (int jt = 0; jt < 4; ++jt) { const int pp = jt & 1, part = jt >> 1, p = 32 * pp + n; float v[8];
        const float* br = P.in[I_BRE] + (size_t)(dg * 64 + p) * 16 + 8 * hh; const float* bi = P.in[I_BIM] + (size_t)(dg * 64 + p) * 16 + 8 * hh;
#pragma unroll
        for (int j = 0; j < 8; ++j) v[j] = part ? (cre[pp] * bi[j] + cim[pp] * br[j]) : (cre[pp] * br[j] - cim[pp] * bi[j]);
        *(u32x4*)(tab + jt * 1024 + lane * 16) = pack8(v); }
#pragma unroll
    for (int jt = 0; jt < 4; ++jt)
#pragma unroll
        for (int sx = 0; sx < 2; ++sx) { const int part = jt >> 1, p0 = 32 * (jt & 1) + 16 * sx + 8 * hh; float v[8];
            const float* cp = (part ? P.in[I_CIM] : P.in[I_CRE]) + (size_t)(dg * 16 + (n & 15)) * 64 + p0;
#pragma unroll
            for (int j = 0; j < 8; ++j) { const float c = cp[j]; v[j] = n < 16 ? (part ? -c : c) : 0.f; }
            *(u32x4*)(tab + 4096 + (jt * 2 + sx) * 1024 + lane * 16) = pack8(v); }
}
template <bool PASS2>
__device__ __forceinline__ void s5_task(const Params& P, LAS unsigned char* img, int task) {
    const int lane = threadIdx.x & 63, n = lane & 31, hh = lane >> 5;
    const int d = task & 1, g = (task >> 1) & 31, pr = task >> 6;
    const int segA = PASS2 ? 2 * pr : 32 + 2 * pr, myseg = segA + hh;
    const bf16_t* Z = (const bf16_t*)(P.ws + WS_Z);
    float* XLOC = (float*)(P.ws + WS_XLOC);
    const int dg = d * 32 + g;
    const unsigned char* tab = P.ws + WS_S5T + (size_t)dg * S5T_STRIDE; const float* lam = (const float*)(tab + 12288);
    float lr[2], li[2], xr[2], xi[2]; bf16x8 Bf[4], Cf[4][2];
#pragma unroll
    for (int pp = 0; pp < 2; ++pp) { lr[pp] = lam[32 * pp + n]; li[pp] = lam[64 + 32 * pp + n]; }
#pragma unroll
    for (int jt = 0; jt < 4; ++jt) Bf[jt] = *(const bf16x8*)(tab + jt * 1024 + lane * 16);
    if (PASS2) {
#pragma unroll
        for (int jt = 0; jt < 4; ++jt)
#pragma unroll
            for (int sx = 0; sx < 2; ++sx) Cf[jt][sx] = *(const bf16x8*)(tab + 4096 + (jt * 2 + sx) * 1024 + lane * 16);
    }
#pragma unroll
    for (int pp = 0; pp < 2; ++pp) { xr[pp] = 0.f; xi[pp] = 0.f; }
    if (PASS2 && myseg >= 32) { const int sb = (myseg - 32) >> 4, sk = (myseg - 32) & 15;
#pragma unroll
        for (int pp = 0; pp < 2; ++pp) { const int p = 32 * pp + n;
            const float ar = lam[128 + p], ai = lam[192 + p];
            float sr = P.in[I_SRE][(size_t)((sb * 2 + d) * 32 + g) * 64 + p], si = P.in[I_SIM][(size_t)((sb * 2 + d) * 32 + g) * 64 + p];
            const int cnt = d ? 15 - sk : sk;
            for (int jj = 0; jj < cnt; ++jj) { const int ks = d ? 15 - jj : jj; const float* xl = XLOC + (size_t)(((sb * 16 + ks) * 32 + g) * 2 + d) * 128;
                const float nr = ar * sr - ai * si + xl[p], ni = ar * si + ai * sr + xl[64 + p]; sr = nr; si = ni; }
            xr[pp] = sr; xi[pp] = si; }
    }
    const int arow_seg = segA + ((n >> 2) & 1), arow_pos = (n & 3) + 4 * (n >> 3);
    const int abase = seg_rowbase(arow_seg), mybase = seg_rowbase(myseg);
    bf16_t* YD = (bf16_t*)P.out + (size_t)d * M * 512;
    const unsigned ibase = (unsigned)(uintptr_t)img;
    const int i16 = lane & 15, q4 = i16 >> 2, p4 = i16 & 3, blk = (lane >> 4) & 1;
    const bf16_t* zu = Z + ZU + g * 16 + 8 * hh;
    bf16x8 aq[4];
#pragma unroll
    for (int u = 0; u < 4; ++u) { const int apos = 16 * u + arow_pos; aq[u] = *(const bf16x8*)(zu + (size_t)(abase + (d ? 255 - apos : apos)) * NZ); }
#pragma nounroll
    for (int tl = 0; tl < 16; ++tl) {
        const bf16x8 a = aq[0];
        aq[0] = aq[1]; aq[1] = aq[2]; aq[2] = aq[3];
        { const int apos = 16 * (tl < 12 ? tl + 4 : 15) + arow_pos; aq[3] = *(const bf16x8*)(zu + (size_t)(abase + (d ? 255 - apos : apos)) * NZ); }
        f32x16 bu[4];
#pragma unroll
        for (int jt = 0; jt < 4; ++jt) { f32x16 z;
#pragma unroll
            for (int i = 0; i < 16; ++i) z[i] = 0.f;
            bu[jt] = MFMA32(a, Bf[jt], z); }
        asm volatile("s_nop 15" : "+v"(bu[0]), "+v"(bu[1]), "+v"(bu[2]), "+v"(bu[3]));
#pragma unroll
        for (int i = 0; i < 16; ++i)
#pragma unroll
            for (int pp = 0; pp < 2; ++pp) {
                const float nr = __builtin_fmaf(-li[pp], xi[pp], __builtin_fmaf(lr[pp], xr[pp], bu[pp][i])), ni = __builtin_fmaf(li[pp], xr[pp], __builtin_fmaf(lr[pp], xi[pp], bu[2 + pp][i]));
                xr[pp] = nr; xi[pp] = ni; asm volatile("" : "+v"(xr[pp]), "+v"(xi[pp])); bu[pp][i] = xr[pp]; bu[2 + pp][i] = xi[pp]; }
        if (PASS2) {
#pragma unroll
            for (int jt = 0; jt < 4; ++jt)
#pragma unroll
                for (int g4 = 0; g4 < 4; ++g4) { u32x2 v; v.x = pk2(bu[jt][4 * g4], bu[jt][4 * g4 + 1]); v.y = pk2(bu[jt][4 * g4 + 2], bu[jt][4 * g4 + 3]);
                    *(LAS u32x2*)(img + jt * 2048 + n * 64 + 8 * (2 * g4 + hh)) = v; }
            LDS_WAIT();
            f32x16 y0, y1;
#pragma unroll
            for (int i = 0; i < 16; ++i) { y0[i] = 0.f; y1[i] = 0.f; }
            s16x4 r[16];
            { const unsigned b0 = ibase + 8 * (4 * blk + p4) + (8 * hh + q4) * 64;
              asm volatile("ds_read_b64_tr_b16 %0, %16\n\tds_read_b64_tr_b16 %1, %16 offset:256\n\tds_read_b64_tr_b16 %2, %16 offset:1024\n\tds_read_b64_tr_b16 %3, %16 offset:1280\n\t"
                           "ds_read_b64_tr_b16 %4, %16 offset:2048\n\tds_read_b64_tr_b16 %5, %16 offset:2304\n\tds_read_b64_tr_b16 %6, %16 offset:3072\n\tds_read_b64_tr_b16 %7, %16 offset:3328\n\t"
                           "ds_read_b64_tr_b16 %8, %16 offset:4096\n\tds_read_b64_tr_b16 %9, %16 offset:4352\n\tds_read_b64_tr_b16 %10, %16 offset:5120\n\tds_read_b64_tr_b16 %11, %16 offset:5376\n\t"
                           "ds_read_b64_tr_b16 %12, %16 offset:6144\n\tds_read_b64_tr_b16 %13, %16 offset:6400\n\tds_read_b64_tr_b16 %14, %16 offset:7168\n\tds_read_b64_tr_b16 %15, %16 offset:7424\n\ts_waitcnt lgkmcnt(0)"
                           : "=&v"(r[0]), "=&v"(r[1]), "=&v"(r[2]), "=&v"(r[3]), "=&v"(r[4]), "=&v"(r[5]), "=&v"(r[6]), "=&v"(r[7]),
                             "=&v"(r[8]), "=&v"(r[9]), "=&v"(r[10]), "=&v"(r[11]), "=&v"(r[12]), "=&v"(r[13]), "=&v"(r[14]), "=&v"(r[15])
                           : "v"(b0) : "memory"); }
#pragma unroll
            for (int jt = 0; jt < 4; ++jt) {
                const bf16x8 xa0 = __builtin_shufflevector(r[4 * jt], r[4 * jt + 1], 0, 1, 2, 3, 4, 5, 6, 7), xa1 = __builtin_shufflevector(r[4 * jt + 2], r[4 * jt + 3], 0, 1, 2, 3, 4, 5, 6, 7);
                y0 = MFMA32(Cf[jt][0], xa0, y0); y1 = MFMA32(Cf[jt][1], xa1, y1); }
            asm volatile("s_nop 15" : "+v"(y0), "+v"(y1));
            { const int ypos = 16 * tl + arow_pos; const int yrow = abase + (d ? 255 - ypos : ypos);
              bf16_t* yp = YD + (size_t)yrow * 512 + g * 16 + 4 * hh;
              u32x2 w0, w1; w0.x = pk2(y0[0] + y1[0], y0[1] + y1[1]); w0.y = pk2(y0[2] + y1[2], y0[3] + y1[3]); w1.x = pk2(y0[4] + y1[4], y0[5] + y1[5]); w1.y = pk2(y0[6] + y1[6], y0[7] + y1[7]);
              *(u32x2*)yp = w0; *(u32x2*)(yp + 8) = w1; }
        }
    }
    if (!PASS2) { float* xl = XLOC + (size_t)(((myseg - 32) * 32 + g) * 2 + d) * 128;
#pragma unroll
        for (int pp = 0; pp < 2; ++pp) { xl[32 * pp + n] = xr[pp]; xl[64 + 32 * pp + n] = xi[pp]; }
    } else if (myseg < 32) {
#pragma unroll
        for (int pp = 0; pp < 2; ++pp) { const size_t o = (size_t)((myseg * 2 + d) * 32 + g) * 64 + 32 * pp + n; P.out[OUT_SRE + o] = xr[pp]; P.out[OUT_SIM + o] = xi[pp]; }
    }
}

__device__ __forceinline__ float fgelu_tanh(float y) { const float z = 0.7978845608f * (y + 0.044715f * y * y * y); const float t = 1.0f - 2.0f * __builtin_amdgcn_rcpf(1.0f + __expf(2.0f * z)); return 0.5f * y * (1.0f + t); }
__device__ __forceinline__ void combine_a(const Params& P, int wg0) {
    if ((int)blockIdx.x < wg0) return;
    const int lane = threadIdx.x & 63, gw = (blockIdx.x - wg0) * 8 + (threadIdx.x >> 6), NGW = (gridDim.x - wg0) * 8, c0 = lane * 8;
    const bf16_t* OF = (const bf16_t*)(P.ws + WS_H); const bf16_t* OBk = OF + (size_t)M * 512;
    const bf16_t* Z = (const bf16_t*)(P.ws + WS_Z); bf16_t* A2 = (bf16_t*)(P.ws + WS_A2);
    float hg[8];
#pragma unroll
    for (int e = 0; e < 8; ++e) hg[e] = P.in[I_HG][c0 + e];
    for (int m = gw; m < M; m += NGW) {
        float a[8], b[8], ga[8], o[8];
        unpack8(*(const u32x4*)(OF + (size_t)m * 512 + c0), a); unpack8(*(const u32x4*)(OBk + (size_t)m * 512 + c0), b); unpack8(*(const u32x4*)(Z + (size_t)m * NZ + ZGA + c0), ga);
        float ss = 0.f;
#pragma unroll
        for (int e = 0; e < 8; ++e) { a[e] += b[e]; ss += a[e] * a[e]; }
        ss += __shfl_xor(ss, 1); ss += __shfl_xor(ss, 2); ss += __shfl_xor(ss, 4); ss += __shfl_xor(ss, 8);
        const float r = rsqrtf(ss * (1.0f / 128.0f) + EPS);
#pragma unroll
        for (int e = 0; e < 8; ++e) o[e] = a[e] * r * hg[e] * ga[e];
        *(u32x4*)(A2 + (size_t)m * 1024 + c0) = pack8(o);
    }
}
__device__ __forceinline__ void combine_b(const Params& P) {
    const int lane = threadIdx.x & 63, gw = blockIdx.x * 8 + (threadIdx.x >> 6), NGW = gridDim.x * 8, c0 = lane * 8;
    const bf16_t* YF = (const bf16_t*)P.out; const bf16_t* YB = YF + (size_t)M * 512;
    const bf16_t* Z = (const bf16_t*)(P.ws + WS_Z); bf16_t* YBF = (bf16_t*)(P.ws + WS_YBF);
    float dsk[8];
#pragma unroll
    for (int e = 0; e < 8; ++e) dsk[e] = P.in[I_S5D][c0 + e];
    for (int m = gw; m < M; m += NGW) {
        float yf[8], yb[8], uu[8], y[8];
        unpack8(*(const u32x4*)(YF + (size_t)m * 512 + c0), yf); unpack8(*(const u32x4*)(YB + (size_t)m * 512 + c0), yb); unpack8(*(const u32x4*)(Z + (size_t)m * NZ + ZU + c0), uu);
#pragma unroll
        for (int e = 0; e < 8; ++e) y[e] = fgelu_tanh(yf[e] + yb[e] + dsk[e] * uu[e]);
        *(u32x4*)(YBF + (size_t)m * 512 + c0) = pack8(y);
    }
}
__device__ __forceinline__ void phase_conv(const Params& P) {
    const bf16_t* PB = (const bf16_t*)(P.ws + WS_Z + 160 * MiB); const bf16_t* GB = (const bf16_t*)(P.ws + WS_A2); bf16_t* A3 = (bf16_t*)(P.ws + WS_Z + 80 * MiB);
    const int gt = blockIdx.x * 512 + threadIdx.x, NT = gridDim.x * 512;
    for (int idx = gt; idx < MP * 128; idx += NT) { const int row = idx >> 7, c0 = (idx & 127) * 8;
        const int pos = row < MP ? (row & 255) : ((row - MP) & 63), L = row < MP ? 256 : 64;
        float p0[8], p1[8], p2[8], gg[8], o[8];
        const u32x4 zero = (u32x4){0u, 0u, 0u, 0u};
        unpack8(pos > 0 ? *(const u32x4*)(PB + (size_t)(row - 1) * D + c0) : zero, p0);
        unpack8(*(const u32x4*)(PB + (size_t)row * D + c0), p1);
        unpack8(pos < L - 1 ? *(const u32x4*)(PB + (size_t)(row + 1) * D + c0) : zero, p2);
        unpack8(*(const u32x4*)(GB + (size_t)row * D + c0), gg);
        const float* cw = P.in[I_CW] + c0; const float* cb = P.in[I_CB] + c0;
#pragma unroll
        for (int e = 0; e < 8; ++e) o[e] = gg[e] * (cw[e] * p0[e] + cw[1024 + e] * p1[e] + cw[2048 + e] * p2[e] + cb[e]);
        *(u32x4*)(A3 + (size_t)row * D + c0) = pack8(o); }
}

#define XB_TMO      128
#define XB_XCNT(j)  (256  + 64 * (j))
#define XB_XSUB(j)  (1280 + 64 * (j))
#define XB_XGEN(j)  (2304 + 64 * (j))
#define XB_TOP      3328
#define XB_TOPGEN   3392
#define XCD_BAR_WORDS 3456
#define XB_SPIN_CAP (1u << 18)

__device__ __forceinline__ unsigned xb_ld(unsigned* p)              { return __hip_atomic_load(p, __ATOMIC_RELAXED, __HIP_MEMORY_SCOPE_AGENT); }
__device__ __forceinline__ unsigned xb_add(unsigned* p, unsigned v) { return __hip_atomic_fetch_add(p, v, __ATOMIC_RELAXED, __HIP_MEMORY_SCOPE_AGENT); }
__device__ __forceinline__ unsigned xb_xcc_id() { return (unsigned)__builtin_amdgcn_s_getreg((3 << 11) | 20) & 0xFu; }
#define XB_SPIN(cond, bar) do { unsigned _sp = 0; while (cond) { __builtin_amdgcn_s_sleep(1); \
    if ((++_sp & 255u) == 0u) { if (xb_ld(&(bar)[XB_TMO])) break; if (_sp > XB_SPIN_CAP) { atomicAdd(&(bar)[XB_TMO], 1u); break; } } } } while (0)

struct XcdBarrier {
    unsigned* bar; unsigned x;
    volatile LAS unsigned* st;
};

__device__ __forceinline__ XcdBarrier xcd_barrier_post(unsigned* bar, volatile LAS unsigned* st) {
    XcdBarrier b; b.bar = bar; b.x = xb_xcc_id(); b.st = st;
    if (threadIdx.x == 0) (void)xb_add(&bar[XB_XCNT(b.x)], 1u);
    return b;
}
__device__ __forceinline__ void xcd_barrier_complete(unsigned* bar, unsigned x, unsigned& nloc, unsigned& nx) {
    const unsigned G = gridDim.x * gridDim.y * gridDim.z;
    unsigned sum, cnt, mine, sp = 0u;
    for (;;) {
        sum = 0u; cnt = 0u; mine = 0u;
#pragma unroll
        for (unsigned j = 0; j < 16; ++j) { const unsigned c = xb_ld(&bar[XB_XCNT(j)]); sum += c; cnt += (c > 0u) ? 1u : 0u; mine = (j == x) ? c : mine; }
        if (sum == G) break;
        __builtin_amdgcn_s_sleep(1);
        if ((++sp & 255u) == 0u) { if (xb_ld(&bar[XB_TMO])) break; if (sp > XB_SPIN_CAP) { atomicAdd(&bar[XB_TMO], 1u); break; } }
    }
    nloc = mine > 0u ? mine : 1u; nx = cnt > 0u ? cnt : 1u;
}

__device__ __forceinline__ void xcd_barrier(const XcdBarrier& b) {
    asm volatile("s_waitcnt vmcnt(0)" ::: "memory");
    __syncthreads();
    if (threadIdx.x == 0) {
        unsigned* bar = b.bar;
        __builtin_amdgcn_s_waitcnt(0);
        unsigned nloc = b.st[0], nx = b.st[1];
        if (nloc == 0u) { xcd_barrier_complete(bar, b.x, nloc, nx); b.st[0] = nloc; b.st[1] = nx; }
        const unsigned old = xb_add(&bar[XB_XSUB(b.x)], 1u);
        const unsigned gen = old / nloc;
        if (old + 1u == (gen + 1u) * nloc) {
            __builtin_amdgcn_fence(__ATOMIC_RELEASE, "agent");
            asm volatile("s_waitcnt vmcnt(0)" ::: "memory");
            const unsigned og = xb_add(&bar[XB_TOP], 1u);
            const unsigned tg = og / nx;
            if (og + 1u == (tg + 1u) * nx) xb_add(&bar[XB_TOPGEN], 1u);
            else XB_SPIN(xb_ld(&bar[XB_TOPGEN]) == tg, bar);
            __builtin_amdgcn_fence(__ATOMIC_ACQUIRE, "agent");
            xb_add(&bar[XB_XGEN(b.x)], 1u);
            asm volatile("s_waitcnt vmcnt(0)" ::: "memory");
        } else {
            XB_SPIN(xb_ld(&bar[XB_XGEN(b.x)]) == gen, bar);
            __builtin_amdgcn_fence(__ATOMIC_ACQUIRE, "agent");
            asm volatile("s_waitcnt vmcnt(0)" ::: "memory");
        }
    }
    __syncthreads();
}


constexpr int LDS_BYTES = 131072 + 64 + 4096;
constexpr int NPHASE = 13;
__global__ void __launch_bounds__(512, 2) mk_fwd(Params P) {
    extern __shared__ __attribute__((aligned(16))) unsigned char lds_raw[];
    LAS unsigned char* lds = (LAS unsigned char*)lds_raw;
    cg::grid_group grid = cg::this_grid();
    const int lo = P.ph_lo, hi = P.ph_hi;
    if (threadIdx.x < 4) ((LAS unsigned*)(lds + 131072))[threadIdx.x] = 0u;
    __syncthreads();
    XcdBarrier bar = xcd_barrier_post((unsigned*)P.ws + P.li * XCD_BAR_WORDS, (volatile LAS unsigned*)(lds + 131072));
    if (hi < 0) grid.sync();
    const int wave = threadIdx.x >> 6;
    bf16_t* H = (bf16_t*)(P.ws + WS_H); bf16_t* Zb = (bf16_t*)(P.ws + WS_Z); bf16_t* A2 = (bf16_t*)(P.ws + WS_A2); bf16_t* YBF = (bf16_t*)(P.ws + WS_YBF);
    float* MOD = (float*)(P.ws + WS_MOD); bf16_t* Y1b = (bf16_t*)(P.ws + WS_Z);
#ifndef PHMASK
#define PHMASK 0x3fff
#endif
#ifndef DBLMASK
#define DBLMASK 0
#endif
#ifndef STAGGER_TICKS
#define STAGGER_TICKS 1300
#endif
#define STAGGER() do { if (blockIdx.x >= 128) { const unsigned long long t0_ = __builtin_amdgcn_s_memrealtime(); while (__builtin_amdgcn_s_memrealtime() - t0_ < STAGGER_TICKS) __builtin_amdgcn_s_sleep(8); } } while (0)
#define IN(k) (((PHMASK >> (k)) & 1) && lo <= (k) && (k) < hi)
#ifdef USE_CG_SYNC
#define SEAM(k) do { if (lo <= (k) && (k) + 1 < hi) grid.sync(); } while (0)
#else
#define SEAM(k) do { if (lo <= (k) && (k) + 1 < hi) xcd_barrier(bar); } while (0)
#endif
    if (IN(0)) phase0(P, lds);
    SEAM(0);
    if (IN(1)) phase_norm(P.in[I_XP], P.in[I_XS], P.in[I_NORMG], MOD, H);
    SEAM(1);
    if (IN(2)) { pg8::Gemm g{H, (const bf16_t*)(P.ws + WS_WIN_E), M, NZ, 1024}; pg8::StaticOrder S; S.init(M, NZ, gridDim.x, blockIdx.x);
        EpiZ E{Zb, P.in[I_LB]}; pg8::gemm_phase<EpiZ, pg8::StaticOrder>(lds, g, S, E); }
    SEAM(2);
    if (IN(3)) {
        for (int t = blockIdx.x; t < 1024; t += gridDim.x) hgrn_pass1_task(P, lds, t);
        for (int t = blockIdx.x * 8 + wave; t < 4096; t += gridDim.x * 8) s5_task<false>(P, lds + wave * 8192, t);
    }
    SEAM(3);
    if (IN(4)) {
        hgrn_carry(P);
        const int nslot = gridDim.x * 8, full = (5120 / nslot) * nslot;
        for (int t = blockIdx.x * 8 + wave; t < full; t += nslot) s5_task<true>(P, lds + wave * 8192, t);
        if (wave < 4) for (int t = full + blockIdx.x * 4 + wave; t < 5120; t += gridDim.x * 4) s5_task<true>(P, lds + wave * 8192, t);
    }
    SEAM(4);
    if (IN(5)) {
        for (int t = blockIdx.x; t < 1280; t += gridDim.x) hgrn_task<true>(P, lds, t);
        combine_b(P);
    }
    SEAM(5);
    if (IN(6)) {
        pg8::Gemm g{YBF, (const bf16_t*)(P.ws + WS_WGLU), M, 512, 512}; pg8::StaticOrder S; S.init(M, 512, gridDim.x, blockIdx.x);
        EpiGlu E{YBF, Zb, P.in[I_BGLU], A2}; pg8::gemm_phase<EpiGlu, pg8::StaticOrder>(lds, g, S, E);
        combine_a(P, gridDim.x > 128 ? 64 : 0);
    }
    SEAM(6);
    if (IN(7)) { pg8::Gemm g{A2, (const bf16_t*)(P.ws + WS_WOUT_E), M, 1024, 1024}; pg8::StaticOrder S; S.init(M, 1024, gridDim.x, blockIdx.x);
        EpiRes3 E{P.in[I_XP], P.in[I_XS], MOD, MOD + 9 * 3072, P.in[I_NORMG] + 1024, Y1b, H, (float*)(P.ws + WS_SSP), lds + 131072 + 64}; pg8::gemm_phase<EpiRes3, pg8::StaticOrder>(lds, g, S, E);
        sw_items(P, lds, gridDim.x >= 256 ? 128 : 0); }
    SEAM(7);
    if (IN(8)) phase_rstd(P);
    SEAM(8);
    if (IN(9)) { pg8::Gemm g{H, (const bf16_t*)(P.ws + WS_WIN_O), M, 4096, 1024}; pg8::StaticOrder S; S.init(M, 4096, gridDim.x, blockIdx.x);
        EpiOdd E{(bf16_t*)(P.ws + WS_Z + 160 * MiB), A2, (const float*)(P.ws + WS_RSTD), (const float*)(P.ws + WS_SW), (bf16_t*)(P.ws + WS_Z + 80 * MiB), P.in[I_CW], P.in[I_CB]}; pg8::gemm_phase<EpiOdd, pg8::StaticOrder>(lds, g, S, E); }
    SEAM(9);
    if (IN(10)) phase_conv(P);
    SEAM(10);
    if (IN(11)) { pg8::Gemm g{(const bf16_t*)(P.ws + WS_Z + 80 * MiB), (const bf16_t*)(P.ws + WS_WOUT_O), M, 1024, 1024}; pg8::StaticOrder S; S.init(M, 1024, gridDim.x, blockIdx.x);
        EpiRes5 E{Y1b, MOD + 9 * 3072, P.in[I_FNG], H, (float*)(P.ws + WS_SSP)}; pg8::gemm_phase<EpiRes5, pg8::StaticOrder>(lds, g, S, E); }
    SEAM(11);
    if (IN(12)) phase_final_norm(P.out, H, (const float*)(P.ws + WS_SSP));
#undef IN
#undef SEAM
}

extern "C" void kernel_launch(void* const* d_in, const int* in_sizes, int n_in, void* d_out, int out_size, void* d_ws, size_t ws_size, hipStream_t stream) {
    static int grid = 0;
    if (grid == 0) {
        if (n_in != 29 || ws_size < WS_END) { fprintf(stderr, "kernel_launch: unexpected n_in %d / ws_size %zu (need %zu)\n", n_in, ws_size, (size_t)WS_END); grid = -1; return; }
        int dev = 0, cus = 0, per_cu = 0;
        hipGetDevice(&dev); hipDeviceGetAttribute(&cus, hipDeviceAttributeMultiprocessorCount, dev);
        if (hipFuncSetAttribute((const void*)mk_fwd, hipFuncAttributeMaxDynamicSharedMemorySize, LDS_BYTES) != hipSuccess) { fprintf(stderr, "kernel_launch: hipFuncSetAttribute failed\n"); grid = -1; return; }
        if (hipOccupancyMaxActiveBlocksPerMultiprocessor(&per_cu, (const void*)mk_fwd, 512, LDS_BYTES) != hipSuccess || per_cu < 1) { fprintf(stderr, "kernel_launch: occupancy query says %d\n", per_cu); per_cu = 1; }
        (void)hipGetLastError();
        grid = cus * per_cu;
        fprintf(stderr, "kernel_launch: grid %d (cus %d x %d)\n", grid, cus, per_cu);
    }
    if (grid < 0) return;
    Params p{};
    (void)hipMemsetAsync(d_ws, 0, 65536, stream);
    for (int i = 0; i < 29; ++i) p.in[i] = (const float*)d_in[i];
    p.out = (float*)d_out; p.ws = (unsigned char*)d_ws;
#if MK_COOP
    void* args[] = {&p};
#ifdef PROBE_SPLIT
    p.ph_lo = 0; p.ph_hi = PROBE_SPLIT + 1;
    (void)hipLaunchCooperativeKernel((const void*)mk_fwd, dim3(grid), dim3(512), args, LDS_BYTES, stream);
    p.ph_lo = PROBE_SPLIT; p.ph_hi = NPHASE; p.li = 1;
#else
    p.ph_lo = 0; p.ph_hi = NPHASE;
#endif
    hipError_t e = hipLaunchCooperativeKernel((const void*)mk_fwd, dim3(grid), dim3(512), args, LDS_BYTES, stream);
    if (e != hipSuccess) fprintf(stderr, "kernel_launch: cooperative launch failed: %s (grid %d)\n", hipGetErrorString(e), grid);
#else
    for (int ph = 0; ph < NPHASE; ++ph) { p.ph_lo = ph; p.ph_hi = ph + 1; hipLaunchKernelGGL(mk_fwd, dim3(grid), dim3(512), LDS_BYTES, stream, p); }
#endif
}
```

```cpp
#include <hip/hip_runtime.h>
#include <hip/hip_cooperative_groups.h>
#include <cstdio>
#include <cstdint>
namespace cg = cooperative_groups;
#ifndef MK_COOP
#define MK_COOP 1
#endif

namespace pg8 {
#define PG8_LAS __attribute__((address_space(3)))
typedef unsigned short bf16_t;
typedef short bf16x8 __attribute__((ext_vector_type(8)));
typedef float f32x4 __attribute__((ext_vector_type(4)));
typedef unsigned u32x4 __attribute__((ext_vector_type(4)));
constexpr int BM = 256, BK = 64, HALF = 128, HTB = HALF * BK * 2  , STAGE_BYTES = 8 * HTB, NXCD = 8, WGM = 8;

__host__ __device__ __forceinline__ int lds_byte(int r, int c) { const int st = (r >> 4) * 2 + (c >> 5), rr = r & 15, cc = c & 31, ob = rr * 64 + cc * 2; return st * 1024 + (ob ^ (((ob >> 9) & 1) << 5)); }
__host__ __device__ __forceinline__ void stage_rc(int b, int& R, int& C) { const int st = b / 1024, sb = b % 1024, swz = sb ^ (((sb >> 9) & 1) << 5); R = (st >> 1) * 16 + swz / 64; C = (st & 1) * 32 + (swz % 64) / 2; }
__host__ __device__ __forceinline__ int perm32(int rho) { const int n = rho >> 4, i = rho & 15; return 8 * (i >> 2) + 4 * n + (i & 3); }

struct Unit { int pm, pn; };
struct Gemm { const bf16_t* A; const bf16_t* Bt; int M, N, K; };

struct StaticOrder {
    int nM, nN, nwg, G, c;
    __host__ __device__ void init(int M, int N, int G_, int c_) { nM = M / BM; nN = N / BM; nwg = nM * nN; G = G_; c = c_; }
    __host__ __device__ bool next(int i, Unit& u) const {
        const long L = (long)i * G + c; if (L >= nwg) return false;
        int wgid = (int)L; { const int q = nwg / NXCD, r = nwg % NXCD, xcd = wgid % NXCD, off = wgid / NXCD; wgid = (xcd < r ? xcd * (q + 1) : r * (q + 1) + (xcd - r) * q) + off; }
        const int nig = WGM * nN, gid = wgid / nig, fm = gid * WGM, gsz = (nM - fm) < WGM ? (nM - fm) : WGM;
        u.pm = fm + ((wgid % nig) % gsz); u.pn = (wgid % nig) / gsz; return true;
    }
    __device__ __forceinline__ void a_ready(const Unit&) const {}
    __device__ __forceinline__ void done(const Unit&) const {}
};

__device__ __forceinline__ unsigned cvt_pk_bf16(float lo, float hi) { unsigned r; asm volatile("v_cvt_pk_bf16_f32 %0, %1, %2" : "=v"(r) : "v"(lo), "v"(hi)); return r; }

template <class Epi, class Sched>
__device__ __forceinline__ void gemm_phase(PG8_LAS unsigned char* lds, const Gemm g, const Sched& S, const Epi& E) {
    const int tid = threadIdx.x, wid = __builtin_amdgcn_readfirstlane(tid >> 6), lane = tid & 63, wr = wid >> 2, wc = wid & 3, fr = lane & 15, fq = lane >> 4;
    const int K = g.K, nt = K / BK;
    unsigned voffA[2], voffB[2];
#pragma unroll
    for (int i = 0; i < 2; ++i) { int R, C; stage_rc(tid * 16 + i * 8192, R, C); const int Rb = Epi::PERM ? ((R & ~31) + perm32(R & 31)) : R;
        voffA[i] = (unsigned)(R * K + C) * 2u; voffB[i] = (unsigned)(Rb * K + C) * 2u; }
    const size_t kstep = (size_t)(BK * 2);
    const size_t hstep = (size_t)HALF * K * 2;
    const size_t tstep = 2 * hstep;
    const unsigned ldsw = (unsigned)wid * 1024u;
    const int aoff = lds_byte(wr * 64 + fr, fq * 8), boff = lds_byte(wc * 32 + fr, fq * 8);
#define PG8_SA(b, h) (((b) * 2 + (h)) * HTB)
#define PG8_SB(b, h) ((4 + (b) * 2 + (h)) * HTB)
#define PG8_STAGE(bufoff, gbase, voff) do { _Pragma("unroll") for (int _i = 0; _i < 2; ++_i) \
        __builtin_amdgcn_global_load_lds((const unsigned*)((const char*)(gbase) + (voff)[_i]), (PG8_LAS unsigned*)(lds + (bufoff) + ldsw + _i * 8192), 16, 0, 0); } while (0)
#define PG8_LDA(dst, b, h) do { _Pragma("unroll") for (int m = 0; m < 4; ++m) _Pragma("unroll") for (int k = 0; k < 2; ++k) dst[m][k] = *(const PG8_LAS bf16x8*)(lds + PG8_SA(b, h) + aoff + m * 2048 + k * 1024); } while (0)
#define PG8_LDB(dst, b, h) do { _Pragma("unroll") for (int n = 0; n < 2; ++n) _Pragma("unroll") for (int k = 0; k < 2; ++k) dst[n][k] = *(const PG8_LAS bf16x8*)(lds + PG8_SB(b, h) + boff + n * 2048 + k * 1024); } while (0)
#define PG8_MMA(ai, bj, At, Bt) do { __builtin_amdgcn_s_setprio(1); _Pragma("unroll") for (int m = 0; m < 4; ++m) _Pragma("unroll") for (int n = 0; n < 2; ++n) _Pragma("unroll") for (int k = 0; k < 2; ++k) \
        acc[ai][bj][m][n] = __builtin_amdgcn_mfma_f32_16x16x32_bf16(Bt[n][k], At[m][k], acc[ai][bj][m][n], 0, 0, 0); __builtin_amdgcn_s_setprio(0); } while (0)
#define PG8_WAIT_V(n) asm volatile("s_waitcnt vmcnt(" #n ")" ::: "memory")
#define PG8_WAIT_L(n) asm volatile("s_waitcnt lgkmcnt(" #n ")" ::: "memory")
#define PG8_BAR __builtin_amdgcn_s_barrier()
#define PG8_SCHED __builtin_amdgcn_sched_barrier(0)
    Unit cur, nxt; int ui = 0;
    if (!S.next(0, cur)) return;
    f32x4 acc[2][2][4][2];
#pragma unroll
    for (int a = 0; a < 2; ++a)
#pragma unroll
        for (int b = 0; b < 2; ++b)
#pragma unroll
            for (int m = 0; m < 4; ++m)
#pragma unroll
                for (int n = 0; n < 2; ++n) acc[a][b][m][n] = (f32x4){0.f, 0.f, 0.f, 0.f};
    bf16x8 At[4][2], B0[2][2], B1[2][2];
    const char* cA = (const char*)g.A + (size_t)cur.pm * tstep; const char* cB = (const char*)g.Bt + (size_t)cur.pn * tstep;
    S.a_ready(cur);
    PG8_STAGE(PG8_SB(0, 0), cB, voffB); PG8_STAGE(PG8_SA(0, 0), cA, voffA); PG8_STAGE(PG8_SB(0, 1), cB + hstep, voffB); PG8_STAGE(PG8_SA(0, 1), cA + hstep, voffA);
    if (wr == 1) PG8_BAR;
    PG8_WAIT_V(4); PG8_BAR;
    PG8_STAGE(PG8_SB(1, 0), cB + kstep, voffB); PG8_STAGE(PG8_SA(1, 0), cA + kstep, voffA); PG8_STAGE(PG8_SB(1, 1), cB + hstep + kstep, voffB);
    PG8_WAIT_V(6); PG8_BAR;
    for (;;) {
        const bool has_next = S.next(ui + 1, nxt);
        const char* nA = has_next ? (const char*)g.A + (size_t)nxt.pm * tstep : cA; const char* nB = has_next ? (const char*)g.Bt + (size_t)nxt.pn * tstep : cB;
        for (int t = 0; t < nt; t += 2) {
            const bool last = (t == nt - 2);
            const char* a1 = cA + (size_t)(t + 1) * kstep;
            const char* a2 = last ? nA : cA + (size_t)(t + 2) * kstep; const char* b2 = last ? nB : cB + (size_t)(t + 2) * kstep;
            const char* a3 = a2 + kstep; const char* b3 = b2 + kstep;
            if (last && has_next) S.a_ready(nxt);
            PG8_LDB(B0, 0, 0); PG8_SCHED; PG8_LDA(At, 0, 0); PG8_STAGE(PG8_SA(1, 1), a1 + hstep, voffA);
            PG8_WAIT_L(8); PG8_BAR; PG8_WAIT_L(0); PG8_MMA(0, 0, At, B0); PG8_BAR; PG8_SCHED;
            PG8_LDB(B1, 0, 1); PG8_STAGE(PG8_SB(0, 0), b2, voffB);
            PG8_BAR; PG8_WAIT_L(0); PG8_MMA(0, 1, At, B1); PG8_BAR;
            PG8_LDA(At, 0, 1); PG8_STAGE(PG8_SA(0, 0), a2, voffA);
            PG8_BAR; PG8_WAIT_L(0); PG8_MMA(1, 0, At, B0); PG8_BAR; PG8_SCHED;
            PG8_STAGE(PG8_SB(0, 1), b2 + hstep, voffB);
            PG8_WAIT_V(6); PG8_BAR; PG8_MMA(1, 1, At, B1); PG8_BAR;
            PG8_LDB(B0, 1, 0); PG8_SCHED; PG8_LDA(At, 1, 0); PG8_STAGE(PG8_SA(0, 1), a2 + hstep, voffA);
            PG8_WAIT_L(8); PG8_BAR; PG8_WAIT_L(0); PG8_MMA(0, 0, At, B0); PG8_BAR; PG8_SCHED;
            PG8_LDB(B1, 1, 1); PG8_STAGE(PG8_SB(1, 0), b3, voffB);
            PG8_BAR; PG8_WAIT_L(0); PG8_MMA(0, 1, At, B1); PG8_BAR;
            PG8_LDA(At, 1, 1); PG8_STAGE(PG8_SA(1, 0), a3, voffA);
            PG8_BAR; PG8_WAIT_L(0); PG8_MMA(1, 0, At, B0); PG8_BAR; PG8_SCHED;
            PG8_STAGE(PG8_SB(1, 1), b3 + hstep, voffB);
            PG8_WAIT_V(6); PG8_BAR; PG8_MMA(1, 1, At, B1); PG8_BAR;
        }
        if constexpr (!Epi::AFTER_DRAIN) { E(acc, cur, wr, wc, fr, fq); S.done(cur); }
        if (!has_next) break;
#pragma unroll
        for (int a = 0; a < 2; ++a)
#pragma unroll
            for (int b = 0; b < 2; ++b)
#pragma unroll
                for (int m = 0; m < 4; ++m)
#pragma unroll
                    for (int n = 0; n < 2; ++n) acc[a][b][m][n] = (f32x4){0.f, 0.f, 0.f, 0.f};
        cur = nxt; cA = nA; cB = nB; ++ui;
    }
    PG8_WAIT_V(0);
    if (wr == 0) PG8_BAR;
    PG8_BAR;
    if constexpr (Epi::AFTER_DRAIN) { E.fused(acc, cur, wr, wc, fr, fq, lds, wid, lane); S.done(cur); }
#undef PG8_SA
#undef PG8_SB
#undef PG8_STAGE
#undef PG8_LDA
#undef PG8_LDB
#undef PG8_MMA
#undef PG8_WAIT_V
#undef PG8_WAIT_L
#undef PG8_BAR
#undef PG8_SCHED
}
}


#define LAS __attribute__((address_space(3)))
typedef unsigned short bf16_t;
typedef short bf16x8 __attribute__((ext_vector_type(8)));
typedef short s16x4 __attribute__((ext_vector_type(4)));
typedef float f32x4 __attribute__((ext_vector_type(4)));
typedef float f32x16 __attribute__((ext_vector_type(16)));
typedef unsigned u32x4 __attribute__((ext_vector_type(4)));
typedef unsigned u32x2 __attribute__((ext_vector_type(2)));

constexpr int D = 1024, MP = 8192, MS = 32768, M = 40960, NZ = 3584;
constexpr int ZQ = 0, ZF = 512, ZV = 1536, ZGA = 2048, ZU = 2560, ZGB = 3072;
constexpr float EPS = 1e-6f;
constexpr size_t MiB = 1u << 20;
constexpr size_t WS_S5T = 128 * 1024;
constexpr size_t S5T_STRIDE = 13312;
constexpr size_t WS_MOD = 1 * MiB;
constexpr size_t WS_BSEG = 1 * MiB + 512 * 1024;
constexpr size_t WS_WIN_E = 2 * MiB;
constexpr size_t WS_WOUT_E = 10 * MiB;
constexpr size_t WS_WGLU = 12 * MiB;
constexpr size_t WS_WIN_O = 13 * MiB;
constexpr size_t WS_WOUT_O = 21 * MiB;
constexpr size_t WS_XLOC = 23 * MiB;
constexpr size_t WS_SSP = 27 * MiB;
constexpr size_t WS_RSTD = 30 * MiB;
constexpr size_t WS_SW = 31 * MiB;
constexpr size_t WS_H = 32 * MiB;
constexpr size_t WS_Z = 112 * MiB;
constexpr size_t WS_A2 = 392 * MiB;
constexpr size_t WS_YBF = 472 * MiB;
constexpr size_t WS_END = 512 * MiB;
constexpr size_t OUT_YS = (size_t)MP * D, OUT_SH = (size_t)M * D, OUT_SRE = OUT_SH + 32 * 2 * 4 * 128 * 128, OUT_SIM = OUT_SRE + 32 * 2 * 32 * 64;

struct Params { const float* in[29]; float* out; unsigned char* ws; int ph_lo, ph_hi, li, pad; };
enum { I_XP = 0, I_XS, I_SH, I_SRE, I_SIM, I_C, I_CCTX, I_NORMG, I_WMOD, I_BMOD, I_WINE, I_WOUTE, I_LB, I_HG, I_LRE, I_LIM, I_LDT, I_BRE, I_BIM, I_CRE, I_CIM, I_S5D, I_WGLU, I_BGLU, I_WINO, I_WOUTO, I_CW, I_CB, I_FNG };

__device__ __forceinline__ float bf2f(unsigned x) { return __uint_as_float(x << 16); }
__device__ __forceinline__ float bflo(unsigned w) { return __uint_as_float(w << 16); }
__device__ __forceinline__ float bfhi(unsigned w) { return __uint_as_float(w & 0xffff0000u); }
typedef __bf16 bf16v2 __attribute__((ext_vector_type(2)));
__device__ __forceinline__ unsigned pk2(float lo, float hi) { bf16v2 v; v[0] = (__bf16)lo; v[1] = (__bf16)hi; return __builtin_bit_cast(unsigned, v); }
__device__ __forceinline__ float fsigmoid(float x) { return __builtin_amdgcn_rcpf(1.0f + __expf(-x)); }
__device__ __forceinline__ float fsilu(float x) { return x * fsigmoid(x); }
__device__ __forceinline__ float wave_sum(float v) {
#pragma unroll
    for (int o = 1; o < 64; o <<= 1) v += __shfl_xor(v, o);
    return v;
}
__device__ __forceinline__ void unpack8(const u32x4 w, float (&f)[8]) {
    f[0] = bflo(w.x); f[1] = bfhi(w.x); f[2] = bflo(w.y); f[3] = bfhi(w.y); f[4] = bflo(w.z); f[5] = bfhi(w.z); f[6] = bflo(w.w); f[7] = bfhi(w.w);
}
__device__ __forceinline__ u32x4 pack8(const float (&f)[8]) { u32x4 w; w.x = pk2(f[0], f[1]); w.y = pk2(f[2], f[3]); w.z = pk2(f[4], f[5]); w.w = pk2(f[6], f[7]); return w; }
#define LDS_WAIT() asm volatile("s_waitcnt lgkmcnt(0)" ::: "memory")

using pg8::Unit; using pg8::HALF; using pg8::BM;
struct EpiZ {
    static constexpr bool PERM = true, AFTER_DRAIN = false;
    bf16_t* Z; const float* lbl;
    __device__ __forceinline__ void operator()(const f32x4 (&acc)[2][2][4][2], const Unit& u, int wr, int wc, int fr, int fq) const {
        const int row0 = u.pm * BM + wr * 64 + fr, col0 = u.pn * BM + wc * 32 + 8 * fq, type = u.pn >> 1;
        float lb[2][8];
        if (type == 1 || type == 2) {
#pragma unroll
            for (int bj = 0; bj < 2; ++bj)
#pragma unroll
                for (int e = 0; e < 8; ++e) { const int c = (col0 + bj * HALF + e) & 511; lb[bj][e] = __builtin_amdgcn_rcpf(1.0f + __expf(lbl[512 + c] - lbl[c])); }
        }
#pragma unroll
        for (int ai = 0; ai < 2; ++ai)
#pragma unroll
            for (int m = 0; m < 4; ++m) { bf16_t* rowp = Z + (size_t)(row0 + ai * HALF + m * 16) * NZ + col0;
#pragma unroll
                for (int bj = 0; bj < 2; ++bj) { float v[8];
#pragma unroll
                    for (int e = 0; e < 4; ++e) { v[e] = acc[ai][bj][m][0][e]; v[4 + e] = acc[ai][bj][m][1][e]; }
                    if (type == 1 || type == 2) {
#pragma unroll
                        for (int e = 0; e < 8; ++e) v[e] = __logf(lb[bj][e] + (1.0f - lb[bj][e]) * fsigmoid(v[e]));
                    } else if (type == 4 || type == 6) {
#pragma unroll
                        for (int e = 0; e < 8; ++e) v[e] = fsilu(v[e]);
                    }
                    *(u32x4*)(rowp + bj * HALF) = pack8(v); } }
    }
};
struct EpiGlu {
    static constexpr bool PERM = true, AFTER_DRAIN = false;
    const bf16_t* Y; const bf16_t* Z; const float* bglu; bf16_t* A2;
    __device__ __forceinline__ void operator()(const f32x4 (&acc)[2][2][4][2], const Unit& u, int wr, int wc, int fr, int fq) const {
        const int row0 = u.pm * BM + wr * 64 + fr, col0 = u.pn * BM + wc * 32 + 8 * fq;
        float bv[2][8];
#pragma unroll
        for (int bj = 0; bj < 2; ++bj)
#pragma unroll
            for (int e = 0; e < 8; ++e) bv[bj][e] = bglu[col0 + bj * HALF + e];
#pragma unroll
        for (int ai = 0; ai < 2; ++ai) {
            u32x4 yv[4][2], zv[4][2];
#pragma unroll
            for (int m = 0; m < 4; ++m) { const size_t row = (size_t)(row0 + ai * HALF + m * 16);
#pragma unroll
                for (int bj = 0; bj < 2; ++bj) { const int col = col0 + bj * HALF; yv[m][bj] = *(const u32x4*)(Y + row * 512 + col); zv[m][bj] = *(const u32x4*)(Z + row * NZ + ZGB + col); } }
            asm volatile("" ::: "memory");
#pragma unroll
            for (int m = 0; m < 4; ++m) { const size_t row = (size_t)(row0 + ai * HALF + m * 16);
#pragma unroll
                for (int bj = 0; bj < 2; ++bj) { const int col = col0 + bj * HALF; float y[8], sg[8], o[8];
                    unpack8(yv[m][bj], y); unpack8(zv[m][bj], sg);
#pragma unroll
                    for (int e = 0; e < 8; ++e) { const float a = (e < 4 ? acc[ai][bj][m][0][e] : acc[ai][bj][m][1][e - 4]) + bv[bj][e]; o[e] = y[e] * fsigmoid(a) * sg[e]; }
                    *(u32x4*)(A2 + row * 1024 + 512 + col) = pack8(o); } }
            asm volatile("" ::: "memory");
        }
    }
};
struct EpiRes3 {
    static constexpr bool PERM = true, AFTER_DRAIN = false;
    const float* xp; const float* xs; const float* mod0; const float* mod1; const float* ng1; bf16_t* Y1b; bf16_t* H; float* SSP; LAS unsigned char* escr;
    __device__ __forceinline__ void operator()(const f32x4 (&acc)[2][2][4][2], const Unit& u, int wr, int wc, int fr, int fq) const {
        const int rowt = u.pm * BM, row0 = rowt + wr * 64 + fr, col0 = u.pn * BM + wc * 32 + 8 * fq;
        const int n = rowt < MP ? 0 : 1 + ((rowt - MP) >> 12);
        const float* base = rowt < MP ? xp : xs - (size_t)MP * D;
        LAS f32x4* slot = (LAS f32x4*)(escr + ((wr * 4 + wc) * 4 + fq) * 128);
        if (fr == 0) {
#pragma unroll
            for (int bj = 0; bj < 2; ++bj)
#pragma unroll
                for (int nn = 0; nn < 2; ++nn) { const int c = col0 + bj * HALF + nn * 4; slot[(bj * 2 + nn) * 2] = *(const f32x4*)(mod0 + n * 3072 + 2048 + c);
                    slot[(bj * 2 + nn) * 2 + 1] = *(const f32x4*)(ng1 + c) * (*(const f32x4*)(mod1 + n * 3072 + 1024 + c) + 1.0f); }
        }
        LDS_WAIT();
#pragma unroll
        for (int ai = 0; ai < 2; ++ai)
#pragma unroll
            for (int mp = 0; mp < 2; ++mp) {
                f32x4 bv[2][2][2];
#pragma unroll
                for (int mm = 0; mm < 2; ++mm) { const size_t off = (size_t)(row0 + ai * HALF + (2 * mp + mm) * 16) * D + col0;
#pragma unroll
                    for (int bj = 0; bj < 2; ++bj)
#pragma unroll
                        for (int nn = 0; nn < 2; ++nn) bv[mm][bj][nn] = *(const f32x4*)(base + off + bj * HALF + nn * 4); }
                asm volatile("" ::: "memory");
#pragma unroll
                for (int mm = 0; mm < 2; ++mm) { const int m = 2 * mp + mm; const int row = row0 + ai * HALF + m * 16; const size_t off = (size_t)row * D + col0; float ss = 0.f;
#pragma unroll
                    for (int bj = 0; bj < 2; ++bj) { u32x4 wy, wh;
#pragma unroll
                        for (int nn = 0; nn < 2; ++nn) { const f32x4 gvv = slot[(bj * 2 + nn) * 2], gmm = slot[(bj * 2 + nn) * 2 + 1];
                            const f32x4 y = bv[mm][bj][nn] + gvv * acc[ai][bj][m][nn]; const f32x4 hh = y * gmm;
                            ss += (y[0] * y[0] + y[1] * y[1]) + (y[2] * y[2] + y[3] * y[3]);
                            wy[2 * nn] = pk2(y[0], y[1]); wy[2 * nn + 1] = pk2(y[2], y[3]); wh[2 * nn] = pk2(hh[0], hh[1]); wh[2 * nn + 1] = pk2(hh[2], hh[3]); }
                        *(u32x4*)(Y1b + off + bj * HALF) = wy; *(u32x4*)(H + off + bj * HALF) = wh; }
                    ss += __shfl_xor(ss, 16); ss += __shfl_xor(ss, 32);
                    if (fq == 0) SSP[((size_t)row * 4 + u.pn) * 4 + wc] = ss; }
                asm volatile("" ::: "memory");
            }
    }
};
struct EpiRes5 {
    static constexpr bool PERM = true, AFTER_DRAIN = false;
    const bf16_t* Y1b; const float* mod1; const float* gF; bf16_t* T; float* SSP;
    __device__ __forceinline__ void operator()(const f32x4 (&acc)[2][2][4][2], const Unit& u, int wr, int wc, int fr, int fq) const {
        const int rowt = u.pm * BM, row0 = rowt + wr * 64 + fr, col0 = u.pn * BM + wc * 32 + 8 * fq;
        const int n = rowt < MP ? 0 : 1 + ((rowt - MP) >> 12);
        f32x4 gv[2][2], gf[2][2];
#pragma unroll
        for (int bj = 0; bj < 2; ++bj)
#pragma unroll
            for (int nn = 0; nn < 2; ++nn) { const int c = col0 + bj * HALF + nn * 4; gv[bj][nn] = *(const f32x4*)(mod1 + n * 3072 + 2048 + c); gf[bj][nn] = *(const f32x4*)(gF + c); }
#pragma unroll
        for (int ai = 0; ai < 2; ++ai) {
            u32x4 bv[4][2];
#pragma unroll
            for (int m = 0; m < 4; ++m) { const size_t off = (size_t)(row0 + ai * HALF + m * 16) * D + col0;
#pragma unroll
                for (int bj = 0; bj < 2; ++bj) bv[m][bj] = *(const u32x4*)(Y1b + off + bj * HALF); }
            asm volatile("" ::: "memory");
#pragma unroll
            for (int m = 0; m < 4; ++m) { const int row = row0 + ai * HALF + m * 16; const size_t off = (size_t)row * D + col0; float ss = 0.f;
#pragma unroll
                for (int bj = 0; bj < 2; ++bj) { const u32x4 w = bv[m][bj]; u32x4 wt;
#pragma unroll
                    for (int nn = 0; nn < 2; ++nn) { const f32x4 b = (f32x4){bflo(w[2 * nn]), bfhi(w[2 * nn]), bflo(w[2 * nn + 1]), bfhi(w[2 * nn + 1])};
                        const f32x4 y = b + gv[bj][nn] * acc[ai][bj][m][nn], t = y * gf[bj][nn];
                        ss += (y[0] * y[0] + y[1] * y[1]) + (y[2] * y[2] + y[3] * y[3]);
                        wt[2 * nn] = pk2(t[0], t[1]); wt[2 * nn + 1] = pk2(t[2], t[3]); }
                    *(u32x4*)(T + off + bj * HALF) = wt; }
                ss += __shfl_xor(ss, 16); ss += __shfl_xor(ss, 32);
                if (fq == 0) SSP[((size_t)row * 4 + u.pn) * 4 + wc] = ss; }
            asm volatile("" ::: "memory");
        }
    }
};
struct EpiOdd {
    static constexpr bool PERM = false, AFTER_DRAIN = false;
    bf16_t* PB; bf16_t* GB; const float* RSTD; const float* SW; bf16_t* A3; const float* cw; const float* cb;
    __device__ __forceinline__ void operator()(const f32x4 (&acc)[2][2][4][2], const Unit& u, int wr, int wc, int fr, int fq) const {
        const int rowt = u.pm * BM, row0 = rowt + wr * 64 + fr, ch0 = u.pn * 64 + 16 * wc + 4 * fq;
        const int n = rowt < MP ? 0 : 1 + ((rowt - MP) >> 12);
        f32x4 sw[4]; float rs[2][4];
#pragma unroll
        for (int blk = 0; blk < 4; ++blk) sw[blk] = *(const f32x4*)(SW + n * 4096 + blk * 1024 + ch0);
#pragma unroll
        for (int ai = 0; ai < 2; ++ai)
#pragma unroll
            for (int m = 0; m < 4; ++m) rs[ai][m] = RSTD[row0 + ai * HALF + m * 16];
        if (rowt >= MP) {
            const f32x4 w0 = *(const f32x4*)(cw + ch0), w1 = *(const f32x4*)(cw + 1024 + ch0), w2 = *(const f32x4*)(cw + 2048 + ch0), bb = *(const f32x4*)(cb + ch0);
#pragma unroll
            for (int ai = 0; ai < 2; ++ai) { f32x4 p[4], gm[4];
#pragma unroll
                for (int m = 0; m < 4; ++m) { const float r = rs[ai][m];
                    const f32x4 bg = acc[ai][0][m][0] * r + sw[0], cgv = acc[ai][0][m][1] * r + sw[1], vv = acc[ai][1][m][0] * r + sw[2], gg = acc[ai][1][m][1] * r + sw[3];
                    p[m] = cgv * vv;
#pragma unroll
                    for (int e = 0; e < 4; ++e) gm[m][e] = bg[e] * fsilu(gg[e]); }
#pragma unroll
                for (int m = 0; m < 4; ++m) { f32x4 pv, nx;
#pragma unroll
                    for (int e = 0; e < 4; ++e) {
                        const float us = __shfl_up(p[m][e], 1, 16), uc = m > 0 ? __shfl(p[m > 0 ? m - 1 : 0][e], 15, 16) : 0.f;
                        const float ds = __shfl_down(p[m][e], 1, 16), dc = m < 3 ? __shfl(p[m < 3 ? m + 1 : 3][e], 0, 16) : 0.f;
                        pv[e] = fr > 0 ? us : uc; nx[e] = fr < 15 ? ds : dc; }
                    const f32x4 y = gm[m] * (w0 * pv + w1 * p[m] + w2 * nx + bb);
                    u32x2 wy; wy.x = pk2(y[0], y[1]); wy.y = pk2(y[2], y[3]);
                    *(u32x2*)(A3 + (size_t)(row0 + ai * HALF + m * 16) * D + ch0) = wy; }
            }
        } else {
#pragma unroll
        for (int ai = 0; ai < 2; ++ai)
#pragma unroll
            for (int m = 0; m < 4; ++m) { const size_t off = (size_t)(row0 + ai * HALF + m * 16) * D + ch0; const float r = rs[ai][m];
                const f32x4 bg = acc[ai][0][m][0] * r + sw[0], cgv = acc[ai][0][m][1] * r + sw[1], vv = acc[ai][1][m][0] * r + sw[2], gg = acc[ai][1][m][1] * r + sw[3];
                const f32x4 p = cgv * vv; f32x4 g;
#pragma unroll
                for (int e = 0; e < 4; ++e) g[e] = bg[e] * fsilu(gg[e]);
                u32x2 wp, wg; wp.x = pk2(p[0], p[1]); wp.y = pk2(p[2], p[3]); wg.x = pk2(g[0], g[1]); wg.y = pk2(g[2], g[3]);
                *(u32x2*)(PB + off) = wp; *(u32x2*)(GB + off) = wg; }
        }
    }
};

__device__ __forceinline__ void s5_build_tables(const Params& P, int dg);
template <int MODE>
__device__ __forceinline__ void transpose_item(const float* W, int K, int N, bf16_t* WT, LAS float* scr, int item, int lane) {
    const int nblk = N / 32, kb = item / nblk, nb = item % nblk, k0 = 64 * kb, n0 = 32 * nb;
#pragma unroll 8
    for (int i = 0; i < 32; ++i) { const int kk = 2 * i + (lane >> 5); scr[kk * 33 + (lane & 31)] = W[(size_t)(k0 + kk) * N + n0 + (lane & 31)]; }
    LDS_WAIT();
    const int c = lane & 7;
#pragma unroll
    for (int j = 0; j < 4; ++j) { const int n = (lane >> 3) + 8 * j; const LAS float* s = scr + (8 * c) * 33 + n;
        u32x4 o; o.x = pk2(s[0 * 33], s[1 * 33]); o.y = pk2(s[2 * 33], s[3 * 33]); o.z = pk2(s[4 * 33], s[5 * 33]); o.w = pk2(s[6 * 33], s[7 * 33]);
        int dn = n0 + n;
        if (MODE == 1) { const int blk = dn >> 10, rem = dn & 1023, tile = rem >> 6, ch = rem & 63; dn = tile * 256 + 128 * (blk >> 1) + 32 * (ch >> 4) + 16 * (blk & 1) + (ch & 15); }
        *(u32x4*)(WT + (size_t)dn * K + k0 + 8 * c) = o; }
    LDS_WAIT();
}
__device__ __forceinline__ void gemv9_item(LAS unsigned char* lds, const float* W, int ldw, int jb, const float* bias, float* out, int ldo) {
    const int tid = threadIdx.x, lane = tid & 63, wave = tid >> 6;
    const LAS float* sc = (const LAS float*)lds; LAS float* red = (LAS float*)(lds + 36864);
    const float* Wc = W + jb * 64 + lane;
    float acc[9];
#pragma unroll
    for (int n = 0; n < 9; ++n) acc[n] = 0.f;
    for (int kk = 0; kk < 128; kk += 16) { const int k0 = wave * 128 + kk;
        float wv[16];
#pragma unroll
        for (int q = 0; q < 16; ++q) wv[q] = Wc[(size_t)(k0 + q) * ldw];
#pragma unroll
        for (int q = 0; q < 16; q += 4)
#pragma unroll
            for (int n = 0; n < 9; ++n) { const f32x4 sv = *(const LAS f32x4*)(sc + n * 1024 + k0 + q); acc[n] += sv[0] * wv[q] + sv[1] * wv[q + 1] + sv[2] * wv[q + 2] + sv[3] * wv[q + 3]; } }
#pragma unroll
    for (int n = 0; n < 9; ++n) red[(wave * 9 + n) * 64 + lane] = acc[n];
    __syncthreads();
    for (int i = tid; i < 576; i += 512) { const int n = i >> 6, jj = i & 63; float sum = 0.f;
#pragma unroll
        for (int w = 0; w < 8; ++w) sum += red[(w * 9 + n) * 64 + jj];
        out[n * ldo + jb * 64 + jj] = sum + (bias ? bias[jb * 64 + jj] : 0.f); }
    __syncthreads();
}
__device__ __forceinline__ void phase0(const Params& P, LAS unsigned char* lds) {
    const int tid = threadIdx.x, lane = tid & 63, wave = tid >> 6;
    float* MOD = (float*)(P.ws + WS_MOD);
    if (blockIdx.x < 96) {
        LAS float* sc = (LAS float*)lds;
        for (int i = tid; i < 9 * 1024; i += 512) { const int n = i >> 10, k = i & 1023; const float c = n == 0 ? P.in[I_CCTX][k] : P.in[I_C][(n - 1) * 1024 + k]; sc[i] = fsilu(c); }
        __syncthreads();
        for (int item = blockIdx.x; item < 96; item += gridDim.x) { const int l = item / 48, jb = item % 48;
            gemv9_item(lds, P.in[I_WMOD] + (size_t)l * 1024 * 3072, 3072, jb, P.in[I_BMOD] + l * 3072, MOD + l * 9 * 3072, 3072); }
    }
    __syncthreads();
    LAS float* scr = (LAS float*)(lds + wave * 8448);
    const int tw0 = gridDim.x >= 192 ? 96 : 0;
    if ((int)blockIdx.x < tw0) return;
    const int gw = (blockIdx.x - tw0) * 8 + wave, NGW = (gridDim.x - tw0) * 8;
    constexpr int I1 = 16 * 112, I2 = 16 * 32, I3 = 8 * 16, I4 = 16 * 128, I5 = 16 * 32;
    for (int it = gw; it < 64 + I1 + I2 + I3 + I4 + I5; it += NGW) {
        int r = it;
        if (r < 64) { s5_build_tables(P, r); continue; } r -= 64;
        if (r < I1) { transpose_item<0>(P.in[I_WINE], 1024, 3584, (bf16_t*)(P.ws + WS_WIN_E), scr, r, lane); continue; } r -= I1;
        if (r < I2) { transpose_item<0>(P.in[I_WOUTE], 1024, 1024, (bf16_t*)(P.ws + WS_WOUT_E), scr, r, lane); continue; } r -= I2;
        if (r < I3) { transpose_item<0>(P.in[I_WGLU], 512, 512, (bf16_t*)(P.ws + WS_WGLU), scr, r, lane); continue; } r -= I3;
        if (r < I4) { transpose_item<1>(P.in[I_WINO], 1024, 4096, (bf16_t*)(P.ws + WS_WIN_O), scr, r, lane); continue; } r -= I4;
        transpose_item<0>(P.in[I_WOUTO], 1024, 1024, (bf16_t*)(P.ws + WS_WOUT_O), scr, r, lane);
    }
}

__device__ __forceinline__ void phase_norm(const float* xp, const float* xs, const float* ng, const float* mod, bf16_t* H) {
    const int lane = threadIdx.x & 63, gw = blockIdx.x * 8 + (threadIdx.x >> 6), NGW = gridDim.x * 8;
    for (int m = gw; m < M; m += NGW) {
        const float* xr = m < MP ? xp + (size_t)m * D : xs + (size_t)(m - MP) * D; const int n = m < MP ? 0 : 1 + ((m - MP) >> 12);
        f32x4 v[4]; float ss = 0.f;
#pragma unroll
        for (int j = 0; j < 4; ++j) { v[j] = __builtin_nontemporal_load((const f32x4*)(xr + 4 * lane + 256 * j)); ss += (v[j][0] * v[j][0] + v[j][1] * v[j][1]) + (v[j][2] * v[j][2] + v[j][3] * v[j][3]); }
        const float rstd = rsqrtf(wave_sum(ss) * (1.0f / D) + EPS);
#pragma unroll
        for (int j = 0; j < 4; ++j) { const int col = 4 * lane + 256 * j;
            const f32x4 g = *(const f32x4*)(ng + col), sh = *(const f32x4*)(mod + n * 3072 + col), sc = *(const f32x4*)(mod + n * 3072 + 1024 + col);
            const f32x4 y = v[j] * rstd * g * (sc + 1.0f) + sh;
            u32x2 w; w.x = pk2(y[0], y[1]); w.y = pk2(y[2], y[3]); *(u32x2*)(H + (size_t)m * D + col) = w; }
    }
}
__device__ __forceinline__ void phase_final_norm(float* out, const bf16_t* T, const float* SSP) {
    const int lane = threadIdx.x & 63, gw = blockIdx.x * 8 + (threadIdx.x >> 6), NGW = gridDim.x * 8;
    for (int m = gw; m < M; m += NGW) {
        const u32x4 t0 = __builtin_nontemporal_load((const u32x4*)(T + (size_t)m * D + 8 * lane)), t1 = __builtin_nontemporal_load((const u32x4*)(T + (size_t)m * D + 512 + 8 * lane));
        const float rstd = rsqrtf(wave_sum(lane < 16 ? SSP[(size_t)m * 16 + lane] : 0.f) * (1.0f / D) + EPS);
        float a[8], b[8]; unpack8(t0, a); unpack8(t1, b);
        float* o = out + (size_t)m * D + 8 * lane;
        __builtin_nontemporal_store((f32x4){a[0], a[1], a[2], a[3]} * rstd, (f32x4*)o); __builtin_nontemporal_store((f32x4){a[4], a[5], a[6], a[7]} * rstd, (f32x4*)(o + 4));
        __builtin_nontemporal_store((f32x4){b[0], b[1], b[2], b[3]} * rstd, (f32x4*)(o + 512)); __builtin_nontemporal_store((f32x4){b[4], b[5], b[6], b[7]} * rstd, (f32x4*)(o + 516));
    }
}

constexpr int HG_QP = 272, HG_SP = 144;
constexpr int HG_Q = 0, HG_K = 17408, HG_KT = 34816, HG_VT = 53248, HG_P = 71680, HG_ST = 80896, HG_TAB = 115712;
__device__ __forceinline__ int seg_rowbase(int sg) { return sg < 32 ? sg * 256 : MP + (sg - 32) * 256; }
#define MFMA16(a, b, c) __builtin_amdgcn_mfma_f32_16x16x32_bf16((a), (b), (c), 0, 0, 0)
#define MFMA32(a, b, c) __builtin_amdgcn_mfma_f32_32x32x16_bf16((a), (b), (c), 0, 0, 0)

template <bool PASS2>
__device__ __forceinline__ void hgrn_task(const Params& P, LAS unsigned char* lds, int task) {
    const int tid = threadIdx.x, lane = tid & 63, w = __builtin_amdgcn_readfirstlane(tid >> 6), col = lane & 15, quad = lane >> 4;
    const int ch = tid & 127, qt = tid >> 7;
    const int d = task & 1, h = (task >> 1) & 3, sg = PASS2 ? (task >> 3) : 32 + (task >> 3);
    const int rowbase = seg_rowbase(sg), slot = ((sg - 32) << 3) | (h << 1) | d;
    const bf16_t* Z = (const bf16_t*)(P.ws + WS_Z);
    float* SLOC = (float*)(P.ws + WS_A2); float* BSEG = (float*)(P.ws + WS_BSEG);
    bf16_t* OB = (bf16_t*)(P.ws + WS_H) + (size_t)d * M * 512;
    LAS float* qtot = (LAS float*)(lds + HG_TAB); LAS float* ebm = qtot + 512; LAS float* e2t = qtot + 640;
    f32x4 S[8];
#pragma unroll
    for (int vt = 0; vt < 8; ++vt) {
        if (PASS2 && sg >= 32) {
#pragma unroll
            for (int j = 0; j < 4; ++j) S[vt][j] = SLOC[(size_t)slot * 16384 + (16 * w + 4 * quad + j) * 128 + 16 * vt + col];
        } else S[vt] = (f32x4){0.f, 0.f, 0.f, 0.f};
    }
    float bsum = 0.f;
    unsigned nlf[16], nv[16], nq[16];
    const char* Zlf = (const char*)(Z + ZF + 512 * d + 128 * h); const char* Zvv = (const char*)(Z + ZV + 128 * h); const char* Zqq = (const char*)(Z + ZQ + 128 * h);
    const int bstep = d ? -(NZ * 2) : NZ * 2;
    const unsigned boff0 = ((unsigned)(rowbase + (d ? 255 - 16 * qt : 16 * qt)) * (unsigned)NZ + (unsigned)ch) * 2u;
#define HG_LOAD(cc) do { unsigned bo = boff0 + (unsigned)(64 * (cc) * bstep); _Pragma("unroll") for (int e = 0; e < 16; ++e) { \
            nlf[e] = *(const bf16_t*)(Zlf + bo); nv[e] = *(const bf16_t*)(Zvv + bo); if (PASS2) nq[e] = *(const bf16_t*)(Zqq + bo); bo += (unsigned)bstep; } } while (0)
    HG_LOAD(0);
    if (w >= 4) __builtin_amdgcn_s_setprio(1);
    for (int c = 0; c < 4; ++c) {
        float lf[16], cs[16], qq[16]; unsigned vraw[16];
#pragma unroll
        for (int e = 0; e < 16; ++e) { lf[e] = bf2f(nlf[e]); vraw[e] = nv[e]; if (PASS2) qq[e] = bf2f(nq[e]); }
        { float run = 0.f;
#pragma unroll
          for (int e = 0; e < 16; ++e) { run += lf[e]; cs[e] = run; } }
        qtot[qt * 128 + ch] = cs[15];
        __syncthreads();
        const float t0 = qtot[ch], t1 = qtot[128 + ch], t2 = qtot[256 + ch], t3 = qtot[384 + ch];
        const float off = qt == 0 ? 0.f : (qt == 1 ? t0 : (qt == 2 ? t0 + t1 : t0 + t1 + t2));
        const float bmid = t0 + t1, blast = (t0 + t1) + (t2 + t3);
        unsigned ktp[8], vtp[8];
#pragma unroll
        for (int e = 0; e < 16; e += 2) {
            float kt[2];
#pragma unroll
            for (int z = 0; z < 2; ++z) { const float b = off + cs[e + z]; const float kk = 1.0f - __expf(lf[e + z]); kt[z] = kk * __expf(fminf(bmid - b, 80.f));
                if (PASS2) { const int i = 16 * qt + e + z; const float qv = qq[e + z] * __expf(b - bmid);
                    *(LAS bf16_t*)(lds + HG_Q + i * HG_QP + ch * 2) = (bf16_t)(pk2(qv, 0.f) & 0xffffu);
                    *(LAS bf16_t*)(lds + HG_K + i * HG_QP + ch * 2) = (bf16_t)(pk2(kt[z], 0.f) & 0xffffu); } }
            ktp[e >> 1] = pk2(kt[0], kt[1]); vtp[e >> 1] = vraw[e] | (vraw[e + 1] << 16);
        }
        *(LAS u32x4*)(lds + HG_KT + ch * HG_SP + qt * 32) = (u32x4){ktp[0], ktp[1], ktp[2], ktp[3]};
        *(LAS u32x4*)(lds + HG_KT + ch * HG_SP + qt * 32 + 16) = (u32x4){ktp[4], ktp[5], ktp[6], ktp[7]};
        *(LAS u32x4*)(lds + HG_VT + ch * HG_SP + qt * 32) = (u32x4){vtp[0], vtp[1], vtp[2], vtp[3]};
        *(LAS u32x4*)(lds + HG_VT + ch * HG_SP + qt * 32 + 16) = (u32x4){vtp[4], vtp[5], vtp[6], vtp[7]};
        if (qt == 0) { ebm[ch] = __expf(bmid); e2t[ch] = __expf(blast - bmid); bsum += blast; }
        __syncthreads();
        if (c < 3) HG_LOAD(c + 1);
        const f32x4 eb = *(const LAS f32x4*)(ebm + 16 * w + 4 * quad), e2v = *(const LAS f32x4*)(e2t + 16 * w + 4 * quad);
#pragma unroll
        for (int vt = 0; vt < 8; ++vt) { S[vt] = S[vt] * eb;
            if (PASS2) { u32x2 sw; sw.x = pk2(S[vt][0], S[vt][1]); sw.y = pk2(S[vt][2], S[vt][3]);
                *(LAS u32x2*)(lds + HG_ST + (16 * vt + col) * HG_QP + (16 * w + 4 * quad) * 2) = sw; } }
        if (PASS2) {
#pragma unroll
            for (int ti = 0; ti < 2; ++ti) { const int id = 2 * w + ti, st = id >> 2, tt = id & 3;
                f32x4 ap = (f32x4){0.f, 0.f, 0.f, 0.f};
                if (st <= tt) {
#pragma unroll
                    for (int ks = 0; ks < 4; ++ks) { const bf16x8 a = *(const LAS bf16x8*)(lds + HG_K + (16 * st + col) * HG_QP + ks * 64 + quad * 16);
                        const bf16x8 b = *(const LAS bf16x8*)(lds + HG_Q + (16 * tt + col) * HG_QP + ks * 64 + quad * 16); ap = MFMA16(a, b, ap); }
                    const int tpos = 16 * tt + col, s0 = 16 * st + 4 * quad;
#pragma unroll
                    for (int j = 0; j < 4; ++j) ap[j] = (s0 + j <= tpos) ? ap[j] : 0.f;
                }
                u32x2 pw; pw.x = pk2(ap[0], ap[1]); pw.y = pk2(ap[2], ap[3]);
                *(LAS u32x2*)(lds + HG_P + (16 * tt + col) * HG_SP + (16 * st + 4 * quad) * 2) = pw; }
        }
        __syncthreads();
        if (PASS2) { const int tt = w >> 1;
#pragma unroll
            for (int vi = 0; vi < 4; ++vi) { const int vt = 4 * (w & 1) + vi; f32x4 ao = (f32x4){0.f, 0.f, 0.f, 0.f};
#pragma unroll
                for (int ks = 0; ks < 2; ++ks) { const bf16x8 a = *(const LAS bf16x8*)(lds + HG_VT + (16 * vt + col) * HG_SP + ks * 64 + quad * 16);
                    const bf16x8 b = *(const LAS bf16x8*)(lds + HG_P + (16 * tt + col) * HG_SP + ks * 64 + quad * 16); ao = MFMA16(a, b, ao); }
#pragma unroll
                for (int ks = 0; ks < 4; ++ks) { const bf16x8 a = *(const LAS bf16x8*)(lds + HG_ST + (16 * vt + col) * HG_QP + ks * 64 + quad * 16);
                    const bf16x8 b = *(const LAS bf16x8*)(lds + HG_Q + (16 * tt + col) * HG_QP + ks * 64 + quad * 16); ao = MFMA16(a, b, ao); }
                const int pos = 64 * c + 16 * tt + col; const int row = rowbase + (d ? 255 - pos : pos);
                u32x2 ow; ow.x = pk2(ao[0], ao[1]); ow.y = pk2(ao[2], ao[3]);
                *(u32x2*)(OB + (size_t)row * 512 + 128 * h + 16 * vt + 4 * quad) = ow; }
        }
#pragma unroll
        for (int vt = 0; vt < 8; ++vt) {
#pragma unroll
            for (int ks = 0; ks < 2; ++ks) { const bf16x8 a = *(const LAS bf16x8*)(lds + HG_KT + (16 * w + col) * HG_SP + ks * 64 + quad * 16);
                const bf16x8 b = *(const LAS bf16x8*)(lds + HG_VT + (16 * vt + col) * HG_SP + ks * 64 + quad * 16); S[vt] = MFMA16(a, b, S[vt]); }
            S[vt] = S[vt] * e2v; }
    }
#undef HG_LOAD
    __builtin_amdgcn_s_setprio(0);
    if (!PASS2) {
#pragma unroll
        for (int vt = 0; vt < 8; ++vt)
#pragma unroll
            for (int j = 0; j < 4; ++j) SLOC[(size_t)slot * 16384 + (16 * w + 4 * quad + j) * 128 + 16 * vt + col] = S[vt][j];
        if (qt == 0) BSEG[slot * 128 + ch] = bsum;
    } else if (sg < 32) {
        float* o = P.out + OUT_SH + (size_t)((sg * 2 + d) * 4 + h) * 16384;
#pragma unroll
        for (int vt = 0; vt < 8; ++vt)
#pragma unroll
            for (int j = 0; j < 4; ++j) o[(16 * w + 4 * quad + j) * 128 + 16 * vt + col] = S[vt][j];
    }
    __syncthreads();
}
__device__ __forceinline__ void hgrn_pass1_task(const Params& P, LAS unsigned char* lds, int task) {
    const int tid = threadIdx.x, lane = tid & 63, w = __builtin_amdgcn_readfirstlane(tid >> 6), col = lane & 15, quad = lane >> 4;
    const int ch = tid & 127, qt = tid >> 7;
    const int d = task & 1, h = (task >> 1) & 3, sg = 32 + (task >> 3), rowbase = seg_rowbase(sg), slot = task;
    const bf16_t* Z = (const bf16_t*)(P.ws + WS_Z);
    float* SLOC = (float*)(P.ws + WS_A2); float* BSEG = (float*)(P.ws + WS_BSEG);
    LAS float* qtot = (LAS float*)(lds + 131072 + 64);
    unsigned lfp[32], vp[32]; float tot = 0.f;
    const long zstep = d ? -(long)NZ : (long)NZ;
    const bf16_t* zl = Z + (size_t)(rowbase + (d ? 255 - 64 * qt : 64 * qt)) * NZ + 128 * h + ch + ZF + 512 * d; const bf16_t* zv = zl + (ZV - ZF - 512 * d);
#pragma unroll
    for (int e2 = 0; e2 < 32; ++e2) {
        const unsigned l0 = zl[0], v0 = zv[0]; zl += zstep; zv += zstep;
        const unsigned l1 = zl[0], v1 = zv[0]; zl += zstep; zv += zstep;
        if ((e2 & 3) == 3) asm volatile("" : "+v"(zl), "+v"(zv));
        lfp[e2] = l0 | (l1 << 16); vp[e2] = v0 | (v1 << 16); tot += bflo(lfp[e2]) + bfhi(lfp[e2]); }
    qtot[qt * 128 + ch] = tot;
    __syncthreads();
    const float t0 = qtot[ch], t1 = qtot[128 + ch], t2 = qtot[256 + ch], t3 = qtot[384 + ch];
    float run = qt == 3 ? 0.f : (qt == 2 ? t3 : (qt == 1 ? t2 + t3 : t1 + t2 + t3));
#pragma unroll
    for (int e2 = 31; e2 >= 0; --e2) { const float l1 = bfhi(lfp[e2]), l0 = bflo(lfp[e2]);
        const float k1 = (1.0f - __expf(l1)) * __expf(run); run += l1;
        const float k0 = (1.0f - __expf(l0)) * __expf(run); run += l0;
        lfp[e2] = pk2(k0, k1); }
#pragma unroll
    for (int c8 = 0; c8 < 8; ++c8) { const int cx = ((8 * qt + c8) ^ (ch & 31)) << 4;
        *(LAS u32x4*)(lds + ch * 512 + cx) = (u32x4){lfp[4 * c8], lfp[4 * c8 + 1], lfp[4 * c8 + 2], lfp[4 * c8 + 3]};
        *(LAS u32x4*)(lds + 65536 + ch * 512 + cx) = (u32x4){vp[4 * c8], vp[4 * c8 + 1], vp[4 * c8 + 2], vp[4 * c8 + 3]}; }
    __syncthreads();
    f32x4 S[8];
#pragma unroll
    for (int vt = 0; vt < 8; ++vt) S[vt] = (f32x4){0.f, 0.f, 0.f, 0.f};
    const int ar = 16 * w + col;
#pragma unroll
    for (int ks = 0; ks < 8; ++ks) { const bf16x8 a = *(const LAS bf16x8*)(lds + ar * 512 + (((4 * ks + quad) ^ (ar & 31)) << 4));
#pragma unroll
        for (int vt = 0; vt < 8; ++vt) { const int br = 16 * vt + col; const bf16x8 b = *(const LAS bf16x8*)(lds + 65536 + br * 512 + (((4 * ks + quad) ^ (br & 31)) << 4)); S[vt] = MFMA16(a, b, S[vt]); } }
#pragma unroll
    for (int vt = 0; vt < 8; ++vt)
#pragma unroll
        for (int j = 0; j < 4; ++j) SLOC[(size_t)slot * 16384 + (16 * w + 4 * quad + j) * 128 + 16 * vt + col] = S[vt][j];
    if (qt == 0) BSEG[slot * 128 + ch] = (t0 + t1) + (t2 + t3);
    __syncthreads();
}
__device__ __forceinline__ void sw_items(const Params& P, LAS unsigned char* lds, int wg0) {
    const int b = (int)blockIdx.x - wg0;
    if (b >= 0 && b < 64) { LAS float* sc = (LAS float*)lds; const float* mod1 = (const float*)(P.ws + WS_MOD) + 9 * 3072;
        for (int i = threadIdx.x; i < 9 * 1024; i += 512) sc[i] = mod1[(i >> 10) * 3072 + (i & 1023)];
        __syncthreads();
        for (int item = b; item < 64; item += (int)gridDim.x - wg0) gemv9_item(lds, P.in[I_WINO], 4096, item, nullptr, (float*)(P.ws + WS_SW), 4096);
    }
}
__device__ __forceinline__ void phase_rstd(const Params& P) {
    const float* SSP = (const float*)(P.ws + WS_SSP); float* RSTD = (float*)(P.ws + WS_RSTD);
    for (int row = blockIdx.x * 512 + threadIdx.x; row < M; row += gridDim.x * 512) { const f32x4* p = (const f32x4*)(SSP + (size_t)row * 16);
        const f32x4 a = p[0], b = p[1], c = p[2], d = p[3];
        const float ss = ((a[0] + a[1]) + (a[2] + a[3])) + ((b[0] + b[1]) + (b[2] + b[3])) + ((c[0] + c[1]) + (c[2] + c[3])) + ((d[0] + d[1]) + (d[2] + d[3]));
        RSTD[row] = rsqrtf(ss * (1.0f / D) + EPS); }
}
__device__ __forceinline__ void hgrn_carry(const Params& P) {
    float* SLOC = (float*)(P.ws + WS_A2); const float* BSEG = (const float*)(P.ws + WS_BSEG);
    const int gt = blockIdx.x * 512 + threadIdx.x, NT = gridDim.x * 512;
    for (int idx = gt; idx < 64 * 16384; idx += NT) { const int chain = idx >> 14, e = idx & 16383, b = chain >> 3, h = (chain >> 1) & 3, d = chain & 1, k = e >> 7;
        float run = P.in[I_SH][(size_t)((b * 2 + d) * 4 + h) * 16384 + e];
        for (int jj = 0; jj < 16; ++jj) { const int ks = d ? 15 - jj : jj; const int slot = ((b * 16 + ks) << 3) | (h << 1) | d;
            const float tmp = SLOC[(size_t)slot * 16384 + e]; SLOC[(size_t)slot * 16384 + e] = run; run = __expf(BSEG[slot * 128 + k]) * run + tmp; } }
}

__device__ __forceinline__ void s5_build_tables(const Params& P, int dg) {
    const int lane = threadIdx.x & 63, n = lane & 31, hh = lane >> 5;
    unsigned char* tab = P.ws + WS_S5T + (size_t)dg * S5T_STRIDE;
    const float dt = __expf(P.in[I_LDT][dg]);
    float lr[2], li[2], cre[2], cim[2];
#pragma unroll
    for (int pp = 0; pp < 2; ++pp) { const int p = 32 * pp + n; const float lre = P.in[I_LRE][dg * 64 + p], lim = P.in[I_LIM][dg * 64 + p];
        const float mag = expf(lre * dt); float sn, cs; sincosf(lim * dt, &sn, &cs); lr[pp] = mag * cs; li[pp] = mag * sn;
        const float den = lre * lre + lim * lim; cre[pp] = ((lr[pp] - 1.0f) * lre + li[pp] * lim) / den; cim[pp] = (li[pp] * lre - (lr[pp] - 1.0f) * lim) / den;
        float ar = lr[pp], ai = li[pp];
#pragma unroll
        for (int q = 0; q < 8; ++q) { const float nr = ar * ar - ai * ai, ni = 2.0f * ar * ai; ar = nr; ai = ni; }
        if (hh == 0) { float* lam = (float*)(tab + 12288); lam[p] = lr[pp]; lam[64 + p] = li[pp]; lam[128 + p] = ar; lam[192 + p] = ai; } }
#pragma unroll
    for (int jt = 0; jt < 4; ++jt) { const int pp = jt & 1, part = jt >> 1, p = 32 * pp + n; float v[8];
        const float* br = P.in[I_BRE] + (size_t)(dg * 64 + p) * 16 + 8 * hh; const float* bi = P.in[I_BIM] + (size_t)(dg * 64 + p) * 16 + 8 * hh;
#pragma unroll
        for (int j = 0; j < 8; ++j) v[j] = part ? (cre[pp] * bi[j] + cim[pp] * br[j]) : (cre[pp] * br[j] - cim[pp] * bi[j]);
        *(u32x4*)(tab + jt * 1024 + lane * 16) = pack8(v); }
#pragma unroll
    for (int jt = 0; jt < 4; ++jt)
#pragma unroll
        for (int sx = 0; sx < 2; ++sx) { const int part = jt >> 1, p0 = 32 * (jt & 1) + 16 * sx + 8 * hh; float v[8];
            const float* cp = (part ? P.in[I_CIM] : P.in[I_CRE]) + (size_t)(dg * 16 + (n & 15)) * 64 + p0;
#pragma unroll
            for (int j = 0; j < 8; ++j) { const float c = cp[j]; v[j] = n < 16 ? (part ? -c : c) : 0.f; }
            *(u32x4*)(tab + 4096 + (jt * 2 + sx) * 1024 + lane * 16) = pack8(v); }
}
template <bool PASS2>
__device__ __forceinline__ void s5_task(const Params& P, LAS unsigned char* img, int task) {
    const int lane = threadIdx.x & 63, n = lane & 31, hh = lane >> 5;
    const int d = task & 1, g = (task >> 1) & 31, pr = task >> 6;
    const int segA = PASS2 ? 2 * pr : 32 + 2 * pr, myseg = segA + hh;
    const bf16_t* Z = (const bf16_t*)(P.ws + WS_Z);
    float* XLOC = (float*)(P.ws + WS_XLOC);
    const int dg = d * 32 + g;
    const unsigned char* tab = P.ws + WS_S5T + (size_t)dg * S5T_STRIDE; const float* lam = (const float*)(tab + 12288);
    float lr[2], li[2], xr[2], xi[2]; bf16x8 Bf[4], Cf[4][2];
#pragma unroll
    for (int pp = 0; pp < 2; ++pp) { lr[pp] = lam[32 * pp + n]; li[pp] = lam[64 + 32 * pp + n]; }
#pragma unroll
    for (int jt = 0; jt < 4; ++jt) Bf[jt] = *(const bf16x8*)(tab + jt * 1024 + lane * 16);
    if (PASS2) {
#pragma unroll
        for (int jt = 0; jt < 4; ++jt)
#pragma unroll
            for (int sx = 0; sx < 2; ++sx) Cf[jt][sx] = *(const bf16x8*)(tab + 4096 + (jt * 2 + sx) * 1024 + lane * 16);
    }
#pragma unroll
    for (int pp = 0; pp < 2; ++pp) { xr[pp] = 0.f; xi[pp] = 0.f; }
    if (PASS2 && myseg >= 32) { const int sb = (myseg - 32) >> 4, sk = (myseg - 32) & 15;
#pragma unroll
        for (int pp = 0; pp < 2; ++pp) { const int p = 32 * pp + n;
            const float ar = lam[128 + p], ai = lam[192 + p];
            float sr = P.in[I_SRE][(size_t)((sb * 2 + d) * 32 + g) * 64 + p], si = P.in[I_SIM][(size_t)((sb * 2 + d) * 32 + g) * 64 + p];
            const int cnt = d ? 15 - sk : sk;
            for (int jj = 0; jj < cnt; ++jj) { const int ks = d ? 15 - jj : jj; const float* xl = XLOC + (size_t)(((sb * 16 + ks) * 32 + g) * 2 + d) * 128;
                const float nr = ar * sr - ai * si + xl[p], ni = ar * si + ai * sr + xl[64 + p]; sr = nr; si = ni; }
            xr[pp] = sr; xi[pp] = si; }
    }
    const int arow_seg = segA + ((n >> 2) & 1), arow_pos = (n & 3) + 4 * (n >> 3);
    const int abase = seg_rowbase(arow_seg), mybase = seg_rowbase(myseg);
    bf16_t* YD = (bf16_t*)P.out + (size_t)d * M * 512;
    const unsigned ibase = (unsigned)(uintptr_t)img;
    const int i16 = lane & 15, q4 = i16 >> 2, p4 = i16 & 3, blk = (lane >> 4) & 1;
    const bf16_t* zu = Z + ZU + g * 16 + 8 * hh;
    bf16x8 aq[4];
#pragma unroll
    for (int u = 0; u < 4; ++u) { const int apos = 16 * u + arow_pos; aq[u] = *(const bf16x8*)(zu + (size_t)(abase + (d ? 255 - apos : apos)) * NZ); }
#pragma nounroll
    for (int tl = 0; tl < 16; ++tl) {
        const bf16x8 a = aq[0];
        aq[0] = aq[1]; aq[1] = aq[2]; aq[2] = aq[3];
        { const int apos = 16 * (tl < 12 ? tl + 4 : 15) + arow_pos; aq[3] = *(const bf16x8*)(zu + (size_t)(abase + (d ? 255 - apos : apos)) * NZ); }
        f32x16 bu[4];
#pragma unroll
        for (int jt = 0; jt < 4; ++jt) { f32x16 z;
#pragma unroll
            for (int i = 0; i < 16; ++i) z[i] = 0.f;
            bu[jt] = MFMA32(a, Bf[jt], z); }
        asm volatile("s_nop 15" : "+v"(bu[0]), "+v"(bu[1]), "+v"(bu[2]), "+v"(bu[3]));
#pragma unroll
        for (int i = 0; i < 16; ++i)
#pragma unroll
            for (int pp = 0; pp < 2; ++pp) {
                const float nr = __builtin_fmaf(-li[pp], xi[pp], __builtin_fmaf(lr[pp], xr[pp], bu[pp][i])), ni = __builtin_fmaf(li[pp], xr[pp], __builtin_fmaf(lr[pp], xi[pp], bu[2 + pp][i]));
                xr[pp] = nr; xi[pp] = ni; asm volatile("" : "+v"(xr[pp]), "+v"(xi[pp])); bu[pp][i] = xr[pp]; bu[2 + pp][i] = xi[pp]; }
        if (PASS2) {
#pragma unroll
            for (int jt = 0; jt < 4; ++jt)
#pragma unroll
                for (int g4 = 0; g4 < 4; ++g4) { u32x2 v; v.x = pk2(bu[jt][4 * g4], bu[jt][4 * g4 + 1]); v.y = pk2(bu[jt][4 * g4 + 2], bu[jt][4 * g4 + 3]);
                    *(LAS u32x2*)(img + jt * 2048 + n * 64 + 8 * (2 * g4 + hh)) = v; }
            LDS_WAIT();
            f32x16 y0, y1;
#pragma unroll
            for (int i = 0; i < 16; ++i) { y0[i] = 0.f; y1[i] = 0.f; }
            s16x4 r[16];
            { const unsigned b0 = ibase + 8 * (4 * blk + p4) + (8 * hh + q4) * 64;
              asm volatile("ds_read_b64_tr_b16 %0, %16\n\tds_read_b64_tr_b16 %1, %16 offset:256\n\tds_read_b64_tr_b16 %2, %16 offset:1024\n\tds_read_b64_tr_b16 %3, %16 offset:1280\n\t"
                           "ds_read_b64_tr_b16 %4, %16 offset:2048\n\tds_read_b64_tr_b16 %5, %16 offset:2304\n\tds_read_b64_tr_b16 %6, %16 offset:3072\n\tds_read_b64_tr_b16 %7, %16 offset:3328\n\t"
                           "ds_read_b64_tr_b16 %8, %16 offset:4096\n\tds_read_b64_tr_b16 %9, %16 offset:4352\n\tds_read_b64_tr_b16 %10, %16 offset:5120\n\tds_read_b64_tr_b16 %11, %16 offset:5376\n\t"
                           "ds_read_b64_tr_b16 %12, %16 offset:6144\n\tds_read_b64_tr_b16 %13, %16 offset:6400\n\tds_read_b64_tr_b16 %14, %16 offset:7168\n\tds_read_b64_tr_b16 %15, %16 offset:7424\n\ts_waitcnt lgkmcnt(0)"
                           : "=&v"(r[0]), "=&v"(r[1]), "=&v"(r[2]), "=&v"(r[3]), "=&v"(r[4]), "=&v"(r[5]), "=&v"(r[6]), "=&v"(r[7]),
                             "=&v"(r[8]), "=&v"(r[9]), "=&v"(r[10]), "=&v"(r[11]), "=&v"(r[12]), "=&v"(r[13]), "=&v"(r[14]), "=&v"(r[15])
                           : "v"(b0) : "memory"); }
#pragma unroll
            for (int jt = 0; jt < 4; ++jt) {
                const bf16x8 xa0 = __builtin_shufflevector(r[4 * jt], r[4 * jt + 1], 0, 1, 2, 3, 4, 5, 6, 7), xa1 = __builtin_shufflevector(r[4 * jt + 2], r[4 * jt + 3], 0, 1, 2, 3, 4, 5, 6, 7);
                y0 = MFMA32(Cf[jt][0], xa0, y0); y1 = MFMA32(Cf[jt][1], xa1, y1); }
            asm volatile("s_nop 15" : "+v"(y0), "+v"(y1));
            { const int ypos = 16 * tl + arow_pos; const int yrow = abase + (d ? 255 - ypos : ypos);
              bf16_t* yp = YD + (size_t)yrow * 512 + g * 16 + 4 * hh;
              u32x2 w0, w1; w0.x = pk2(y0[0] + y1[0], y0[1] + y1[1]); w0.y = pk2(y0[2] + y1[2], y0[3] + y1[3]); w1.x = pk2(y0[4] + y1[4], y0[5] + y1[5]); w1.y = pk2(y0[6] + y1[6], y0[7] + y1[7]);
              *(u32x2*)yp = w0; *(u32x2*)(yp + 8) = w1; }
        }
    }
    if (!PASS2) { float* xl = XLOC + (size_t)(((myseg - 32) * 32 + g) * 2 + d) * 128;
#pragma unroll
        for (int pp = 0; pp < 2; ++pp) { xl[32 * pp + n] = xr[pp]; xl[64 + 32 * pp + n] = xi[pp]; }
    } else if (myseg < 32) {
#pragma unroll
        for (int pp = 0; pp < 2; ++pp) { const size_t o = (size_t)((myseg * 2 + d) * 32 + g) * 64 + 32 * pp + n; P.out[OUT_SRE + o] = xr[pp]; P.out[OUT_SIM + o] = xi[pp]; }
    }
}

__device__ __forceinline__ float fgelu_tanh(float y) { const float z = 0.7978845608f * (y + 0.044715f * y * y * y); const float t = 1.0f - 2.0f * __builtin_amdgcn_rcpf(1.0f + __expf(2.0f * z)); return 0.5f * y * (1.0f + t); }
__device__ __forceinline__ void combine_a(const Params& P, int wg0) {
    if ((int)blockIdx.x < wg0) return;
    const int lane = threadIdx.x & 63, gw = (blockIdx.x - wg0) * 8 + (threadIdx.x >> 6), NGW = (gridDim.x - wg0) * 8, c0 = lane * 8;
    const bf16_t* OF = (const bf16_t*)(P.ws + WS_H); const bf16_t* OBk = OF + (size_t)M * 512;
    const bf16_t* Z = (const bf16_t*)(P.ws + WS_Z); bf16_t* A2 = (bf16_t*)(P.ws + WS_A2);
    float hg[8];
#pragma unroll
    for (int e = 0; e < 8; ++e) hg[e] = P.in[I_HG][c0 + e];
    for (int m = gw; m < M; m += NGW) {
        float a[8], b[8], ga[8], o[8];
        unpack8(*(const u32x4*)(OF + (size_t)m * 512 + c0), a); unpack8(*(const u32x4*)(OBk + (size_t)m * 512 + c0), b); unpack8(*(const u32x4*)(Z + (size_t)m * NZ + ZGA + c0), ga);
        float ss = 0.f;
#pragma unroll
        for (int e = 0; e < 8; ++e) { a[e] += b[e]; ss += a[e] * a[e]; }
        ss += __shfl_xor(ss, 1); ss += __shfl_xor(ss, 2); ss += __shfl_xor(ss, 4); ss += __shfl_xor(ss, 8);
        const float r = rsqrtf(ss * (1.0f / 128.0f) + EPS);
#pragma unroll
        for (int e = 0; e < 8; ++e) o[e] = a[e] * r * hg[e] * ga[e];
        *(u32x4*)(A2 + (size_t)m * 1024 + c0) = pack8(o);
    }
}
__device__ __forceinline__ void combine_b(const Params& P) {
    const int lane = threadIdx.x & 63, gw = blockIdx.x * 8 + (threadIdx.x >> 6), NGW = gridDim.x * 8, c0 = lane * 8;
    const bf16_t* YF = (const bf16_t*)P.out; const bf16_t* YB = YF + (size_t)M * 512;
    const bf16_t* Z = (const bf16_t*)(P.ws + WS_Z); bf16_t* YBF = (bf16_t*)(P.ws + WS_YBF);
    float dsk[8];
#pragma unroll
    for (int e = 0; e < 8; ++e) dsk[e] = P.in[I_S5D][c0 + e];
    for (int m = gw; m < M; m += NGW) {
        float yf[8], yb[8], uu[8], y[8];
        unpack8(*(const u32x4*)(YF + (size_t)m * 512 + c0), yf); unpack8(*(const u32x4*)(YB + (size_t)m * 512 + c0), yb); unpack8(*(const u32x4*)(Z + (size_t)m * NZ + ZU + c0), uu);
#pragma unroll
        for (int e = 0; e < 8; ++e) y[e] = fgelu_tanh(yf[e] + yb[e] + dsk[e] * uu[e]);
        *(u32x4*)(YBF + (size_t)m * 512 + c0) = pack8(y);
    }
}
__device__ __forceinline__ void phase_conv(const Params& P) {
    const bf16_t* PB = (const bf16_t*)(P.ws + WS_Z + 160 * MiB); const bf16_t* GB = (const bf16_t*)(P.ws + WS_A2); bf16_t* A3 = (bf16_t*)(P.ws + WS_Z + 80 * MiB);
    const int gt = blockIdx.x * 512 + threadIdx.x, NT = gridDim.x * 512;
    for (int idx = gt; idx < MP * 128; idx += NT) { const int row = idx >> 7, c0 = (idx & 127) * 8;
        const int pos = row < MP ? (row & 255) : ((row - MP) & 63), L = row < MP ? 256 : 64;
        float p0[8], p1[8], p2[8], gg[8], o[8];
        const u32x4 zero = (u32x4){0u, 0u, 0u, 0u};
        unpack8(pos > 0 ? *(const u32x4*)(PB + (size_t)(row - 1) * D + c0) : zero, p0);
        unpack8(*(const u32x4*)(PB + (size_t)row * D + c0), p1);
        unpack8(pos < L - 1 ? *(const u32x4*)(PB + (size_t)(row + 1) * D + c0) : zero, p2);
        unpack8(*(const u32x4*)(GB + (size_t)row * D + c0), gg);
        const float* cw = P.in[I_CW] + c0; const float* cb = P.in[I_CB] + c0;
#pragma unroll
        for (int e = 0; e < 8; ++e) o[e] = gg[e] * (cw[e] * p0[e] + cw[1024 + e] * p1[e] + cw[2048 + e] * p2[e] + cb[e]);
        *(u32x4*)(A3 + (size_t)row * D + c0) = pack8(o); }
}

#define XB_TMO      128
#define XB_XCNT(j)  (256  + 64 * (j))
#define XB_XSUB(j)  (1280 + 64 * (j))
#define XB_XGEN(j)  (2304 + 64 * (j))
#define XB_TOP      3328
#define XB_TOPGEN   3392
#define XCD_BAR_WORDS 3456
#define XB_SPIN_CAP (1u << 18)

__device__ __forceinline__ unsigned xb_ld(unsigned* p)              { return __hip_atomic_load(p, __ATOMIC_RELAXED, __HIP_MEMORY_SCOPE_AGENT); }
__device__ __forceinline__ unsigned xb_add(unsigned* p, unsigned v) { return __hip_atomic_fetch_add(p, v, __ATOMIC_RELAXED, __HIP_MEMORY_SCOPE_AGENT); }
__device__ __forceinline__ unsigned xb_xcc_id() { return (unsigned)__builtin_amdgcn_s_getreg((3 << 11) | 20) & 0xFu; }
#define XB_SPIN(cond, bar) do { unsigned _sp = 0; while (cond) { __builtin_amdgcn_s_sleep(1); \
    if ((++_sp & 255u) == 0u) { if (xb_ld(&(bar)[XB_TMO])) break; if (_sp > XB_SPIN_CAP) { atomicAdd(&(bar)[XB_TMO], 1u); break; } } } } while (0)

struct XcdBarrier {
    unsigned* bar; unsigned x;
    volatile LAS unsigned* st;
};

__device__ __forceinline__ XcdBarrier xcd_barrier_post(unsigned* bar, volatile LAS unsigned* st) {
    XcdBarrier b; b.bar = bar; b.x = xb_xcc_id(); b.st = st;
    if (threadIdx.x == 0) (void)xb_add(&bar[XB_XCNT(b.x)], 1u);
    return b;
}
__device__ __forceinline__ void xcd_barrier_complete(unsigned* bar, unsigned x, unsigned& nloc, unsigned& nx) {
    const unsigned G = gridDim.x * gridDim.y * gridDim.z;
    unsigned sum, cnt, mine, sp = 0u;
    for (;;) {
        sum = 0u; cnt = 0u; mine = 0u;
#pragma unroll
        for (unsigned j = 0; j < 16; ++j) { const unsigned c = xb_ld(&bar[XB_XCNT(j)]); sum += c; cnt += (c > 0u) ? 1u : 0u; mine = (j == x) ? c : mine; }
        if (sum == G) break;
        __builtin_amdgcn_s_sleep(1);
        if ((++sp & 255u) == 0u) { if (xb_ld(&bar[XB_TMO])) break; if (sp > XB_SPIN_CAP) { atomicAdd(&bar[XB_TMO], 1u); break; } }
    }
    nloc = mine > 0u ? mine : 1u; nx = cnt > 0u ? cnt : 1u;
}

__device__ __forceinline__ void xcd_barrier(const XcdBarrier& b) {
    asm volatile("s_waitcnt vmcnt(0)" ::: "memory");
    __syncthreads();
    if (threadIdx.x == 0) {
        unsigned* bar = b.bar;
        __builtin_amdgcn_s_waitcnt(0);
        unsigned nloc = b.st[0], nx = b.st[1];
        if (nloc == 0u) { xcd_barrier_complete(bar, b.x, nloc, nx); b.st[0] = nloc; b.st[1] = nx; }
        const unsigned old = xb_add(&bar[XB_XSUB(b.x)], 1u);
        const unsigned gen = old / nloc;
        if (old + 1u == (gen + 1u) * nloc) {
            __builtin_amdgcn_fence(__ATOMIC_RELEASE, "agent");
            asm volatile("s_waitcnt vmcnt(0)" ::: "memory");
            const unsigned og = xb_add(&bar[XB_TOP], 1u);
            const unsigned tg = og / nx;
            if (og + 1u == (tg + 1u) * nx) xb_add(&bar[XB_TOPGEN], 1u);
            else XB_SPIN(xb_ld(&bar[XB_TOPGEN]) == tg, bar);
            __builtin_amdgcn_fence(__ATOMIC_ACQUIRE, "agent");
            xb_add(&bar[XB_XGEN(b.x)], 1u);
            asm volatile("s_waitcnt vmcnt(0)" ::: "memory");
        } else {
            XB_SPIN(xb_ld(&bar[XB_XGEN(b.x)]) == gen, bar);
            __builtin_amdgcn_fence(__ATOMIC_ACQUIRE, "agent");
            asm volatile("s_waitcnt vmcnt(0)" ::: "memory");
        }
    }
    __syncthreads();
}


constexpr int LDS_BYTES = 131072 + 64 + 4096;
constexpr int NPHASE = 13;
__global__ void __launch_bounds__(512, 2) mk_fwd(Params P) {
    extern __shared__ __attribute__((aligned(16))) unsigned char lds_raw[];
    LAS unsigned char* lds = (LAS unsigned char*)lds_raw;
    cg::grid_group grid = cg::this_grid();
    const int lo = P.ph_lo, hi = P.ph_hi;
    if (threadIdx.x < 4) ((LAS unsigned*)(lds + 131072))[threadIdx.x] = 0u;
    __syncthreads();
    XcdBarrier bar = xcd_barrier_post((unsigned*)P.ws + P.li * XCD_BAR_WORDS, (volatile LAS unsigned*)(lds + 131072));
    if (hi < 0) grid.sync();
    const int wave = threadIdx.x >> 6;
    bf16_t* H = (bf16_t*)(P.ws + WS_H); bf16_t* Zb = (bf16_t*)(P.ws + WS_Z); bf16_t* A2 = (bf16_t*)(P.ws + WS_A2); bf16_t* YBF = (bf16_t*)(P.ws + WS_YBF);
    float* MOD = (float*)(P.ws + WS_MOD); bf16_t* Y1b = (bf16_t*)(P.ws + WS_Z);
#ifndef PHMASK
#define PHMASK 0x3fff
#endif
#ifndef DBLMASK
#define DBLMASK 0
#endif
#ifndef STAGGER_TICKS
#define STAGGER_TICKS 1300
#endif
#define STAGGER() do { if (blockIdx.x >= 128) { const unsigned long long t0_ = __builtin_amdgcn_s_memrealtime(); while (__builtin_amdgcn_s_memrealtime() - t0_ < STAGGER_TICKS) __builtin_amdgcn_s_sleep(8); } } while (0)
#define IN(k) (((PHMASK >> (k)) & 1) && lo <= (k) && (k) < hi)
#ifdef USE_CG_SYNC
#define SEAM(k) do { if (lo <= (k) && (k) + 1 < hi) grid.sync(); } while (0)
#else
#define SEAM(k) do { if (lo <= (k) && (k) + 1 < hi) xcd_barrier(bar); } while (0)
#endif
    if (IN(0)) phase0(P, lds);
    SEAM(0);
    if (IN(1)) phase_norm(P.in[I_XP], P.in[I_XS], P.in[I_NORMG], MOD, H);
    SEAM(1);
    if (IN(2)) { pg8::Gemm g{H, (const bf16_t*)(P.ws + WS_WIN_E), M, NZ, 1024}; pg8::StaticOrder S; S.init(M, NZ, gridDim.x, blockIdx.x);
        EpiZ E{Zb, P.in[I_LB]}; pg8::gemm_phase<EpiZ, pg8::StaticOrder>(lds, g, S, E); }
    SEAM(2);
    if (IN(3)) {
        for (int t = blockIdx.x; t < 1024; t += gridDim.x) hgrn_pass1_task(P, lds, t);
        for (int t = blockIdx.x * 8 + wave; t < 4096; t += gridDim.x * 8) s5_task<false>(P, lds + wave * 8192, t);
    }
    SEAM(3);
    if (IN(4)) {
        hgrn_carry(P);
        const int nslot = gridDim.x * 8, slot = wave < 4 ? blockIdx.x * 4 + wave : (nslot >> 1) + blockIdx.x * 4 + (wave - 4);
        for (int t = slot; t < 5120; t += nslot) s5_task<true>(P, lds + wave * 8192, t);
    }
    SEAM(4);
    if (IN(5)) {
        for (int t = blockIdx.x; t < 1280; t += gridDim.x) hgrn_task<true>(P, lds, t);
        combine_b(P);
    }
    SEAM(5);
    if (IN(6)) {
        pg8::Gemm g{YBF, (const bf16_t*)(P.ws + WS_WGLU), M, 512, 512}; pg8::StaticOrder S; S.init(M, 512, gridDim.x, blockIdx.x);
        EpiGlu E{YBF, Zb, P.in[I_BGLU], A2}; pg8::gemm_phase<EpiGlu, pg8::StaticOrder>(lds, g, S, E);
        combine_a(P, gridDim.x > 128 ? 64 : 0);
    }
    SEAM(6);
    if (IN(7)) { pg8::Gemm g{A2, (const bf16_t*)(P.ws + WS_WOUT_E), M, 1024, 1024}; pg8::StaticOrder S; S.init(M, 1024, gridDim.x, blockIdx.x);
        EpiRes3 E{P.in[I_XP], P.in[I_XS], MOD, MOD + 9 * 3072, P.in[I_NORMG] + 1024, Y1b, H, (float*)(P.ws + WS_SSP), lds + 131072 + 64}; pg8::gemm_phase<EpiRes3, pg8::StaticOrder>(lds, g, S, E);
        sw_items(P, lds, gridDim.x >= 256 ? 128 : 0); }
    SEAM(7);
    if (IN(8)) phase_rstd(P);
    SEAM(8);
    if (IN(9)) { pg8::Gemm g{H, (const bf16_t*)(P.ws + WS_WIN_O), M, 4096, 1024}; pg8::StaticOrder S; S.init(M, 4096, gridDim.x, blockIdx.x);
        EpiOdd E{(bf16_t*)(P.ws + WS_Z + 160 * MiB), A2, (const float*)(P.ws + WS_RSTD), (const float*)(P.ws + WS_SW), (bf16_t*)(P.ws + WS_Z + 80 * MiB), P.in[I_CW], P.in[I_CB]}; pg8::gemm_phase<EpiOdd, pg8::StaticOrder>(lds, g, S, E); }
    SEAM(9);
    if (IN(10)) phase_conv(P);
    SEAM(10);
    if (IN(11)) { pg8::Gemm g{(const bf16_t*)(P.ws + WS_Z + 80 * MiB), (const bf16_t*)(P.ws + WS_WOUT_O), M, 1024, 1024}; pg8::StaticOrder S; S.init(M, 1024, gridDim.x, blockIdx.x);
        EpiRes5 E{Y1b, MOD + 9 * 3072, P.in[I_FNG], H, (float*)(P.ws + WS_SSP)}; pg8::gemm_phase<EpiRes5, pg8::StaticOrder>(lds, g, S, E); }
    SEAM(11);
    if (IN(12)) phase_final_norm(P.out, H, (const float*)(P.ws + WS_SSP));
#undef IN
#undef SEAM
}

extern "C" void kernel_launch(void* const* d_in, const int* in_sizes, int n_in, void* d_out, int out_size, void* d_ws, size_t ws_size, hipStream_t stream) {
    static int grid = 0;
    if (grid == 0) {
        if (n_in != 29 || ws_size < WS_END) { fprintf(stderr, "kernel_launch: unexpected n_in %d / ws_size %zu (need %zu)\n", n_in, ws_size, (size_t)WS_END); grid = -1; return; }
        int dev = 0, cus = 0, per_cu = 0;
        hipGetDevice(&dev); hipDeviceGetAttribute(&cus, hipDeviceAttributeMultiprocessorCount, dev);
        if (hipFuncSetAttribute((const void*)mk_fwd, hipFuncAttributeMaxDynamicSharedMemorySize, LDS_BYTES) != hipSuccess) { fprintf(stderr, "kernel_launch: hipFuncSetAttribute failed\n"); grid = -1; return; }
        if (hipOccupancyMaxActiveBlocksPerMultiprocessor(&per_cu, (const void*)mk_fwd, 512, LDS_BYTES) != hipSuccess || per_cu < 1) { fprintf(stderr, "kernel_launch: occupancy query says %d\n", per_cu); per_cu = 1; }
        (void)hipGetLastError();
        grid = cus * per_cu;
        fprintf(stderr, "kernel_launch: grid %d (cus %d x %d)\n", grid, cus, per_cu);
    }
    if (grid < 0) return;
    Params p{};
    (void)hipMemsetAsync(d_ws, 0, 65536, stream);
    for (int i = 0; i < 29; ++i) p.in[i] = (const float*)d_in[i];
    p.out = (float*)d_out; p.ws = (unsigned char*)d_ws;
#if MK_COOP
    void* args[] = {&p};
#ifdef PROBE_SPLIT
    p.ph_lo = 0; p.ph_hi = PROBE_SPLIT + 1;
    (void)hipLaunchCooperativeKernel((const void*)mk_fwd, dim3(grid), dim3(512), args, LDS_BYTES, stream);
    p.ph_lo = PROBE_SPLIT; p.ph_hi = NPHASE; p.li = 1;
#else
    p.ph_lo = 0; p.ph_hi = NPHASE;
#endif
    hipError_t e = hipLaunchCooperativeKernel((const void*)mk_fwd, dim3(grid), dim3(512), args, LDS_BYTES, stream);
    if (e != hipSuccess) fprintf(stderr, "kernel_launch: cooperative launch failed: %s (grid %d)\n", hipGetErrorString(e), grid);
#else
    for (int ph = 0; ph < NPHASE; ++ph) { p.ph_lo = ph; p.ph_hi = ph + 1; hipLaunchKernelGGL(mk_fwd, dim3(grid), dim3(512), LDS_BYTES, stream, p); }
#endif
}
```

```cpp
#include <hip/hip_runtime.h>
#include <hip/hip_cooperative_groups.h>
#include <cstdio>
#include <cstdint>
namespace cg = cooperative_groups;
#ifndef MK_COOP
#define MK_COOP 1
#endif

namespace pg8 {
#define PG8_LAS __attribute__((address_space(3)))
typedef unsigned short bf16_t;
typedef short bf16x8 __attribute__((ext_vector_type(8)));
typedef float f32x4 __attribute__((ext_vector_type(4)));
typedef unsigned u32x4 __attribute__((ext_vector_type(4)));
constexpr int BM = 256, BK = 64, HALF = 128, HTB = HALF * BK * 2  , STAGE_BYTES = 8 * HTB, NXCD = 8, WGM = 8;

__host__ __device__ __forceinline__ int lds_byte(int r, int c) { const int st = (r >> 4) * 2 + (c >> 5), rr = r & 15, cc = c & 31, ob = rr * 64 + cc * 2; return st * 1024 + (ob ^ (((ob >> 9) & 1) << 5)); }
__host__ __device__ __forceinline__ void stage_rc(int b, int& R, int& C) { const int st = b / 1024, sb = b % 1024, swz = sb ^ (((sb >> 9) & 1) << 5); R = (st >> 1) * 16 + swz / 64; C = (st & 1) * 32 + (swz % 64) / 2; }
__host__ __device__ __forceinline__ int perm32(int rho) { const int n = rho >> 4, i = rho & 15; return 8 * (i >> 2) + 4 * n + (i & 3); }

struct Unit { int pm, pn; };
struct Gemm { const bf16_t* A; const bf16_t* Bt; int M, N, K; };

struct StaticOrder {
    int nM, nN, nwg, G, c;
    __host__ __device__ void init(int M, int N, int G_, int c_) { nM = M / BM; nN = N / BM; nwg = nM * nN; G = G_; c = c_; }
    __host__ __device__ bool next(int i, Unit& u) const {
        const long L = (long)i * G + c; if (L >= nwg) return false;
        int wgid = (int)L; { const int q = nwg / NXCD, r = nwg % NXCD, xcd = wgid % NXCD, off = wgid / NXCD; wgid = (xcd < r ? xcd * (q + 1) : r * (q + 1) + (xcd - r) * q) + off; }
        const int nig = WGM * nN, gid = wgid / nig, fm = gid * WGM, gsz = (nM - fm) < WGM ? (nM - fm) : WGM;
        u.pm = fm + ((wgid % nig) % gsz); u.pn = (wgid % nig) / gsz; return true;
    }
    __device__ __forceinline__ void a_ready(const Unit&) const {}
    __device__ __forceinline__ void done(const Unit&) const {}
};

__device__ __forceinline__ unsigned cvt_pk_bf16(float lo, float hi) { unsigned r; asm volatile("v_cvt_pk_bf16_f32 %0, %1, %2" : "=v"(r) : "v"(lo), "v"(hi)); return r; }

template <class Epi, class Sched>
__device__ __forceinline__ void gemm_phase(PG8_LAS unsigned char* lds, const Gemm g, const Sched& S, const Epi& E) {
    const int tid = threadIdx.x, wid = __builtin_amdgcn_readfirstlane(tid >> 6), lane = tid & 63, wr = wid >> 2, wc = wid & 3, fr = lane & 15, fq = lane >> 4;
    const int K = g.K, nt = K / BK;
    unsigned voffA[2], voffB[2];
#pragma unroll
    for (int i = 0; i < 2; ++i) { int R, C; stage_rc(tid * 16 + i * 8192, R, C); const int Rb = Epi::PERM ? ((R & ~31) + perm32(R & 31)) : R;
        voffA[i] = (unsigned)(R * K + C) * 2u; voffB[i] = (unsigned)(Rb * K + C) * 2u; }
    const size_t kstep = (size_t)(BK * 2);
    const size_t hstep = (size_t)HALF * K * 2;
    const size_t tstep = 2 * hstep;
    const unsigned ldsw = (unsigned)wid * 1024u;
    const int aoff = lds_byte(wr * 64 + fr, fq * 8), boff = lds_byte(wc * 32 + fr, fq * 8);
#define PG8_SA(b, h) (((b) * 2 + (h)) * HTB)
#define PG8_SB(b, h) ((4 + (b) * 2 + (h)) * HTB)
#define PG8_STAGE(bufoff, gbase, voff) do { _Pragma("unroll") for (int _i = 0; _i < 2; ++_i) \
        __builtin_amdgcn_global_load_lds((const unsigned*)((const char*)(gbase) + (voff)[_i]), (PG8_LAS unsigned*)(lds + (bufoff) + ldsw + _i * 8192), 16, 0, 0); } while (0)
#define PG8_LDA(dst, b, h) do { _Pragma("unroll") for (int m = 0; m < 4; ++m) _Pragma("unroll") for (int k = 0; k < 2; ++k) dst[m][k] = *(const PG8_LAS bf16x8*)(lds + PG8_SA(b, h) + aoff + m * 2048 + k * 1024); } while (0)
#define PG8_LDB(dst, b, h) do { _Pragma("unroll") for (int n = 0; n < 2; ++n) _Pragma("unroll") for (int k = 0; k < 2; ++k) dst[n][k] = *(const PG8_LAS bf16x8*)(lds + PG8_SB(b, h) + boff + n * 2048 + k * 1024); } while (0)
#define PG8_MMA(ai, bj, At, Bt) do { __builtin_amdgcn_s_setprio(1); _Pragma("unroll") for (int m = 0; m < 4; ++m) _Pragma("unroll") for (int n = 0; n < 2; ++n) _Pragma("unroll") for (int k = 0; k < 2; ++k) \
        acc[ai][bj][m][n] = __builtin_amdgcn_mfma_f32_16x16x32_bf16(Bt[n][k], At[m][k], acc[ai][bj][m][n], 0, 0, 0); __builtin_amdgcn_s_setprio(0); } while (0)
#define PG8_WAIT_V(n) asm volatile("s_waitcnt vmcnt(" #n ")" ::: "memory")
#define PG8_WAIT_L(n) asm volatile("s_waitcnt lgkmcnt(" #n ")" ::: "memory")
#define PG8_BAR __builtin_amdgcn_s_barrier()
#define PG8_SCHED __builtin_amdgcn_sched_barrier(0)
    Unit cur, nxt; int ui = 0;
    if (!S.next(0, cur)) return;
    f32x4 acc[2][2][4][2];
#pragma unroll
    for (int a = 0; a < 2; ++a)
#pragma unroll
        for (int b = 0; b < 2; ++b)
#pragma unroll
            for (int m = 0; m < 4; ++m)
#pragma unroll
                for (int n = 0; n < 2; ++n) acc[a][b][m][n] = (f32x4){0.f, 0.f, 0.f, 0.f};
    bf16x8 At[4][2], B0[2][2], B1[2][2];
    const char* cA = (const char*)g.A + (size_t)cur.pm * tstep; const char* cB = (const char*)g.Bt + (size_t)cur.pn * tstep;
    S.a_ready(cur);
    PG8_STAGE(PG8_SB(0, 0), cB, voffB); PG8_STAGE(PG8_SA(0, 0), cA, voffA); PG8_STAGE(PG8_SB(0, 1), cB + hstep, voffB); PG8_STAGE(PG8_SA(0, 1), cA + hstep, voffA);
    if (wr == 1) PG8_BAR;
    PG8_WAIT_V(4); PG8_BAR;
    PG8_STAGE(PG8_SB(1, 0), cB + kstep, voffB); PG8_STAGE(PG8_SA(1, 0), cA + kstep, voffA); PG8_STAGE(PG8_SB(1, 1), cB + hstep + kstep, voffB);
    PG8_WAIT_V(6); PG8_BAR;
    for (;;) {
        const bool has_next = S.next(ui + 1, nxt);
        const char* nA = has_next ? (const char*)g.A + (size_t)nxt.pm * tstep : cA; const char* nB = has_next ? (const char*)g.Bt + (size_t)nxt.pn * tstep : cB;
        for (int t = 0; t < nt; t += 2) {
            const bool last = (t == nt - 2);
            const char* a1 = cA + (size_t)(t + 1) * kstep;
            const char* a2 = last ? nA : cA + (size_t)(t + 2) * kstep; const char* b2 = last ? nB : cB + (size_t)(t + 2) * kstep;
            const char* a3 = a2 + kstep; const char* b3 = b2 + kstep;
            if (last && has_next) S.a_ready(nxt);
            PG8_LDB(B0, 0, 0); PG8_SCHED; PG8_LDA(At, 0, 0); PG8_STAGE(PG8_SA(1, 1), a1 + hstep, voffA);
            PG8_WAIT_L(8); PG8_BAR; PG8_WAIT_L(0); PG8_MMA(0, 0, At, B0); PG8_BAR; PG8_SCHED;
            PG8_LDB(B1, 0, 1); PG8_STAGE(PG8_SB(0, 0), b2, voffB);
            PG8_BAR; PG8_WAIT_L(0); PG8_MMA(0, 1, At, B1); PG8_BAR;
            PG8_LDA(At, 0, 1); PG8_STAGE(PG8_SA(0, 0), a2, voffA);
            PG8_BAR; PG8_WAIT_L(0); PG8_MMA(1, 0, At, B0); PG8_BAR; PG8_SCHED;
            PG8_STAGE(PG8_SB(0, 1), b2 + hstep, voffB);
            PG8_WAIT_V(6); PG8_BAR; PG8_MMA(1, 1, At, B1); PG8_BAR;
            PG8_LDB(B0, 1, 0); PG8_SCHED; PG8_LDA(At, 1, 0); PG8_STAGE(PG8_SA(0, 1), a2 + hstep, voffA);
            PG8_WAIT_L(8); PG8_BAR; PG8_WAIT_L(0); PG8_MMA(0, 0, At, B0); PG8_BAR; PG8_SCHED;
            PG8_LDB(B1, 1, 1); PG8_STAGE(PG8_SB(1, 0), b3, voffB);
            PG8_BAR; PG8_WAIT_L(0); PG8_MMA(0, 1, At, B1); PG8_BAR;
            PG8_LDA(At, 1, 1); PG8_STAGE(PG8_SA(1, 0), a3, voffA);
            PG8_BAR; PG8_WAIT_L(0); PG8_MMA(1, 0, At, B0); PG8_BAR; PG8_SCHED;
            PG8_STAGE(PG8_SB(1, 1), b3 + hstep, voffB);
            PG8_WAIT_V(6); PG8_BAR; PG8_MMA(1, 1, At, B1); PG8_BAR;
        }
        if constexpr (!Epi::AFTER_DRAIN) { E(acc, cur, wr, wc, fr, fq); S.done(cur); }
        if (!has_next) break;
#pragma unroll
        for (int a = 0; a < 2; ++a)
#pragma unroll
            for (int b = 0; b < 2; ++b)
#pragma unroll
                for (int m = 0; m < 4; ++m)
#pragma unroll
                    for (int n = 0; n < 2; ++n) acc[a][b][m][n] = (f32x4){0.f, 0.f, 0.f, 0.f};
        cur = nxt; cA = nA; cB = nB; ++ui;
    }
    PG8_WAIT_V(0);
    if (wr == 0) PG8_BAR;
    PG8_BAR;
    if constexpr (Epi::AFTER_DRAIN) { E.fused(acc, cur, wr, wc, fr, fq, lds, wid, lane); S.done(cur); }
#undef PG8_SA
#undef PG8_SB
#undef PG8_STAGE
#undef PG8_LDA
#undef PG8_LDB
#undef PG8_MMA
#undef PG8_WAIT_V
#undef PG8_WAIT_L
#undef PG8_BAR
#undef PG8_SCHED
}
}


#define LAS __attribute__((address_space(3)))
typedef unsigned short bf16_t;
typedef short bf16x8 __attribute__((ext_vector_type(8)));
typedef short s16x4 __attribute__((ext_vector_type(4)));
typedef float f32x4 __attribute__((ext_vector_type(4)));
typedef float f32x16 __attribute__((ext_vector_type(16)));
typedef unsigned u32x4 __attribute__((ext_vector_type(4)));
typedef unsigned u32x2 __attribute__((ext_vector_type(2)));

constexpr int D = 1024, MP = 8192, MS = 32768, M = 40960, NZ = 3584;
constexpr int ZQ = 0, ZF = 512, ZV = 1536, ZGA = 2048, ZU = 2560, ZGB = 3072;
constexpr float EPS = 1e-6f;
constexpr size_t MiB = 1u << 20;
constexpr size_t WS_S5T = 128 * 1024;
constexpr size_t S5T_STRIDE = 13312;
constexpr size_t WS_MOD = 1 * MiB;
constexpr size_t WS_BSEG = 1 * MiB + 512 * 1024;
constexpr size_t WS_WIN_E = 2 * MiB;
constexpr size_t WS_WOUT_E = 10 * MiB;
constexpr size_t WS_WGLU = 12 * MiB;
constexpr size_t WS_WIN_O = 13 * MiB;
constexpr size_t WS_WOUT_O = 21 * MiB;
constexpr size_t WS_XLOC = 23 * MiB;
constexpr size_t WS_SSP = 27 * MiB;
constexpr size_t WS_RSTD = 30 * MiB;
constexpr size_t WS_SW = 31 * MiB;
constexpr size_t WS_H = 32 * MiB;
constexpr size_t WS_Z = 112 * MiB;
constexpr size_t WS_A2 = 392 * MiB;
constexpr size_t WS_YBF = 472 * MiB;
constexpr size_t WS_END = 512 * MiB;
constexpr size_t OUT_YS = (size_t)MP * D, OUT_SH = (size_t)M * D, OUT_SRE = OUT_SH + 32 * 2 * 4 * 128 * 128, OUT_SIM = OUT_SRE + 32 * 2 * 32 * 64;

struct Params { const float* in[29]; float* out; unsigned char* ws; int ph_lo, ph_hi, li, pad; };
enum { I_XP = 0, I_XS, I_SH, I_SRE, I_SIM, I_C, I_CCTX, I_NORMG, I_WMOD, I_BMOD, I_WINE, I_WOUTE, I_LB, I_HG, I_LRE, I_LIM, I_LDT, I_BRE, I_BIM, I_CRE, I_CIM, I_S5D, I_WGLU, I_BGLU, I_WINO, I_WOUTO, I_CW, I_CB, I_FNG };

__device__ __forceinline__ float bf2f(unsigned x) { return __uint_as_float(x << 16); }
__device__ __forceinline__ float bflo(unsigned w) { return __uint_as_float(w << 16); }
__device__ __forceinline__ float bfhi(unsigned w) { return __uint_as_float(w & 0xffff0000u); }
typedef __bf16 bf16v2 __attribute__((ext_vector_type(2)));
__device__ __forceinline__ unsigned pk2(float lo, float hi) { bf16v2 v; v[0] = (__bf16)lo; v[1] = (__bf16)hi; return __builtin_bit_cast(unsigned, v); }
__device__ __forceinline__ float fsigmoid(float x) { return __builtin_amdgcn_rcpf(1.0f + __expf(-x)); }
__device__ __forceinline__ float fsilu(float x) { return x * fsigmoid(x); }
__device__ __forceinline__ float wave_sum(float v) {
#pragma unroll
    for (int o = 1; o < 64; o <<= 1) v += __shfl_xor(v, o);
    return v;
}
__device__ __forceinline__ void unpack8(const u32x4 w, float (&f)[8]) {
    f[0] = bflo(w.x); f[1] = bfhi(w.x); f[2] = bflo(w.y); f[3] = bfhi(w.y); f[4] = bflo(w.z); f[5] = bfhi(w.z); f[6] = bflo(w.w); f[7] = bfhi(w.w);
}
__device__ __forceinline__ u32x4 pack8(const float (&f)[8]) { u32x4 w; w.x = pk2(f[0], f[1]); w.y = pk2(f[2], f[3]); w.z = pk2(f[4], f[5]); w.w = pk2(f[6], f[7]); return w; }
#define LDS_WAIT() asm volatile("s_waitcnt lgkmcnt(0)" ::: "memory")

using pg8::Unit; using pg8::HALF; using pg8::BM;
struct EpiZ {
    static constexpr bool PERM = true, AFTER_DRAIN = false;
    bf16_t* Z; const float* lbl;
    __device__ __forceinline__ void operator()(const f32x4 (&acc)[2][2][4][2], const Unit& u, int wr, int wc, int fr, int fq) const {
        const int row0 = u.pm * BM + wr * 64 + fr, col0 = u.pn * BM + wc * 32 + 8 * fq, type = u.pn >> 1;
        float lb[2][8];
        if (type == 1 || type == 2) {
#pragma unroll
            for (int bj = 0; bj < 2; ++bj)
#pragma unroll
                for (int e = 0; e < 8; ++e) { const int c = (col0 + bj * HALF + e) & 511; lb[bj][e] = __builtin_amdgcn_rcpf(1.0f + __expf(lbl[512 + c] - lbl[c])); }
        }
#pragma unroll
        for (int ai = 0; ai < 2; ++ai)
#pragma unroll
            for (int m = 0; m < 4; ++m) { bf16_t* rowp = Z + (size_t)(row0 + ai * HALF + m * 16) * NZ + col0;
#pragma unroll
                for (int bj = 0; bj < 2; ++bj) { float v[8];
#pragma unroll
                    for (int e = 0; e < 4; ++e) { v[e] = acc[ai][bj][m][0][e]; v[4 + e] = acc[ai][bj][m][1][e]; }
                    if (type == 1 || type == 2) {
#pragma unroll
                        for (int e = 0; e < 8; ++e) v[e] = __logf(lb[bj][e] + (1.0f - lb[bj][e]) * fsigmoid(v[e]));
                    } else if (type == 4 || type == 6) {
#pragma unroll
                        for (int e = 0; e < 8; ++e) v[e] = fsilu(v[e]);
                    }
                    *(u32x4*)(rowp + bj * HALF) = pack8(v); } }
    }
};
struct EpiGlu {
    static constexpr bool PERM = true, AFTER_DRAIN = false;
    const bf16_t* Y; const bf16_t* Z; const float* bglu; bf16_t* A2;
    __device__ __forceinline__ void operator()(const f32x4 (&acc)[2][2][4][2], const Unit& u, int wr, int wc, int fr, int fq) const {
        const int row0 = u.pm * BM + wr * 64 + fr, col0 = u.pn * BM + wc * 32 + 8 * fq;
        float bv[2][8];
#pragma unroll
        for (int bj = 0; bj < 2; ++bj)
#pragma unroll
            for (int e = 0; e < 8; ++e) bv[bj][e] = bglu[col0 + bj * HALF + e];
#pragma unroll
        for (int ai = 0; ai < 2; ++ai) {
            u32x4 yv[4][2], zv[4][2];
#pragma unroll
            for (int m = 0; m < 4; ++m) { const size_t row = (size_t)(row0 + ai * HALF + m * 16);
#pragma unroll
                for (int bj = 0; bj < 2; ++bj) { const int col = col0 + bj * HALF; yv[m][bj] = *(const u32x4*)(Y + row * 512 + col); zv[m][bj] = *(const u32x4*)(Z + row * NZ + ZGB + col); } }
            asm volatile("" ::: "memory");
#pragma unroll
            for (int m = 0; m < 4; ++m) { const size_t row = (size_t)(row0 + ai * HALF + m * 16);
#pragma unroll
                for (int bj = 0; bj < 2; ++bj) { const int col = col0 + bj * HALF; float y[8], sg[8], o[8];
                    unpack8(yv[m][bj], y); unpack8(zv[m][bj], sg);
#pragma unroll
                    for (int e = 0; e < 8; ++e) { const float a = (e < 4 ? acc[ai][bj][m][0][e] : acc[ai][bj][m][1][e - 4]) + bv[bj][e]; o[e] = y[e] * fsigmoid(a) * sg[e]; }
                    *(u32x4*)(A2 + row * 1024 + 512 + col) = pack8(o); } }
            asm volatile("" ::: "memory");
        }
    }
};
struct EpiRes3 {
    static constexpr bool PERM = true, AFTER_DRAIN = false;
    const float* xp; const float* xs; const float* mod0; const float* mod1; const float* ng1; bf16_t* Y1b; bf16_t* H; float* SSP; LAS unsigned char* escr;
    __device__ __forceinline__ void operator()(const f32x4 (&acc)[2][2][4][2], const Unit& u, int wr, int wc, int fr, int fq) const {
        const int rowt = u.pm * BM, row0 = rowt + wr * 64 + fr, col0 = u.pn * BM + wc * 32 + 8 * fq;
        const int n = rowt < MP ? 0 : 1 + ((rowt - MP) >> 12);
        const float* base = rowt < MP ? xp : xs - (size_t)MP * D;
        LAS f32x4* slot = (LAS f32x4*)(escr + ((wr * 4 + wc) * 4 + fq) * 128);
        if (fr == 0) {
#pragma unroll
            for (int bj = 0; bj < 2; ++bj)
#pragma unroll
                for (int nn = 0; nn < 2; ++nn) { const int c = col0 + bj * HALF + nn * 4; slot[(bj * 2 + nn) * 2] = *(const f32x4*)(mod0 + n * 3072 + 2048 + c);
                    slot[(bj * 2 + nn) * 2 + 1] = *(const f32x4*)(ng1 + c) * (*(const f32x4*)(mod1 + n * 3072 + 1024 + c) + 1.0f); }
        }
        LDS_WAIT();
#pragma unroll
        for (int ai = 0; ai < 2; ++ai)
#pragma unroll
            for (int mp = 0; mp < 2; ++mp) {
                f32x4 bv[2][2][2];
#pragma unroll
                for (int mm = 0; mm < 2; ++mm) { const size_t off = (size_t)(row0 + ai * HALF + (2 * mp + mm) * 16) * D + col0;
#pragma unroll
                    for (int bj = 0; bj < 2; ++bj)
#pragma unroll
                        for (int nn = 0; nn < 2; ++nn) bv[mm][bj][nn] = *(const f32x4*)(base + off + bj * HALF + nn * 4); }
                asm volatile("" ::: "memory");
#pragma unroll
                for (int mm = 0; mm < 2; ++mm) { const int m = 2 * mp + mm; const int row = row0 + ai * HALF + m * 16; const size_t off = (size_t)row * D + col0; float ss = 0.f;
#pragma unroll
                    for (int bj = 0; bj < 2; ++bj) { u32x4 wy, wh;
#pragma unroll
                        for (int nn = 0; nn < 2; ++nn) { const f32x4 gvv = slot[(bj * 2 + nn) * 2], gmm = slot[(bj * 2 + nn) * 2 + 1];
                            const f32x4 y = bv[mm][bj][nn] + gvv * acc[ai][bj][m][nn]; const f32x4 hh = y * gmm;
                            ss += (y[0] * y[0] + y[1] * y[1]) + (y[2] * y[2] + y[3] * y[3]);
                            wy[2 * nn] = pk2(y[0], y[1]); wy[2 * nn + 1] = pk2(y[2], y[3]); wh[2 * nn] = pk2(hh[0], hh[1]); wh[2 * nn + 1] = pk2(hh[2], hh[3]); }
                        *(u32x4*)(Y1b + off + bj * HALF) = wy; *(u32x4*)(H + off + bj * HALF) = wh; }
                    ss += __shfl_xor(ss, 16); ss += __shfl_xor(ss, 32);
                    if (fq == 0) SSP[((size_t)row * 4 + u.pn) * 4 + wc] = ss; }
                asm volatile("" ::: "memory");
            }
    }
};
struct EpiRes5 {
    static constexpr bool PERM = true, AFTER_DRAIN = false;
    const bf16_t* Y1b; const float* mod1; const float* gF; bf16_t* T; float* SSP;
    __device__ __forceinline__ void operator()(const f32x4 (&acc)[2][2][4][2], const Unit& u, int wr, int wc, int fr, int fq) const {
        const int rowt = u.pm * BM, row0 = rowt + wr * 64 + fr, col0 = u.pn * BM + wc * 32 + 8 * fq;
        const int n = rowt < MP ? 0 : 1 + ((rowt - MP) >> 12);
        f32x4 gv[2][2], gf[2][2];
#pragma unroll
        for (int bj = 0; bj < 2; ++bj)
#pragma unroll
            for (int nn = 0; nn < 2; ++nn) { const int c = col0 + bj * HALF + nn * 4; gv[bj][nn] = *(const f32x4*)(mod1 + n * 3072 + 2048 + c); gf[bj][nn] = *(const f32x4*)(gF + c); }
#pragma unroll
        for (int ai = 0; ai < 2; ++ai) {
            u32x4 bv[4][2];
#pragma unroll
            for (int m = 0; m < 4; ++m) { const size_t off = (size_t)(row0 + ai * HALF + m * 16) * D + col0;
#pragma unroll
                for (int bj = 0; bj < 2; ++bj) bv[m][bj] = *(const u32x4*)(Y1b + off + bj * HALF); }
            asm volatile("" ::: "memory");
#pragma unroll
            for (int m = 0; m < 4; ++m) { const int row = row0 + ai * HALF + m * 16; const size_t off = (size_t)row * D + col0; float ss = 0.f;
#pragma unroll
                for (int bj = 0; bj < 2; ++bj) { const u32x4 w = bv[m][bj]; u32x4 wt;
#pragma unroll
                    for (int nn = 0; nn < 2; ++nn) { const f32x4 b = (f32x4){bflo(w[2 * nn]), bfhi(w[2 * nn]), bflo(w[2 * nn + 1]), bfhi(w[2 * nn + 1])};
                        const f32x4 y = b + gv[bj][nn] * acc[ai][bj][m][nn], t = y * gf[bj][nn];
                        ss += (y[0] * y[0] + y[1] * y[1]) + (y[2] * y[2] + y[3] * y[3]);
                        wt[2 * nn] = pk2(t[0], t[1]); wt[2 * nn + 1] = pk2(t[2], t[3]); }
                    *(u32x4*)(T + off + bj * HALF) = wt; }
                ss += __shfl_xor(ss, 16); ss += __shfl_xor(ss, 32);
                if (fq == 0) SSP[((size_t)row * 4 + u.pn) * 4 + wc] = ss; }
            asm volatile("" ::: "memory");
        }
    }
};
struct EpiOdd {
    static constexpr bool PERM = false, AFTER_DRAIN = false;
    bf16_t* PB; bf16_t* GB; const float* RSTD; const float* SW; bf16_t* A3; const float* cw; const float* cb;
    __device__ __forceinline__ void operator()(const f32x4 (&acc)[2][2][4][2], const Unit& u, int wr, int wc, int fr, int fq) const {
        const int rowt = u.pm * BM, row0 = rowt + wr * 64 + fr, ch0 = u.pn * 64 + 16 * wc + 4 * fq;
        const int n = rowt < MP ? 0 : 1 + ((rowt - MP) >> 12);
        f32x4 sw[4]; float rs[2][4];
#pragma unroll
        for (int blk = 0; blk < 4; ++blk) sw[blk] = *(const f32x4*)(SW + n * 4096 + blk * 1024 + ch0);
#pragma unroll
        for (int ai = 0; ai < 2; ++ai)
#pragma unroll
            for (int m = 0; m < 4; ++m) rs[ai][m] = RSTD[row0 + ai * HALF + m * 16];
        if (rowt >= MP) {
            const f32x4 w0 = *(const f32x4*)(cw + ch0), w1 = *(const f32x4*)(cw + 1024 + ch0), w2 = *(const f32x4*)(cw + 2048 + ch0), bb = *(const f32x4*)(cb + ch0);
#pragma unroll
            for (int ai = 0; ai < 2; ++ai) { f32x4 p[4], gm[4];
#pragma unroll
                for (int m = 0; m < 4; ++m) { const float r = rs[ai][m];
                    const f32x4 bg = acc[ai][0][m][0] * r + sw[0], cgv = acc[ai][0][m][1] * r + sw[1], vv = acc[ai][1][m][0] * r + sw[2], gg = acc[ai][1][m][1] * r + sw[3];
                    p[m] = cgv * vv;
#pragma unroll
                    for (int e = 0; e < 4; ++e) gm[m][e] = bg[e] * fsilu(gg[e]); }
#pragma unroll
                for (int m = 0; m < 4; ++m) { f32x4 pv, nx;
#pragma unroll
                    for (int e = 0; e < 4; ++e) {
                        const float us = __shfl_up(p[m][e], 1, 16), uc = m > 0 ? __shfl(p[m > 0 ? m - 1 : 0][e], 15, 16) : 0.f;
                        const float ds = __shfl_down(p[m][e], 1, 16), dc = m < 3 ? __shfl(p[m < 3 ? m + 1 : 3][e], 0, 16) : 0.f;
                        pv[e] = fr > 0 ? us : uc; nx[e] = fr < 15 ? ds : dc; }
                    const f32x4 y = gm[m] * (w0 * pv + w1 * p[m] + w2 * nx + bb);
                    u32x2 wy; wy.x = pk2(y[0], y[1]); wy.y = pk2(y[2], y[3]);
                    *(u32x2*)(A3 + (size_t)(row0 + ai * HALF + m * 16) * D + ch0) = wy; }
            }
        } else {
#pragma unroll
        for (int ai = 0; ai < 2; ++ai)
#pragma unroll
            for (int m = 0; m < 4; ++m) { const size_t off = (size_t)(row0 + ai * HALF + m * 16) * D + ch0; const float r = rs[ai][m];
                const f32x4 bg = acc[ai][0][m][0] * r + sw[0], cgv = acc[ai][0][m][1] * r + sw[1], vv = acc[ai][1][m][0] * r + sw[2], gg = acc[ai][1][m][1] * r + sw[3];
                const f32x4 p = cgv * vv; f32x4 g;
#pragma unroll
                for (int e = 0; e < 4; ++e) g[e] = bg[e] * fsilu(gg[e]);
                u32x2 wp, wg; wp.x = pk2(p[0], p[1]); wp.y = pk2(p[2], p[3]); wg.x = pk2(g[0], g[1]); wg.y = pk2(g[2], g[3]);
                *(u32x2*)(PB + off) = wp; *(u32x2*)(GB + off) = wg; }
        }
    }
};

__device__ __forceinline__ void s5_build_tables(const Params& P, int dg);
template <int MODE>
__device__ __forceinline__ void transpose_item(const float* W, int K, int N, bf16_t* WT, LAS float* scr, int item, int lane) {
    const int nblk = N / 32, kb = item / nblk, nb = item % nblk, k0 = 64 * kb, n0 = 32 * nb;
#pragma unroll 8
    for (int i = 0; i < 32; ++i) { const int kk = 2 * i + (lane >> 5); scr[kk * 33 + (lane & 31)] = W[(size_t)(k0 + kk) * N + n0 + (lane & 31)]; }
    LDS_WAIT();
    const int c = lane & 7;
#pragma unroll
    for (int j = 0; j < 4; ++j) { const int n = (lane >> 3) + 8 * j; const LAS float* s = scr + (8 * c) * 33 + n;
        u32x4 o; o.x = pk2(s[0 * 33], s[1 * 33]); o.y = pk2(s[2 * 33], s[3 * 33]); o.z = pk2(s[4 * 33], s[5 * 33]); o.w = pk2(s[6 * 33], s[7 * 33]);
        int dn = n0 + n;
        if (MODE == 1) { const int blk = dn >> 10, rem = dn & 1023, tile = rem >> 6, ch = rem & 63; dn = tile * 256 + 128 * (blk >> 1) + 32 * (ch >> 4) + 16 * (blk & 1) + (ch & 15); }
        *(u32x4*)(WT + (size_t)dn * K + k0 + 8 * c) = o; }
    LDS_WAIT();
}
__device__ __forceinline__ void gemv9_item(LAS unsigned char* lds, const float* W, int ldw, int jb, const float* bias, float* out, int ldo) {
    const int tid = threadIdx.x, lane = tid & 63, wave = tid >> 6;
    const LAS float* sc = (const LAS float*)lds; LAS float* red = (LAS float*)(lds + 36864);
    const float* Wc = W + jb * 64 + lane;
    float acc[9];
#pragma unroll
    for (int n = 0; n < 9; ++n) acc[n] = 0.f;
    for (int kk = 0; kk < 128; kk += 16) { const int k0 = wave * 128 + kk;
        float wv[16];
#pragma unroll
        for (int q = 0; q < 16; ++q) wv[q] = Wc[(size_t)(k0 + q) * ldw];
#pragma unroll
        for (int q = 0; q < 16; q += 4)
#pragma unroll
            for (int n = 0; n < 9; ++n) { const f32x4 sv = *(const LAS f32x4*)(sc + n * 1024 + k0 + q); acc[n] += sv[0] * wv[q] + sv[1] * wv[q + 1] + sv[2] * wv[q + 2] + sv[3] * wv[q + 3]; } }
#pragma unroll
    for (int n = 0; n < 9; ++n) red[(wave * 9 + n) * 64 + lane] = acc[n];
    __syncthreads();
    for (int i = tid; i < 576; i += 512) { const int n = i >> 6, jj = i & 63; float sum = 0.f;
#pragma unroll
        for (int w = 0; w < 8; ++w) sum += red[(w * 9 + n) * 64 + jj];
        out[n * ldo + jb * 64 + jj] = sum + (bias ? bias[jb * 64 + jj] : 0.f); }
    __syncthreads();
}
__device__ __forceinline__ void phase0(const Params& P, LAS unsigned char* lds) {
    const int tid = threadIdx.x, lane = tid & 63, wave = tid >> 6;
    float* MOD = (float*)(P.ws + WS_MOD);
    if (blockIdx.x < 96) {
        LAS float* sc = (LAS float*)lds;
        for (int i = tid; i < 9 * 1024; i += 512) { const int n = i >> 10, k = i & 1023; const float c = n == 0 ? P.in[I_CCTX][k] : P.in[I_C][(n - 1) * 1024 + k]; sc[i] = fsilu(c); }
        __syncthreads();
        for (int item = blockIdx.x; item < 96; item += gridDim.x) { const int l = item / 48, jb = item % 48;
            gemv9_item(lds, P.in[I_WMOD] + (size_t)l * 1024 * 3072, 3072, jb, P.in[I_BMOD] + l * 3072, MOD + l * 9 * 3072, 3072); }
    }
    __syncthreads();
    LAS float* scr = (LAS float*)(lds + wave * 8448);
    const int tw0 = gridDim.x >= 192 ? 96 : 0;
    if ((int)blockIdx.x < tw0) return;
    const int gw = (blockIdx.x - tw0) * 8 + wave, NGW = (gridDim.x - tw0) * 8;
    constexpr int I1 = 16 * 112, I2 = 16 * 32, I3 = 8 * 16, I4 = 16 * 128, I5 = 16 * 32;
    for (int it = gw; it < 64 + I1 + I2 + I3 + I4 + I5; it += NGW) {
        int r = it;
        if (r < 64) { s5_build_tables(P, r); continue; } r -= 64;
        if (r < I1) { transpose_item<0>(P.in[I_WINE], 1024, 3584, (bf16_t*)(P.ws + WS_WIN_E), scr, r, lane); continue; } r -= I1;
        if (r < I2) { transpose_item<0>(P.in[I_WOUTE], 1024, 1024, (bf16_t*)(P.ws + WS_WOUT_E), scr, r, lane); continue; } r -= I2;
        if (r < I3) { transpose_item<0>(P.in[I_WGLU], 512, 512, (bf16_t*)(P.ws + WS_WGLU), scr, r, lane); continue; } r -= I3;
        if (r < I4) { transpose_item<1>(P.in[I_WINO], 1024, 4096, (bf16_t*)(P.ws + WS_WIN_O), scr, r, lane); continue; } r -= I4;
        transpose_item<0>(P.in[I_WOUTO], 1024, 1024, (bf16_t*)(P.ws + WS_WOUT_O), scr, r, lane);
    }
}

__device__ __forceinline__ void phase_norm(const float* xp, const float* xs, const float* ng, const float* mod, bf16_t* H) {
    const int lane = threadIdx.x & 63, gw = blockIdx.x * 8 + (threadIdx.x >> 6), NGW = gridDim.x * 8;
    for (int m = gw; m < M; m += NGW) {
        const float* xr = m < MP ? xp + (size_t)m * D : xs + (size_t)(m - MP) * D; const int n = m < MP ? 0 : 1 + ((m - MP) >> 12);
        f32x4 v[4]; float ss = 0.f;
#pragma unroll
        for (int j = 0; j < 4; ++j) { v[j] = __builtin_nontemporal_load((const f32x4*)(xr + 4 * lane + 256 * j)); ss += (v[j][0] * v[j][0] + v[j][1] * v[j][1]) + (v[j][2] * v[j][2] + v[j][3] * v[j][3]); }
        const float rstd = rsqrtf(wave_sum(ss) * (1.0f / D) + EPS);
#pragma unroll
        for (int j = 0; j < 4; ++j) { const int col = 4 * lane + 256 * j;
            const f32x4 g = *(const f32x4*)(ng + col), sh = *(const f32x4*)(mod + n * 3072 + col), sc = *(const f32x4*)(mod + n * 3072 + 1024 + col);
            const f32x4 y = v[j] * rstd * g * (sc + 1.0f) + sh;
            u32x2 w; w.x = pk2(y[0], y[1]); w.y = pk2(y[2], y[3]); *(u32x2*)(H + (size_t)m * D + col) = w; }
    }
}
__device__ __forceinline__ void phase_final_norm(float* out, const bf16_t* T, const float* SSP) {
    const int lane = threadIdx.x & 63, gw = blockIdx.x * 8 + (threadIdx.x >> 6), NGW = gridDim.x * 8;
    for (int m = gw; m < M; m += NGW) {
        const u32x4 t0 = __builtin_nontemporal_load((const u32x4*)(T + (size_t)m * D + 8 * lane)), t1 = __builtin_nontemporal_load((const u32x4*)(T + (size_t)m * D + 512 + 8 * lane));
        const float rstd = rsqrtf(wave_sum(lane < 16 ? SSP[(size_t)m * 16 + lane] : 0.f) * (1.0f / D) + EPS);
        float a[8], b[8]; unpack8(t0, a); unpack8(t1, b);
        float* o = out + (size_t)m * D + 8 * lane;
        __builtin_nontemporal_store((f32x4){a[0], a[1], a[2], a[3]} * rstd, (f32x4*)o); __builtin_nontemporal_store((f32x4){a[4], a[5], a[6], a[7]} * rstd, (f32x4*)(o + 4));
        __builtin_nontemporal_store((f32x4){b[0], b[1], b[2], b[3]} * rstd, (f32x4*)(o + 512)); __builtin_nontemporal_store((f32x4){b[4], b[5], b[6], b[7]} * rstd, (f32x4*)(o + 516));
    }
}

constexpr int HG_QP = 272, HG_SP = 144;
constexpr int HG_Q = 0, HG_K = 17408, HG_KT = 34816, HG_VT = 53248, HG_P = 71680, HG_ST = 80896, HG_TAB = 115712;
__device__ __forceinline__ int seg_rowbase(int sg) { return sg < 32 ? sg * 256 : MP + (sg - 32) * 256; }
#define MFMA16(a, b, c) __builtin_amdgcn_mfma_f32_16x16x32_bf16((a), (b), (c), 0, 0, 0)
#define MFMA32(a, b, c) __builtin_amdgcn_mfma_f32_32x32x16_bf16((a), (b), (c), 0, 0, 0)

template <bool PASS2>
__device__ __forceinline__ void hgrn_task(const Params& P, LAS unsigned char* lds, int task) {
    const int tid = threadIdx.x, lane = tid & 63, w = __builtin_amdgcn_readfirstlane(tid >> 6), col = lane & 15, quad = lane >> 4;
    const int ch = tid & 127, qt = tid >> 7;
    const int d = task & 1, h = (task >> 1) & 3, sg = PASS2 ? (task >> 3) : 32 + (task >> 3);
    const int rowbase = seg_rowbase(sg), slot = ((sg - 32) << 3) | (h << 1) | d;
    const bf16_t* Z = (const bf16_t*)(P.ws + WS_Z);
    float* SLOC = (float*)(P.ws + WS_A2); float* BSEG = (float*)(P.ws + WS_BSEG);
    bf16_t* OB = (bf16_t*)(P.ws + WS_H) + (size_t)d * M * 512;
    LAS float* qtot = (LAS float*)(lds + HG_TAB); LAS float* ebm = qtot + 512; LAS float* e2t = qtot + 640;
    f32x4 S[8];
#pragma unroll
    for (int vt = 0; vt < 8; ++vt) {
        if (PASS2 && sg >= 32) {
#pragma unroll
            for (int j = 0; j < 4; ++j) S[vt][j] = SLOC[(size_t)slot * 16384 + (16 * w + 4 * quad + j) * 128 + 16 * vt + col];
        } else S[vt] = (f32x4){0.f, 0.f, 0.f, 0.f};
    }
    float bsum = 0.f;
    unsigned nlf[16], nv[16], nq[16];
    const char* Zlf = (const char*)(Z + ZF + 512 * d + 128 * h); const char* Zvv = (const char*)(Z + ZV + 128 * h); const char* Zqq = (const char*)(Z + ZQ + 128 * h);
    const int bstep = d ? -(NZ * 2) : NZ * 2;
    const unsigned boff0 = ((unsigned)(rowbase + (d ? 255 - 16 * qt : 16 * qt)) * (unsigned)NZ + (unsigned)ch) * 2u;
#define HG_LOAD(cc) do { unsigned bo = boff0 + (unsigned)(64 * (cc) * bstep); _Pragma("unroll") for (int e = 0; e < 16; ++e) { \
            nlf[e] = *(const bf16_t*)(Zlf + bo); nv[e] = *(const bf16_t*)(Zvv + bo); if (PASS2) nq[e] = *(const bf16_t*)(Zqq + bo); bo += (unsigned)bstep; } } while (0)
    HG_LOAD(0);
    for (int c = 0; c < 4; ++c) {
        float lf[16], cs[16], qq[16]; unsigned vraw[16];
#pragma unroll
        for (int e = 0; e < 16; ++e) { lf[e] = bf2f(nlf[e]); vraw[e] = nv[e]; if (PASS2) qq[e] = bf2f(nq[e]); }
        { float run = 0.f;
#pragma unroll
          for (int e = 0; e < 16; ++e) { run += lf[e]; cs[e] = run; } }
        qtot[qt * 128 + ch] = cs[15];
        __syncthreads();
        const float t0 = qtot[ch], t1 = qtot[128 + ch], t2 = qtot[256 + ch], t3 = qtot[384 + ch];
        const float off = qt == 0 ? 0.f : (qt == 1 ? t0 : (qt == 2 ? t0 + t1 : t0 + t1 + t2));
        const float bmid = t0 + t1, blast = (t0 + t1) + (t2 + t3);
        unsigned ktp[8], vtp[8];
#pragma unroll
        for (int e = 0; e < 16; e += 2) {
            float kt[2];
#pragma unroll
            for (int z = 0; z < 2; ++z) { const float b = off + cs[e + z]; const float kk = 1.0f - __expf(lf[e + z]); kt[z] = kk * __expf(fminf(bmid - b, 80.f));
                if (PASS2) { const int i = 16 * qt + e + z; const float qv = qq[e + z] * __expf(b - bmid);
                    *(LAS bf16_t*)(lds + HG_Q + i * HG_QP + ch * 2) = (bf16_t)(pk2(qv, 0.f) & 0xffffu);
                    *(LAS bf16_t*)(lds + HG_K + i * HG_QP + ch * 2) = (bf16_t)(pk2(kt[z], 0.f) & 0xffffu); } }
            ktp[e >> 1] = pk2(kt[0], kt[1]); vtp[e >> 1] = vraw[e] | (vraw[e + 1] << 16);
        }
        *(LAS u32x4*)(lds + HG_KT + ch * HG_SP + qt * 32) = (u32x4){ktp[0], ktp[1], ktp[2], ktp[3]};
        *(LAS u32x4*)(lds + HG_KT + ch * HG_SP + qt * 32 + 16) = (u32x4){ktp[4], ktp[5], ktp[6], ktp[7]};
        *(LAS u32x4*)(lds + HG_VT + ch * HG_SP + qt * 32) = (u32x4){vtp[0], vtp[1], vtp[2], vtp[3]};
        *(LAS u32x4*)(lds + HG_VT + ch * HG_SP + qt * 32 + 16) = (u32x4){vtp[4], vtp[5], vtp[6], vtp[7]};
        if (qt == 0) { ebm[ch] = __expf(bmid); e2t[ch] = __expf(blast - bmid); bsum += blast; }
        __syncthreads();
        if (c < 3) HG_LOAD(c + 1);
        const f32x4 eb = *(const LAS f32x4*)(ebm + 16 * w + 4 * quad), e2v = *(const LAS f32x4*)(e2t + 16 * w + 4 * quad);
#pragma unroll
        for (int vt = 0; vt < 8; ++vt) { S[vt] = S[vt] * eb;
            if (PASS2) { u32x2 sw; sw.x = pk2(S[vt][0], S[vt][1]); sw.y = pk2(S[vt][2], S[vt][3]);
                *(LAS u32x2*)(lds + HG_ST + (16 * vt + col) * HG_QP + (16 * w + 4 * quad) * 2) = sw; } }
        if (PASS2) {
#pragma unroll
            for (int ti = 0; ti < 2; ++ti) { const int id = 2 * w + ti, st = id >> 2, tt = id & 3;
                f32x4 ap = (f32x4){0.f, 0.f, 0.f, 0.f};
                if (st <= tt) {
#pragma unroll
                    for (int ks = 0; ks < 4; ++ks) { const bf16x8 a = *(const LAS bf16x8*)(lds + HG_K + (16 * st + col) * HG_QP + ks * 64 + quad * 16);
                        const bf16x8 b = *(const LAS bf16x8*)(lds + HG_Q + (16 * tt + col) * HG_QP + ks * 64 + quad * 16); ap = MFMA16(a, b, ap); }
                    const int tpos = 16 * tt + col, s0 = 16 * st + 4 * quad;
#pragma unroll
                    for (int j = 0; j < 4; ++j) ap[j] = (s0 + j <= tpos) ? ap[j] : 0.f;
                }
                u32x2 pw; pw.x = pk2(ap[0], ap[1]); pw.y = pk2(ap[2], ap[3]);
                *(LAS u32x2*)(lds + HG_P + (16 * tt + col) * HG_SP + (16 * st + 4 * quad) * 2) = pw; }
        }
        __syncthreads();
        if (PASS2) { const int tt = w >> 1;
#pragma unroll
            for (int vi = 0; vi < 4; ++vi) { const int vt = 4 * (w & 1) + vi; f32x4 ao = (f32x4){0.f, 0.f, 0.f, 0.f};
#pragma unroll
                for (int ks = 0; ks < 2; ++ks) { const bf16x8 a = *(const LAS bf16x8*)(lds + HG_VT + (16 * vt + col) * HG_SP + ks * 64 + quad * 16);
                    const bf16x8 b = *(const LAS bf16x8*)(lds + HG_P + (16 * tt + col) * HG_SP + ks * 64 + quad * 16); ao = MFMA16(a, b, ao); }
#pragma unroll
                for (int ks = 0; ks < 4; ++ks) { const bf16x8 a = *(const LAS bf16x8*)(lds + HG_ST + (16 * vt + col) * HG_QP + ks * 64 + quad * 16);
                    const bf16x8 b = *(const LAS bf16x8*)(lds + HG_Q + (16 * tt + col) * HG_QP + ks * 64 + quad * 16); ao = MFMA16(a, b, ao); }
                const int pos = 64 * c + 16 * tt + col; const int row = rowbase + (d ? 255 - pos : pos);
                u32x2 ow; ow.x = pk2(ao[0], ao[1]); ow.y = pk2(ao[2], ao[3]);
                *(u32x2*)(OB + (size_t)row * 512 + 128 * h + 16 * vt + 4 * quad) = ow; }
        }
#pragma unroll
        for (int vt = 0; vt < 8; ++vt) {
#pragma unroll
            for (int ks = 0; ks < 2; ++ks) { const bf16x8 a = *(const LAS bf16x8*)(lds + HG_KT + (16 * w + col) * HG_SP + ks * 64 + quad * 16);
                const bf16x8 b = *(const LAS bf16x8*)(lds + HG_VT + (16 * vt + col) * HG_SP + ks * 64 + quad * 16); S[vt] = MFMA16(a, b, S[vt]); }
            S[vt] = S[vt] * e2v; }
    }
#undef HG_LOAD
    if (!PASS2) {
#pragma unroll
        for (int vt = 0; vt < 8; ++vt)
#pragma unroll
            for (int j = 0; j < 4; ++j) SLOC[(size_t)slot * 16384 + (16 * w + 4 * quad + j) * 128 + 16 * vt + col] = S[vt][j];
        if (qt == 0) BSEG[slot * 128 + ch] = bsum;
    } else if (sg < 32) {
        float* o = P.out + OUT_SH + (size_t)((sg * 2 + d) * 4 + h) * 16384;
#pragma unroll
        for (int vt = 0; vt < 8; ++vt)
#pragma unroll
            for (int j = 0; j < 4; ++j) o[(16 * w + 4 * quad + j) * 128 + 16 * vt + col] = S[vt][j];
    }
    __syncthreads();
}
__device__ __forceinline__ void hgrn_pass1_task(const Params& P, LAS unsigned char* lds, int task) {
    const int tid = threadIdx.x, lane = tid & 63, w = __builtin_amdgcn_readfirstlane(tid >> 6), col = lane & 15, quad = lane >> 4;
    const int ch = tid & 127, qt = tid >> 7;
    const int d = task & 1, h = (task >> 1) & 3, sg = 32 + (task >> 3), rowbase = seg_rowbase(sg), slot = task;
    const bf16_t* Z = (const bf16_t*)(P.ws + WS_Z);
    float* SLOC = (float*)(P.ws + WS_A2); float* BSEG = (float*)(P.ws + WS_BSEG);
    LAS float* qtot = (LAS float*)(lds + 131072 + 64);
    unsigned lfp[32], vp[32]; float tot = 0.f;
    const long zstep = d ? -(long)NZ : (long)NZ;
    const bf16_t* zl = Z + (size_t)(rowbase + (d ? 255 - 64 * qt : 64 * qt)) * NZ + 128 * h + ch + ZF + 512 * d; const bf16_t* zv = zl + (ZV - ZF - 512 * d);
#pragma unroll
    for (int e2 = 0; e2 < 32; ++e2) {
        const unsigned l0 = zl[0], v0 = zv[0]; zl += zstep; zv += zstep;
        const unsigned l1 = zl[0], v1 = zv[0]; zl += zstep; zv += zstep;
        if ((e2 & 3) == 3) asm volatile("" : "+v"(zl), "+v"(zv));
        lfp[e2] = l0 | (l1 << 16); vp[e2] = v0 | (v1 << 16); tot += bflo(lfp[e2]) + bfhi(lfp[e2]); }
    qtot[qt * 128 + ch] = tot;
    __syncthreads();
    const float t0 = qtot[ch], t1 = qtot[128 + ch], t2 = qtot[256 + ch], t3 = qtot[384 + ch];
    float run = qt == 3 ? 0.f : (qt == 2 ? t3 : (qt == 1 ? t2 + t3 : t1 + t2 + t3));
#pragma unroll
    for (int e2 = 31; e2 >= 0; --e2) { const float l1 = bfhi(lfp[e2]), l0 = bflo(lfp[e2]);
        const float k1 = (1.0f - __expf(l1)) * __expf(run); run += l1;
        const float k0 = (1.0f - __expf(l0)) * __expf(run); run += l0;
        lfp[e2] = pk2(k0, k1); }
#pragma unroll
    for (int c8 = 0; c8 < 8; ++c8) { const int cx = ((8 * qt + c8) ^ (ch & 31)) << 4;
        *(LAS u32x4*)(lds + ch * 512 + cx) = (u32x4){lfp[4 * c8], lfp[4 * c8 + 1], lfp[4 * c8 + 2], lfp[4 * c8 + 3]};
        *(LAS u32x4*)(lds + 65536 + ch * 512 + cx) = (u32x4){vp[4 * c8], vp[4 * c8 + 1], vp[4 * c8 + 2], vp[4 * c8 + 3]}; }
    __syncthreads();
    f32x4 S[8];
#pragma unroll
    for (int vt = 0; vt < 8; ++vt) S[vt] = (f32x4){0.f, 0.f, 0.f, 0.f};
    const int ar = 16 * w + col;
#pragma unroll
    for (int ks = 0; ks < 8; ++ks) { const bf16x8 a = *(const LAS bf16x8*)(lds + ar * 512 + (((4 * ks + quad) ^ (ar & 31)) << 4));
#pragma unroll
        for (int vt = 0; vt < 8; ++vt) { const int br = 16 * vt + col; const bf16x8 b = *(const LAS bf16x8*)(lds + 65536 + br * 512 + (((4 * ks + quad) ^ (br & 31)) << 4)); S[vt] = MFMA16(a, b, S[vt]); } }
#pragma unroll
    for (int vt = 0; vt < 8; ++vt)
#pragma unroll
        for (int j = 0; j < 4; ++j) SLOC[(size_t)slot * 16384 + (16 * w + 4 * quad + j) * 128 + 16 * vt + col] = S[vt][j];
    if (qt == 0) BSEG[slot * 128 + ch] = (t0 + t1) + (t2 + t3);
    __syncthreads();
}
__device__ __forceinline__ void sw_items(const Params& P, LAS unsigned char* lds, int wg0) {
    const int b = (int)blockIdx.x - wg0;
    if (b >= 0 && b < 64) { LAS float* sc = (LAS float*)lds; const float* mod1 = (const float*)(P.ws + WS_MOD) + 9 * 3072;
        for (int i = threadIdx.x; i < 9 * 1024; i += 512) sc[i] = mod1[(i >> 10) * 3072 + (i & 1023)];
        __syncthreads();
        for (int item = b; item < 64; item += (int)gridDim.x - wg0) gemv9_item(lds, P.in[I_WINO], 4096, item, nullptr, (float*)(P.ws + WS_SW), 4096);
    }
}
__device__ __forceinline__ void phase_rstd(const Params& P) {
    const float* SSP = (const float*)(P.ws + WS_SSP); float* RSTD = (float*)(P.ws + WS_RSTD);
    for (int row = blockIdx.x * 512 + threadIdx.x; row < M; row += gridDim.x * 512) { const f32x4* p = (const f32x4*)(SSP + (size_t)row * 16);
        const f32x4 a = p[0], b = p[1], c = p[2], d = p[3];
        const float ss = ((a[0] + a[1]) + (a[2] + a[3])) + ((b[0] + b[1]) + (b[2] + b[3])) + ((c[0] + c[1]) + (c[2] + c[3])) + ((d[0] + d[1]) + (d[2] + d[3]));
        RSTD[row] = rsqrtf(ss * (1.0f / D) + EPS); }
}
__device__ __forceinline__ void hgrn_carry(const Params& P) {
    float* SLOC = (float*)(P.ws + WS_A2); const float* BSEG = (const float*)(P.ws + WS_BSEG);
    const int gt = blockIdx.x * 512 + threadIdx.x, NT = gridDim.x * 512;
    for (int idx = gt; idx < 64 * 16384; idx += NT) { const int chain = idx >> 14, e = idx & 16383, b = chain >> 3, h = (chain >> 1) & 3, d = chain & 1, k = e >> 7;
        float run = P.in[I_SH][(size_t)((b * 2 + d) * 4 + h) * 16384 + e];
        for (int jj = 0; jj < 16; ++jj) { const int ks = d ? 15 - jj : jj; const int slot = ((b * 16 + ks) << 3) | (h << 1) | d;
            const float tmp = SLOC[(size_t)slot * 16384 + e]; SLOC[(size_t)slot * 16384 + e] = run; run = __expf(BSEG[slot * 128 + k]) * run + tmp; } }
}

__device__ __forceinline__ void s5_build_tables(const Params& P, int dg) {
    const int lane = threadIdx.x & 63, n = lane & 31, hh = lane >> 5;
    unsigned char* tab = P.ws + WS_S5T + (size_t)dg * S5T_STRIDE;
    const float dt = __expf(P.in[I_LDT][dg]);
    float lr[2], li[2], cre[2], cim[2];
#pragma unroll
    for (int pp = 0; pp < 2; ++pp) { const int p = 32 * pp + n; const float lre = P.in[I_LRE][dg * 64 + p], lim = P.in[I_LIM][dg * 64 + p];
        const float mag = expf(lre * dt); float sn, cs; sincosf(lim * dt, &sn, &cs); lr[pp] = mag * cs; li[pp] = mag * sn;
        const float den = lre * lre + lim * lim; cre[pp] = ((lr[pp] - 1.0f) * lre + li[pp] * lim) / den; cim[pp] = (li[pp] * lre - (lr[pp] - 1.0f) * lim) / den;
        float ar = lr[pp], ai = li[pp];
#pragma unroll
        for (int q = 0; q < 8; ++q) { const float nr = ar * ar - ai * ai, ni = 2.0f * ar * ai; ar = nr; ai = ni; }
        if (hh == 0) { float* lam = (float*)(tab + 12288); lam[p] = lr[pp]; lam[64 + p] = li[pp]; lam[128 + p] = ar; lam[192 + p] = ai; } }
#pragma unroll
    for (int jt = 0; jt < 4; ++jt) { const int pp = jt & 1, part = jt >> 1, p = 32 * pp + n; float v[8];
        const float* br = P.in[I_BRE] + (size_t)(dg * 64 + p) * 16 + 8 * hh; const float* bi = P.in[I_BIM] + (size_t)(dg * 64 + p) * 16 + 8 * hh;
#pragma unroll
        for (int j = 0; j < 8; ++j) v[j] = part ? (cre[pp] * bi[j] + cim[pp] * br[j]) : (cre[pp] * br[j] - cim[pp] * bi[j]);
        *(u32x4*)(tab + jt * 1024 + lane * 16) = pack8(v); }
#pragma unroll
    for (int jt = 0; jt < 4; ++jt)
#pragma unroll
        for (int sx = 0; sx < 2; ++sx) { const int part = jt >> 1, p0 = 32 * (jt & 1) + 16 * sx + 8 * hh; float v[8];
            const float* cp = (part ? P.in[I_CIM] : P.in[I_CRE]) + (size_t)(dg * 16 + (n & 15)) * 64 + p0;
#pragma unroll
            for (int j = 0; j < 8; ++j) { const float c = cp[j]; v[j] = n < 16 ? (part ? -c : c) : 0.f; }
            *(u32x4*)(tab + 4096 + (jt * 2 + sx) * 1024 + lane * 16) = pack8(v); }
}
template <bool PASS2>
__device__ __forceinline__ void s5_task(const Params& P, LAS unsigned char* img, int task) {
    const int lane = threadIdx.x & 63, n = lane & 31, hh = lane >> 5;
    const int d = task & 1, g = (task >> 1) & 31, pr = task >> 6;
    const int segA = PASS2 ? 2 * pr : 32 + 2 * pr, myseg = segA + hh;
    const bf16_t* Z = (const bf16_t*)(P.ws + WS_Z);
    float* XLOC = (float*)(P.ws + WS_XLOC);
    const int dg = d * 32 + g;
    const unsigned char* tab = P.ws + WS_S5T + (size_t)dg * S5T_STRIDE; const float* lam = (const float*)(tab + 12288);
    float lr[2], li[2], xr[2], xi[2]; bf16x8 Bf[4], Cf[4][2];
#pragma unroll
    for (int pp = 0; pp < 2; ++pp) { lr[pp] = lam[32 * pp + n]; li[pp] = lam[64 + 32 * pp + n]; }
#pragma unroll
    for (int jt = 0; jt < 4; ++jt) Bf[jt] = *(const bf16x8*)(tab + jt * 1024 + lane * 16);
    if (PASS2) {
#pragma unroll
        for (int jt = 0; jt < 4; ++jt)
#pragma unroll
            for (int sx = 0; sx < 2; ++sx) Cf[jt][sx] = *(const bf16x8*)(tab + 4096 + (jt * 2 + sx) * 1024 + lane * 16);
    }
#pragma unroll
    for (int pp = 0; pp < 2; ++pp) { xr[pp] = 0.f; xi[pp] = 0.f; }
    if (PASS2 && myseg >= 32) { const int sb = (myseg - 32) >> 4, sk = (myseg - 32) & 15;
#pragma unroll
        for (int pp = 0; pp < 2; ++pp) { const int p = 32 * pp + n;
            const float ar = lam[128 + p], ai = lam[192 + p];
            float sr = P.in[I_SRE][(size_t)((sb * 2 + d) * 32 + g) * 64 + p], si = P.in[I_SIM][(size_t)((sb * 2 + d) * 32 + g) * 64 + p];
            const int cnt = d ? 15 - sk : sk;
            for (int jj = 0; jj < cnt; ++jj) { const int ks = d ? 15 - jj : jj; const float* xl = XLOC + (size_t)(((sb * 16 + ks) * 32 + g) * 2 + d) * 128;
                const float nr = ar * sr - ai * si + xl[p], ni = ar * si + ai * sr + xl[64 + p]; sr = nr; si = ni; }
            xr[pp] = sr; xi[pp] = si; }
    }
    const int arow_seg = segA + ((n >> 2) & 1), arow_pos = (n & 3) + 4 * (n >> 3);
    const int abase = seg_rowbase(arow_seg), mybase = seg_rowbase(myseg);
    bf16_t* YD = (bf16_t*)P.out + (size_t)d * M * 512;
    const unsigned ibase = (unsigned)(uintptr_t)img;
    const int i16 = lane & 15, q4 = i16 >> 2, p4 = i16 & 3, blk = (lane >> 4) & 1;
    const bf16_t* zu = Z + ZU + g * 16 + 8 * hh;
    bf16x8 aq[2];
#pragma unroll
    for (int u = 0; u < 2; ++u) { const int apos = 16 * u + arow_pos; aq[u] = *(const bf16x8*)(zu + (size_t)(abase + (d ? 255 - apos : apos)) * NZ); }
#pragma nounroll
    for (int tl = 0; tl < 16; ++tl) {
        const bf16x8 a = aq[0];
        aq[0] = aq[1];
        { const int apos = 16 * (tl < 14 ? tl + 2 : 15) + arow_pos; aq[1] = *(const bf16x8*)(zu + (size_t)(abase + (d ? 255 - apos : apos)) * NZ); }
        f32x16 bu[4];
#pragma unroll
        for (int jt = 0; jt < 4; ++jt) { f32x16 z;
#pragma unroll
            for (int i = 0; i < 16; ++i) z[i] = 0.f;
            bu[jt] = MFMA32(a, Bf[jt], z); }
        asm volatile("s_nop 15" : "+v"(bu[0]), "+v"(bu[1]), "+v"(bu[2]), "+v"(bu[3]));
#pragma unroll
        for (int i = 0; i < 16; ++i)
#pragma unroll
            for (int pp = 0; pp < 2; ++pp) {
                const float nr = __builtin_fmaf(-li[pp], xi[pp], __builtin_fmaf(lr[pp], xr[pp], bu[pp][i])), ni = __builtin_fmaf(li[pp], xr[pp], __builtin_fmaf(lr[pp], xi[pp], bu[2 + pp][i]));
                xr[pp] = nr; xi[pp] = ni; asm volatile("" : "+v"(xr[pp]), "+v"(xi[pp])); bu[pp][i] = xr[pp]; bu[2 + pp][i] = xi[pp]; }
        if (PASS2) {
#pragma unroll
            for (int jt = 0; jt < 4; ++jt)
#pragma unroll
                for (int g4 = 0; g4 < 4; ++g4) { u32x2 v; v.x = pk2(bu[jt][4 * g4], bu[jt][4 * g4 + 1]); v.y = pk2(bu[jt][4 * g4 + 2], bu[jt][4 * g4 + 3]);
                    *(LAS u32x2*)(img + jt * 2048 + n * 64 + 8 * (2 * g4 + hh)) = v; }
            LDS_WAIT();
            f32x16 y0, y1;
#pragma unroll
            for (int i = 0; i < 16; ++i) { y0[i] = 0.f; y1[i] = 0.f; }
            s16x4 r[16];
            { const unsigned b0 = ibase + 8 * (4 * blk + p4) + (8 * hh + q4) * 64;
              asm volatile("ds_read_b64_tr_b16 %0, %16\n\tds_read_b64_tr_b16 %1, %16 offset:256\n\tds_read_b64_tr_b16 %2, %16 offset:1024\n\tds_read_b64_tr_b16 %3, %16 offset:1280\n\t"
                           "ds_read_b64_tr_b16 %4, %16 offset:2048\n\tds_read_b64_tr_b16 %5, %16 offset:2304\n\tds_read_b64_tr_b16 %6, %16 offset:3072\n\tds_read_b64_tr_b16 %7, %16 offset:3328\n\t"
                           "ds_read_b64_tr_b16 %8, %16 offset:4096\n\tds_read_b64_tr_b16 %9, %16 offset:4352\n\tds_read_b64_tr_b16 %10, %16 offset:5120\n\tds_read_b64_tr_b16 %11, %16 offset:5376\n\t"
                           "ds_read_b64_tr_b16 %12, %16 offset:6144\n\tds_read_b64_tr_b16 %13, %16 offset:6400\n\tds_read_b64_tr_b16 %14, %16 offset:7168\n\tds_read_b64_tr_b16 %15, %16 offset:7424\n\ts_waitcnt lgkmcnt(0)"
                           : "=&v"(r[0]), "=&v"(r[1]), "=&v"(r[2]), "=&v"(r[3]), "=&v"(r[4]), "=&v"(r[5]), "=&v"(r[6]), "=&v"(r[7]),
                             "=&v"(r[8]), "=&v"(r[9]), "=&v"(r[10]), "=&v"(r[11]), "=&v"(r[12]), "=&v"(r[13]), "=&v"(r[14]), "=&v"(r[15])
                           : "v"(b0) : "memory"); }
#pragma unroll
            for (int jt = 0; jt < 4; ++jt) {
                const bf16x8 xa0 = __builtin_shufflevector(r[4 * jt], r[4 * jt + 1], 0, 1, 2, 3, 4, 5, 6, 7), xa1 = __builtin_shufflevector(r[4 * jt + 2], r[4 * jt + 3], 0, 1, 2, 3, 4, 5, 6, 7);
                y0 = MFMA32(Cf[jt][0], xa0, y0); y1 = MFMA32(Cf[jt][1], xa1, y1); }
            asm volatile("s_nop 15" : "+v"(y0), "+v"(y1));
            { const int ypos = 16 * tl + arow_pos; const int yrow = abase + (d ? 255 - ypos : ypos);
              bf16_t* yp = YD + (size_t)yrow * 512 + g * 16 + 4 * hh;
              u32x2 w0, w1; w0.x = pk2(y0[0] + y1[0], y0[1] + y1[1]); w0.y = pk2(y0[2] + y1[2], y0[3] + y1[3]); w1.x = pk2(y0[4] + y1[4], y0[5] + y1[5]); w1.y = pk2(y0[6] + y1[6], y0[7] + y1[7]);
              *(u32x2*)yp = w0; *(u32x2*)(yp + 8) = w1; }
        }
    }
    if (!PASS2) { float* xl = XLOC + (size_t)(((myseg - 32) * 32 + g) * 2 + d) * 128;
#pragma unroll
        for (int pp = 0; pp < 2; ++pp) { xl[32 * pp + n] = xr[pp]; xl[64 + 32 * pp + n] = xi[pp]; }
    } else if (myseg < 32) {
#pragma unroll
        for (int pp = 0; pp < 2; ++pp) { const size_t o = (size_t)((myseg * 2 + d) * 32 + g) * 64 + 32 * pp + n; P.out[OUT_SRE + o] = xr[pp]; P.out[OUT_SIM + o] = xi[pp]; }
    }
}

__device__ __forceinline__ float fgelu_tanh(float y) { const float z = 0.7978845608f * (y + 0.044715f * y * y * y); const float t = 1.0f - 2.0f * __builtin_amdgcn_rcpf(1.0f + __expf(2.0f * z)); return 0.5f * y * (1.0f + t); }
__device__ __forceinline__ void combine_a(const Params& P, int wg0) {
    if ((int)blockIdx.x < wg0) return;
    const int lane = threadIdx.x & 63, gw = (blockIdx.x - wg0) * 8 + (threadIdx.x >> 6), NGW = (gridDim.x - wg0) * 8, c0 = lane * 8;
    const bf16_t* OF = (const bf16_t*)(P.ws + WS_H); const bf16_t* OBk = OF + (size_t)M * 512;
    const bf16_t* Z = (const bf16_t*)(P.ws + WS_Z); bf16_t* A2 = (bf16_t*)(P.ws + WS_A2);
    float hg[8];
#pragma unroll
    for (int e = 0; e < 8; ++e) hg[e] = P.in[I_HG][c0 + e];
    for (int m = gw; m < M; m += NGW) {
        float a[8], b[8], ga[8], o[8];
        unpack8(*(const u32x4*)(OF + (size_t)m * 512 + c0), a); unpack8(*(const u32x4*)(OBk + (size_t)m * 512 + c0), b); unpack8(*(const u32x4*)(Z + (size_t)m * NZ + ZGA + c0), ga);
        float ss = 0.f;
#pragma unroll
        for (int e = 0; e < 8; ++e) { a[e] += b[e]; ss += a[e] * a[e]; }
        ss += __shfl_xor(ss, 1); ss += __shfl_xor(ss, 2); ss += __shfl_xor(ss, 4); ss += __shfl_xor(ss, 8);
        const float r = rsqrtf(ss * (1.0f / 128.0f) + EPS);
#pragma unroll
        for (int e = 0; e < 8; ++e) o[e] = a[e] * r * hg[e] * ga[e];
        *(u32x4*)(A2 + (size_t)m * 1024 + c0) = pack8(o);
    }
}
__device__ __forceinline__ void combine_b(const Params& P) {
    const int lane = threadIdx.x & 63, gw = blockIdx.x * 8 + (threadIdx.x >> 6), NGW = gridDim.x * 8, c0 = lane * 8;
    const bf16_t* YF = (const bf16_t*)P.out; const bf16_t* YB = YF + (size_t)M * 512;
    const bf16_t* Z = (const bf16_t*)(P.ws + WS_Z); bf16_t* YBF = (bf16_t*)(P.ws + WS_YBF);
    float dsk[8];
#pragma unroll
    for (int e = 0; e < 8; ++e) dsk[e] = P.in[I_S5D][c0 + e];
    for (int m = gw; m < M; m += NGW) {
        float yf[8], yb[8], uu[8], y[8];
        unpack8(*(const u32x4*)(YF + (size_t)m * 512 + c0), yf); unpack8(*(const u32x4*)(YB + (size_t)m * 512 + c0), yb); unpack8(*(const u32x4*)(Z + (size_t)m * NZ + ZU + c0), uu);
#pragma unroll
        for (int e = 0; e < 8; ++e) y[e] = fgelu_tanh(yf[e] + yb[e] + dsk[e] * uu[e]);
        *(u32x4*)(YBF + (size_t)m * 512 + c0) = pack8(y);
    }
}
__device__ __forceinline__ void phase_conv(const Params& P) {
    const bf16_t* PB = (const bf16_t*)(P.ws + WS_Z + 160 * MiB); const bf16_t* GB = (const bf16_t*)(P.ws + WS_A2); bf16_t* A3 = (bf16_t*)(P.ws + WS_Z + 80 * MiB);
    const int gt = blockIdx.x * 512 + threadIdx.x, NT = gridDim.x * 512;
    for (int idx = gt; idx < MP * 128; idx += NT) { const int row = idx >> 7, c0 = (idx & 127) * 8;
        const int pos = row < MP ? (row & 255) : ((row - MP) & 63), L = row < MP ? 256 : 64;
        float p0[8], p1[8], p2[8], gg[8], o[8];
        const u32x4 zero = (u32x4){0u, 0u, 0u, 0u};
        unpack8(pos > 0 ? *(const u32x4*)(PB + (size_t)(row - 1) * D + c0) : zero, p0);
        unpack8(*(const u32x4*)(PB + (size_t)row * D + c0), p1);
        unpack8(pos < L - 1 ? *(const u32x4*)(PB + (size_t)(row + 1) * D + c0) : zero, p2);
        unpack8(*(const u32x4*)(GB + (size_t)row * D + c0), gg);
        const float* cw = P.in[I_CW] + c0; const float* cb = P.in[I_CB] + c0;
#pragma unroll
        for (int e = 0; e < 8; ++e) o[e] = gg[e] * (cw[e] * p0[e] + cw[1024 + e] * p1[e] + cw[2048 + e] * p2[e] + cb[e]);
        *(u32x4*)(A3 + (size_t)row * D + c0) = pack8(o); }
}

#define XB_TMO      128
#define XB_XCNT(j)  (256  + 64 * (j))
#define XB_XSUB(j)  (1280 + 64 * (j))
#define XB_XGEN(j)  (2304 + 64 * (j))
#define XB_TOP      3328
#define XB_TOPGEN   3392
#define XCD_BAR_WORDS 3456
#define XB_SPIN_CAP (1u << 18)

__device__ __forceinline__ unsigned xb_ld(unsigned* p)              { return __hip_atomic_load(p, __ATOMIC_RELAXED, __HIP_MEMORY_SCOPE_AGENT); }
__device__ __forceinline__ unsigned xb_add(unsigned* p, unsigned v) { return __hip_atomic_fetch_add(p, v, __ATOMIC_RELAXED, __HIP_MEMORY_SCOPE_AGENT); }
__device__ __forceinline__ unsigned xb_xcc_id() { return (unsigned)__builtin_amdgcn_s_getreg((3 << 11) | 20) & 0xFu; }
#define XB_SPIN(cond, bar) do { unsigned _sp = 0; while (cond) { __builtin_amdgcn_s_sleep(1); \
    if ((++_sp & 255u) == 0u) { if (xb_ld(&(bar)[XB_TMO])) break; if (_sp > XB_SPIN_CAP) { atomicAdd(&(bar)[XB_TMO], 1u); break; } } } } while (0)

struct XcdBarrier {
    unsigned* bar; unsigned x;
    volatile LAS unsigned* st;
};

__device__ __forceinline__ XcdBarrier xcd_barrier_post(unsigned* bar, volatile LAS unsigned* st) {
    XcdBarrier b; b.bar = bar; b.x = xb_xcc_id(); b.st = st;
    if (threadIdx.x == 0) (void)xb_add(&bar[XB_XCNT(b.x)], 1u);
    return b;
}
__device__ __forceinline__ void xcd_barrier_complete(unsigned* bar, unsigned x, unsigned& nloc, unsigned& nx) {
    const unsigned G = gridDim.x * gridDim.y * gridDim.z;
    unsigned sum, cnt, mine, sp = 0u;
    for (;;) {
        sum = 0u; cnt = 0u; mine = 0u;
#pragma unroll
        for (unsigned j = 0; j < 16; ++j) { const unsigned c = xb_ld(&bar[XB_XCNT(j)]); sum += c; cnt += (c > 0u) ? 1u : 0u; mine = (j == x) ? c : mine; }
        if (sum == G) break;
        __builtin_amdgcn_s_sleep(1);
        if ((++sp & 255u) == 0u) { if (xb_ld(&bar[XB_TMO])) break; if (sp > XB_SPIN_CAP) { atomicAdd(&bar[XB_TMO], 1u); break; } }
    }
    nloc = mine > 0u ? mine : 1u; nx = cnt > 0u ? cnt : 1u;
}

__device__ __forceinline__ void xcd_barrier(const XcdBarrier& b) {
    asm volatile("s_waitcnt vmcnt(0)" ::: "memory");
    __syncthreads();
    if (threadIdx.x == 0) {
        unsigned* bar = b.bar;
        __builtin_amdgcn_s_waitcnt(0);
        unsigned nloc = b.st[0], nx = b.st[1];
        if (nloc == 0u) { xcd_barrier_complete(bar, b.x, nloc, nx); b.st[0] = nloc; b.st[1] = nx; }
        const unsigned old = xb_add(&bar[XB_XSUB(b.x)], 1u);
        const unsigned gen = old / nloc;
        if (old + 1u == (gen + 1u) * nloc) {
            __builtin_amdgcn_fence(__ATOMIC_RELEASE, "agent");
            asm volatile("s_waitcnt vmcnt(0)" ::: "memory");
            const unsigned og = xb_add(&bar[XB_TOP], 1u);
            const unsigned tg = og / nx;
            if (og + 1u == (tg + 1u) * nx) xb_add(&bar[XB_TOPGEN], 1u);
            else XB_SPIN(xb_ld(&bar[XB_TOPGEN]) == tg, bar);
            __builtin_amdgcn_fence(__ATOMIC_ACQUIRE, "agent");
            xb_add(&bar[XB_XGEN(b.x)], 1u);
            asm volatile("s_waitcnt vmcnt(0)" ::: "memory");
        } else {
            XB_SPIN(xb_ld(&bar[XB_XGEN(b.x)]) == gen, bar);
            __builtin_amdgcn_fence(__ATOMIC_ACQUIRE, "agent");
            asm volatile("s_waitcnt vmcnt(0)" ::: "memory");
        }
    }
    __syncthreads();
}


constexpr int LDS_BYTES = 131072 + 64 + 4096;
constexpr int NPHASE = 13;
__global__ void __launch_bounds__(512, 2) mk_fwd(Params P) {
    extern __shared__ __attribute__((aligned(16))) unsigned char lds_raw[];
    LAS unsigned char* lds = (LAS unsigned char*)lds_raw;
    cg::grid_group grid = cg::this_grid();
    const int lo = P.ph_lo, hi = P.ph_hi;
    if (threadIdx.x < 4) ((LAS unsigned*)(lds + 131072))[threadIdx.x] = 0u;
    __syncthreads();
    XcdBarrier bar = xcd_barrier_post((unsigned*)P.ws + P.li * XCD_BAR_WORDS, (volatile LAS unsigned*)(lds + 131072));
    if (hi < 0) grid.sync();
    const int wave = threadIdx.x >> 6;
    bf16_t* H = (bf16_t*)(P.ws + WS_H); bf16_t* Zb = (bf16_t*)(P.ws + WS_Z); bf16_t* A2 = (bf16_t*)(P.ws + WS_A2); bf16_t* YBF = (bf16_t*)(P.ws + WS_YBF);
    float* MOD = (float*)(P.ws + WS_MOD); bf16_t* Y1b = (bf16_t*)(P.ws + WS_Z);
#ifndef PHMASK
#define PHMASK 0x3fff
#endif
#ifndef DBLMASK
#define DBLMASK 0
#endif
#ifndef STAGGER_TICKS
#define STAGGER_TICKS 1300
#endif
#define STAGGER() do { if (blockIdx.x >= 128) { const unsigned long long t0_ = __builtin_amdgcn_s_memrealtime(); while (__builtin_amdgcn_s_memrealtime() - t0_ < STAGGER_TICKS) __builtin_amdgcn_s_sleep(8); } } while (0)
#define IN(k) (((PHMASK >> (k)) & 1) && lo <= (k) && (k) < hi)
#ifdef USE_CG_SYNC
#define SEAM(k) do { if (lo <= (k) && (k) + 1 < hi) grid.sync(); } while (0)
#else
#define SEAM(k) do { if (lo <= (k) && (k) + 1 < hi) xcd_barrier(bar); } while (0)
#endif
    if (IN(0)) phase0(P, lds);
    SEAM(0);
    if (IN(1)) phase_norm(P.in[I_XP], P.in[I_XS], P.in[I_NORMG], MOD, H);
    SEAM(1);
    if (IN(2)) { pg8::Gemm g{H, (const bf16_t*)(P.ws + WS_WIN_E), M, NZ, 1024}; pg8::StaticOrder S; S.init(M, NZ, gridDim.x, blockIdx.x);
        EpiZ E{Zb, P.in[I_LB]}; pg8::gemm_phase<EpiZ, pg8::StaticOrder>(lds, g, S, E); }
    SEAM(2);
    if (IN(3)) {
        for (int t = blockIdx.x; t < 1024; t += gridDim.x) hgrn_pass1_task(P, lds, t);
        for (int t = blockIdx.x * 8 + wave; t < 4096; t += gridDim.x * 8) s5_task<false>(P, lds + wave * 8192, t);
    }
    SEAM(3);
    if (IN(4)) {
        hgrn_carry(P);
        const int nslot = gridDim.x * 8, slot = wave < 4 ? blockIdx.x * 4 + wave : (nslot >> 1) + blockIdx.x * 4 + (wave - 4);
        for (int t = slot; t < 5120; t += nslot) s5_task<true>(P, lds + wave * 8192, t);
    }
    SEAM(4);
    if (IN(5)) {
        for (int t = blockIdx.x; t < 1280; t += gridDim.x) hgrn_task<true>(P, lds, t);
        combine_b(P);
    }
    SEAM(5);
    if (IN(6)) {
        pg8::Gemm g{YBF, (const bf16_t*)(P.ws + WS_WGLU), M, 512, 512}; pg8::StaticOrder S; S.init(M, 512, gridDim.x, blockIdx.x);
        EpiGlu E{YBF, Zb, P.in[I_BGLU], A2}; pg8::gemm_phase<EpiGlu, pg8::StaticOrder>(lds, g, S, E);
        combine_a(P, gridDim.x > 128 ? 64 : 0);
    }
    SEAM(6);
    if (IN(7)) { pg8::Gemm g{A2, (const bf16_t*)(P.ws + WS_WOUT_E), M, 1024, 1024}; pg8::StaticOrder S; S.init(M, 1024, gridDim.x, blockIdx.x);
        EpiRes3 E{P.in[I_XP], P.in[I_XS], MOD, MOD + 9 * 3072, P.in[I_NORMG] + 1024, Y1b, H, (float*)(P.ws + WS_SSP), lds + 131072 + 64}; pg8::gemm_phase<EpiRes3, pg8::StaticOrder>(lds, g, S, E);
        sw_items(P, lds, gridDim.x >= 256 ? 128 : 0); }
    SEAM(7);
    if (IN(8)) phase_rstd(P);
    SEAM(8);
    if (IN(9)) { pg8::Gemm g{H, (const bf16_t*)(P.ws + WS_WIN_O), M, 4096, 1024}; pg8::StaticOrder S; S.init(M, 4096, gridDim.x, blockIdx.x);
        EpiOdd E{(bf16_t*)(P.ws + WS_Z + 160 * MiB), A2, (const float*)(P.ws + WS_RSTD), (const float*)(P.ws + WS_SW), (bf16_t*)(P.ws + WS_Z + 80 * MiB), P.in[I_CW], P.in[I_CB]}; pg8::gemm_phase<EpiOdd, pg8::StaticOrder>(lds, g, S, E); }
    SEAM(9);
    if (IN(10)) phase_conv(P);
    SEAM(10);
    if (IN(11)) { pg8::Gemm g{(const bf16_t*)(P.ws + WS_Z + 80 * MiB), (const bf16_t*)(P.ws + WS_WOUT_O), M, 1024, 1024}; pg8::StaticOrder S; S.init(M, 1024, gridDim.x, blockIdx.x);
        EpiRes5 E{Y1b, MOD + 9 * 3072, P.in[I_FNG], H, (float*)(P.ws + WS_SSP)}; pg8::gemm_phase<EpiRes5, pg8::StaticOrder>(lds, g, S, E); }
    SEAM(11);
    if (IN(12)) phase_final_norm(P.out, H, (const float*)(P.ws + WS_SSP));
#undef IN
#undef SEAM
}

extern "C" void kernel_launch(void* const* d_in, const int* in_sizes, int n_in, void* d_out, int out_size, void* d_ws, size_t ws_size, hipStream_t stream) {
    static int grid = 0;
    if (grid == 0) {
        if (n_in != 29 || ws_size < WS_END) { fprintf(stderr, "kernel_launch: unexpected n_in %d / ws_size %zu (need %zu)\n", n_in, ws_size, (size_t)WS_END); grid = -1; return; }
        int dev = 0, cus = 0, per_cu = 0;
        hipGetDevice(&dev); hipDeviceGetAttribute(&cus, hipDeviceAttributeMultiprocessorCount, dev);
        if (hipFuncSetAttribute((const void*)mk_fwd, hipFuncAttributeMaxDynamicSharedMemorySize, LDS_BYTES) != hipSuccess) { fprintf(stderr, "kernel_launch: hipFuncSetAttribute failed\n"); grid = -1; return; }
        if (hipOccupancyMaxActiveBlocksPerMultiprocessor(&per_cu, (const void*)mk_fwd, 512, LDS_BYTES) != hipSuccess || per_cu < 1) { fprintf(stderr, "kernel_launch: occupancy query says %d\n", per_cu); per_cu = 1; }
        (void)hipGetLastError();
        grid = cus * per_cu;
        fprintf(stderr, "kernel_launch: grid %d (cus %d x %d)\n", grid, cus, per_cu);
    }
    if (grid < 0) return;
    Params p{};
    (void)hipMemsetAsync(d_ws, 0, 65536, stream);
    for (int i = 0; i < 29; ++i) p.in[i] = (const float*)d_in[i];
    p.out = (float*)d_out; p.ws = (unsigned char*)d_ws;
#if MK_COOP
    void* args[] = {&p};
#ifdef PROBE_SPLIT
    p.ph_lo = 0; p.ph_hi = PROBE_SPLIT + 1;
    (void)hipLaunchCooperativeKernel((const void*)mk_fwd, dim3(grid), dim3(512), args, LDS_BYTES, stream);
    p.ph_lo = PROBE_SPLIT; p.ph_hi = NPHASE; p.li = 1;
#else
    p.ph_lo = 0; p.ph_hi = NPHASE;
#endif
    hipError_t e = hipLaunchCooperativeKernel((const void*)mk_fwd, dim3(grid), dim3(512), args, LDS_BYTES, stream);
    if (e != hipSuccess) fprintf(stderr, "kernel_launch: cooperative launch failed: %s (grid %d)\n", hipGetErrorString(e), grid);
#else
    for (int ph = 0; ph < NPHASE; ++ph) { p.ph_lo = ph; p.ph_hi = ph + 1; hipLaunchKernelGGL(mk_fwd, dim3(grid), dim3(512), LDS_BYTES, stream, p); }
#endif
}
```
